# Optimizing an MI355X kernel written in HIP

```python
import jax, jax.numpy as jnp
from jax import lax
import numpy as np

D_MODEL = 1024
BATCH = 16
SEQ = 2048
DEPTH = 2

CHUNK = 64
MIX_WIDTH = D_MODEL
RWKV_HEADS = 8
RWKV_HEAD_DIM = 64
RWKV_WIDTH = RWKV_HEADS * RWKV_HEAD_DIM
DECAY_LORA = 64
ICL_LORA = 64
GATE_LORA = 128
RWKV_IN = 3 * RWKV_WIDTH + DECAY_LORA + ICL_LORA + GATE_LORA
RET_HEADS = 4
RET_QK_DIM = 64
RET_V_DIM = 128
RET_QK_WIDTH = RET_HEADS * RET_QK_DIM
RET_V_WIDTH = RET_HEADS * RET_V_DIM
RET_IN = 2 * RET_QK_WIDTH + 2 * RET_V_WIDTH
PROJ_WIDTH = RWKV_IN + RET_IN
D_FF = 2816
ROPE_BASE = 10000.0
NORM_EPS = 1e-6
LN_X_EPS = 64e-5

kernel_name = "hybrid_rwkv7_retnet_macaron_trunk"


def rms_norm(x, gain, eps=NORM_EPS):
    xf = x.astype(jnp.float32)
    y = xf * lax.rsqrt(jnp.mean(xf * xf, axis=-1, keepdims=True) + eps)
    return (y * gain.astype(jnp.float32)).astype(x.dtype)


def swiglu(h, w_gate, w_up, w_down):
    return (jax.nn.silu(h @ w_gate) * (h @ w_up)) @ w_down


def token_shift(p, mu):
    prev = jnp.pad(p, ((0, 0), (1, 0), (0, 0)))[:, :-1]
    return p + mu * (prev - p)


def rwkv7_scan(r, w, k, v, a, b):
    B, S, H, N = r.shape

    def step(state, inp):
        r_t, w_t, k_t, v_t, a_t, b_t = inp
        sa = jnp.einsum('bhvk,bhk->bhv', state, a_t)
        state = (state * w_t[:, :, None, :] + sa[..., None] * b_t[:, :, None, :]
                 + v_t[..., None] * k_t[:, :, None, :])
        return state, jnp.einsum('bhvk,bhk->bhv', state, r_t)

    xs = (jnp.moveaxis(r, 1, 0), jnp.moveaxis(w, 1, 0), jnp.moveaxis(k, 1, 0),
          jnp.moveaxis(v, 1, 0), jnp.moveaxis(a, 1, 0), jnp.moveaxis(b, 1, 0))
    state0 = jnp.zeros((B, H, N, N), jnp.float32)
    _, y = lax.scan(step, state0, xs)
    return jnp.moveaxis(y, 0, 1)


def rwkv7_group(p, mu, w0, w_lora_up, a0, a_lora_up, g_lora_up, k_k, k_a, r_k,
                ln_w, ln_b):
    B, S, _ = p.shape
    p = token_shift(p, mu)
    o1 = RWKV_WIDTH
    o2 = 2 * RWKV_WIDTH
    o3 = 3 * RWKV_WIDTH
    o4 = o3 + DECAY_LORA
    o5 = o4 + ICL_LORA
    r, k, v, w_d, a_d, g_d = jnp.split(p, [o1, o2, o3, o4, o5], axis=-1)
    f32 = jnp.float32
    log_w = -jax.nn.softplus(-(w0 + jnp.tanh(w_d) @ w_lora_up).astype(f32)) - 0.5
    decay = jnp.exp(-jnp.exp(log_w))
    a = jax.nn.sigmoid((a0 + a_d @ a_lora_up).astype(f32))
    g = (jax.nn.sigmoid(g_d) @ g_lora_up).astype(f32)

    def heads(t):
        return t.astype(f32).reshape(B, S, RWKV_HEADS, RWKV_HEAD_DIM)

    kk = heads(k * k_k)
    kk = kk * lax.rsqrt(jnp.maximum(jnp.sum(kk * kk, axis=-1, keepdims=True), 1e-24))
    k_h = heads(k.astype(f32) * (1.0 + (a - 1.0) * k_a.astype(f32)))
    r_h = heads(r)
    v_h = heads(v)
    a_h = heads(a)
    y = rwkv7_scan(r_h, heads(decay), k_h, v_h, -kk, kk * a_h)
    mean = jnp.mean(y, axis=-1, keepdims=True)
    var = jnp.mean(jnp.square(y - mean), axis=-1, keepdims=True)
    y = ((y - mean) * lax.rsqrt(var + LN_X_EPS)
         * ln_w.astype(f32).reshape(RWKV_HEADS, RWKV_HEAD_DIM)
         + ln_b.astype(f32).reshape(RWKV_HEADS, RWKV_HEAD_DIM))
    y = y + jnp.sum(r_h * k_h * r_k.astype(f32), axis=-1, keepdims=True) * v_h
    return (y.reshape(B, S, RWKV_WIDTH) * g).astype(p.dtype)


def rotary(x, pos):
    half = x.shape[-1] // 2
    inv_freq = 1.0 / (ROPE_BASE ** jnp.linspace(0.0, 1.0, half, dtype=jnp.float32))
    ang = pos[:, None] * inv_freq[None, :]
    cos = jnp.cos(ang)[None, :, None, :]
    sin = jnp.sin(ang)[None, :, None, :]
    x1, x2 = x[..., :half], x[..., half:]
    return jnp.concatenate([x1 * cos - x2 * sin, x1 * sin + x2 * cos], axis=-1)


def retention_chunkwise(q, k, v):
    B, S, H, dk = q.shape
    dv = v.shape[-1]
    nc = S // CHUNK
    log_gamma = jnp.log(1.0 - jnp.power(2.0, -5.0 - jnp.arange(H, dtype=jnp.float32)))
    qc = q.reshape(B, nc, CHUNK, H, dk)
    kc = k.reshape(B, nc, CHUNK, H, dk)
    vc = v.reshape(B, nc, CHUNK, H, dv)
    pos = jnp.arange(CHUNK, dtype=jnp.float32)
    dist = jnp.abs(pos[:, None] - pos[None, :])
    intra_decay = jnp.exp(log_gamma[:, None, None] * dist)
    scores = jnp.einsum('bnihd,bnjhd->bnhij', qc, kc) * intra_decay
    intra = jnp.einsum('bnhij,bnjhe->bnihe', scores, vc)
    key_w = jnp.exp(log_gamma[:, None] * (CHUNK - 1.0 - pos)[None, :])
    chunk_kv = jnp.einsum('bnjhd,hj,bnjhe->bnhde', kc, key_w, vc)
    chunk_decay = jnp.exp(log_gamma * CHUNK)[None, :, None, None]

    def step(state, kv_n):
        return state * chunk_decay + kv_n, state

    _, prev = lax.scan(step, jnp.zeros((B, H, dk, dv), jnp.float32),
                       jnp.moveaxis(chunk_kv, 1, 0))
    prev = jnp.moveaxis(prev, 0, 1)
    query_w = jnp.exp(log_gamma[:, None] * (pos + 1.0)[None, :])
    cross = jnp.einsum('bnihd,hi,bnhde->bnihe', qc, query_w, prev)
    return (intra + cross).reshape(B, S, H, dv)


def retnet_group(p):
    B, S, _ = p.shape
    f32 = jnp.float32
    q, k, v, g = jnp.split(p, [RET_QK_WIDTH, 2 * RET_QK_WIDTH,
                               2 * RET_QK_WIDTH + RET_V_WIDTH], axis=-1)
    pos = jnp.arange(S, dtype=f32)
    q = rotary(q.astype(f32).reshape(B, S, RET_HEADS, RET_QK_DIM), pos)
    k = rotary(k.astype(f32).reshape(B, S, RET_HEADS, RET_QK_DIM), pos) * (RET_QK_DIM ** -0.5)
    v = v.astype(f32).reshape(B, S, RET_HEADS, RET_V_DIM)
    o = retention_chunkwise(q, k, v)
    o = o * lax.rsqrt(jnp.mean(o * o, axis=-1, keepdims=True) + NORM_EPS)
    return (o.reshape(B, S, RET_V_WIDTH) * jax.nn.silu(g.astype(f32))).astype(p.dtype)


def setup_inputs(seed: int = 0) -> dict:
    key = jax.random.key(seed)
    ks = jax.random.split(key, 32)
    f32 = jnp.float32

    def nrm(k, shape, scale):
        return jax.random.normal(k, shape, f32) * scale

    decay_speed = -7.0 + 5.0 * jnp.linspace(0.0, 1.0, RWKV_WIDTH, dtype=f32) ** 0.85 + 0.5
    return {
        "x": nrm(ks[0], (BATCH, SEQ, D_MODEL), 1.0),
        "ffn1_norm": 1.0 + nrm(ks[1], (DEPTH, D_MODEL), 0.1),
        "ffn1_w_gate": nrm(ks[2], (DEPTH, D_MODEL, D_FF), D_MODEL ** -0.5),
        "ffn1_w_up": nrm(ks[3], (DEPTH, D_MODEL, D_FF), D_MODEL ** -0.5),
        "ffn1_w_down": nrm(ks[4], (DEPTH, D_FF, D_MODEL), D_FF ** -0.5),
        "mix_norm": 1.0 + nrm(ks[5], (DEPTH, D_MODEL), 0.1),
        "w_in": nrm(ks[6], (DEPTH, D_MODEL, PROJ_WIDTH), D_MODEL ** -0.5),
        "shift_mu": jax.random.uniform(ks[7], (DEPTH, RWKV_IN), f32),
        "w0": decay_speed[None, :] + nrm(ks[8], (DEPTH, RWKV_WIDTH), 0.1),
        "w_lora_up": nrm(ks[9], (DEPTH, DECAY_LORA, RWKV_WIDTH), 0.1),
        "a0": nrm(ks[10], (DEPTH, RWKV_WIDTH), 0.1),
        "a_lora_up": nrm(ks[11], (DEPTH, ICL_LORA, RWKV_WIDTH), 0.5 * ICL_LORA ** -0.5),
        "g_lora_up": nrm(ks[12], (DEPTH, GATE_LORA, RWKV_WIDTH), GATE_LORA ** -0.5),
        "k_k": 0.85 + nrm(ks[13], (DEPTH, RWKV_WIDTH), 0.05),
        "k_a": 1.0 + nrm(ks[14], (DEPTH, RWKV_WIDTH), 0.05),
        "r_k": nrm(ks[15], (DEPTH, RWKV_HEADS, RWKV_HEAD_DIM), 0.1),
        "ln_x_w": 1.0 + nrm(ks[16], (DEPTH, RWKV_WIDTH), 0.1),
        "ln_x_b": nrm(ks[17], (DEPTH, RWKV_WIDTH), 0.01),
        "w_out": nrm(ks[18], (DEPTH, MIX_WIDTH, D_MODEL), MIX_WIDTH ** -0.5),
        "ffn2_norm": 1.0 + nrm(ks[19], (DEPTH, D_MODEL), 0.1),
        "ffn2_w_gate": nrm(ks[20], (DEPTH, D_MODEL, D_FF), D_MODEL ** -0.5),
        "ffn2_w_up": nrm(ks[21], (DEPTH, D_MODEL, D_FF), D_MODEL ** -0.5),
        "ffn2_w_down": nrm(ks[22], (DEPTH, D_FF, D_MODEL), D_FF ** -0.5),
        "final_norm": 1.0 + nrm(ks[23], (D_MODEL,), 0.1),
    }


def reference(x, ffn1_norm, ffn1_w_gate, ffn1_w_up, ffn1_w_down, mix_norm, w_in,
              shift_mu, w0, w_lora_up, a0, a_lora_up, g_lora_up, k_k, k_a, r_k,
              ln_x_w, ln_x_b, w_out, ffn2_norm, ffn2_w_gate, ffn2_w_up, ffn2_w_down,
              final_norm):
    for l in range(DEPTH):
        x = x + 0.5 * swiglu(rms_norm(x, ffn1_norm[l]), ffn1_w_gate[l], ffn1_w_up[l],
                             ffn1_w_down[l])
        h = rms_norm(x, mix_norm[l])
        proj = h @ w_in[l]
        y_rwkv = rwkv7_group(proj[..., :RWKV_IN], shift_mu[l], w0[l], w_lora_up[l], a0[l],
                             a_lora_up[l], g_lora_up[l], k_k[l], k_a[l], r_k[l],
                             ln_x_w[l], ln_x_b[l])
        y_ret = retnet_group(proj[..., RWKV_IN:])
        mixed = jnp.concatenate([y_rwkv, y_ret], axis=-1).astype(x.dtype)
        x = x + mixed @ w_out[l]
        x = x + 0.5 * swiglu(rms_norm(x, ffn2_norm[l]), ffn2_w_gate[l], ffn2_w_up[l],
                             ffn2_w_down[l])
    return rms_norm(x, final_norm)
```

```cpp
#include <hip/hip_runtime.h>
#include <cstdio>
#include <cstdint>
#include <cmath>
namespace pg8 {
#define PG8_LAS __attribute__((address_space(3)))
typedef unsigned short bf16_t;
typedef short bf16x8 __attribute__((ext_vector_type(8)));
typedef float f32x4 __attribute__((ext_vector_type(4)));
typedef unsigned u32x4 __attribute__((ext_vector_type(4)));
constexpr int BM = 256, BK = 64, HALF = 128, HTB = HALF * BK * 2  , STAGE_BYTES = 8 * HTB, NXCD = 8, WGM = 8;

__host__ __device__ __forceinline__ int lds_byte(int r, int c) { const int st = (r >> 4) * 2 + (c >> 5), rr = r & 15, cc = c & 31, ob = rr * 64 + cc * 2; return st * 1024 + (ob ^ (((ob >> 9) & 1) << 5)); }
__host__ __device__ __forceinline__ void stage_rc(int b, int& R, int& C) { const int st = b / 1024, sb = b % 1024, swz = sb ^ (((sb >> 9) & 1) << 5); R = (st >> 1) * 16 + swz / 64; C = (st & 1) * 32 + (swz % 64) / 2; }
__host__ __device__ __forceinline__ int perm32(int rho) { const int n = rho >> 4, i = rho & 15; return 8 * (i >> 2) + 4 * n + (i & 3); }

struct Unit { int pm, pn; };
struct Gemm { const bf16_t* A; const bf16_t* Bt; int M, N, K; };

struct StaticOrder {
    int nM, nN, nwg, G, c;
    __host__ __device__ void init(int M, int N, int G_, int c_) { nM = M / BM; nN = N / BM; nwg = nM * nN; G = G_; c = c_; }
    __host__ __device__ bool next(int i, Unit& u) const {
        const long L = (long)i * G + c; if (L >= nwg) return false;
        int wgid = (int)L; { const int q = nwg / NXCD, r = nwg % NXCD, xcd = wgid % NXCD, off = wgid / NXCD; wgid = (xcd < r ? xcd * (q + 1) : r * (q + 1) + (xcd - r) * q) + off; }
        const int nig = WGM * nN, gid = wgid / nig, fm = gid * WGM, gsz = (nM - fm) < WGM ? (nM - fm) : WGM;
        u.pm = fm + ((wgid % nig) % gsz); u.pn = (wgid % nig) / gsz; return true;
    }
    __device__ __forceinline__ void a_ready(const Unit&) const {}
    __device__ __forceinline__ void done(const Unit&) const {}
};


__device__ __forceinline__ unsigned cvt_pk_bf16(float lo, float hi) { unsigned r; asm volatile("v_cvt_pk_bf16_f32 %0, %1, %2" : "=v"(r) : "v"(lo), "v"(hi)); return r; }
typedef unsigned u32x2 __attribute__((ext_vector_type(2)));
constexpr int SSQ_P = 16;
constexpr float RMS_EPS = 1e-6f;
__device__ __forceinline__ float fast_rcp(float x) { return __builtin_amdgcn_rcpf(x); }
__device__ __forceinline__ float sigmoid_f(float x) { return fast_rcp(1.0f + __expf(-x)); }
__device__ __forceinline__ float silu_f(float x) { return x * sigmoid_f(x); }
__device__ __forceinline__ float row_rstd(const float* ssq, int row) {
    const f32x4* p = (const f32x4*)(ssq + (size_t)row * SSQ_P);
    const f32x4 a = p[0], b = p[1], c = p[2], d = p[3];
    const f32x4 s = (a + b) + (c + d);
    const float t = (s[0] + s[1]) + (s[2] + s[3]);
    return 1.0f / sqrtf(t * (1.0f / 1024.0f) + RMS_EPS);
}
struct EpiSwiglu {
    static constexpr bool PERM = true, AFTER_DRAIN = false;
    bf16_t* H; int ldh; const float* ssq;
    __device__ __forceinline__ void operator()(const f32x4 (&acc)[2][2][4][2], const Unit& u, int wr, int wc, int fr, int fq) const {
        const int row0 = u.pm * BM + wr * 64 + fr, col0 = u.pn * HALF + wc * 32 + 8 * fq;
#pragma unroll
        for (int ai = 0; ai < 2; ++ai)
#pragma unroll
            for (int m = 0; m < 4; ++m) { const int row = row0 + ai * HALF + m * 16; const float rs = row_rstd(ssq, row);
                float hv[8];
#pragma unroll
                for (int n = 0; n < 2; ++n)
#pragma unroll
                    for (int i = 0; i < 4; ++i) { const float g = acc[ai][0][m][n][i] * rs, up = acc[ai][1][m][n][i] * rs; hv[n * 4 + i] = silu_f(g) * up; }
                u32x4 w; w.x = cvt_pk_bf16(hv[0], hv[1]); w.y = cvt_pk_bf16(hv[2], hv[3]); w.z = cvt_pk_bf16(hv[4], hv[5]); w.w = cvt_pk_bf16(hv[6], hv[7]);
                *(u32x4*)(H + (size_t)row * ldh + col0) = w; }
    }
};
struct EpiResid {
    static constexpr bool PERM = false, AFTER_DRAIN = false;
    float* x; bf16_t* xb; float* ssq; float scale;
    __device__ __forceinline__ void operator()(const f32x4 (&acc)[2][2][4][2], const Unit& u, int wr, int wc, int fr, int fq) const {
        const int row0 = u.pm * BM + wr * 64 + fr, col0 = u.pn * BM + wc * 32 + 4 * fq;
#pragma unroll
        for (int ai = 0; ai < 2; ++ai)
#pragma unroll
            for (int m = 0; m < 4; ++m) { const int row = row0 + ai * HALF + m * 16; float ss = 0.f;
#pragma unroll
                for (int bj = 0; bj < 2; ++bj)
#pragma unroll
                    for (int n = 0; n < 2; ++n) { const size_t off = (size_t)row * 1024 + col0 + bj * HALF + n * 16;
                        const f32x4 xo = *(const f32x4*)(x + off); const f32x4 xn = xo + acc[ai][bj][m][n] * scale;
                        *(f32x4*)(x + off) = xn; ss += (xn[0] * xn[0] + xn[1] * xn[1]) + (xn[2] * xn[2] + xn[3] * xn[3]);
                        u32x2 w; w.x = cvt_pk_bf16(xn[0], xn[1]); w.y = cvt_pk_bf16(xn[2], xn[3]); *(u32x2*)(xb + off) = w; }
                ss += __shfl_xor(ss, 16); ss += __shfl_xor(ss, 32);
                if (fq == 0) ssq[(size_t)row * SSQ_P + u.pn * 4 + wc] = ss; }
    }
};
template <bool SCALE> struct EpiProj {
    static constexpr bool PERM = true, AFTER_DRAIN = false;
    bf16_t* O; int ldc; const float* ssq;
    __device__ __forceinline__ void operator()(const f32x4 (&acc)[2][2][4][2], const Unit& u, int wr, int wc, int fr, int fq) const {
        const int row0 = u.pm * BM + wr * 64 + fr, col0 = u.pn * BM + wc * 32 + 8 * fq;
#pragma unroll
        for (int ai = 0; ai < 2; ++ai)
#pragma unroll
            for (int m = 0; m < 4; ++m) { const int row = row0 + ai * HALF + m * 16; const float rs = SCALE ? row_rstd(ssq, row) : 1.0f;
#pragma unroll
                for (int bj = 0; bj < 2; ++bj) { const f32x4 v0 = acc[ai][bj][m][0] * rs, v1 = acc[ai][bj][m][1] * rs;
                    u32x4 w; w.x = cvt_pk_bf16(v0[0], v0[1]); w.y = cvt_pk_bf16(v0[2], v0[3]); w.z = cvt_pk_bf16(v1[0], v1[1]); w.w = cvt_pk_bf16(v1[2], v1[3]);
                    *(u32x4*)(O + (size_t)row * ldc + col0 + bj * HALF) = w; } }
    }
};

template <class Epi, class Sched, bool ALIGN_EPI = false, bool SP2 = false>
__device__ __forceinline__ void gemm_phase(PG8_LAS unsigned char* lds, const Gemm g, const Sched& S, const Epi& E) {
    int tid_ = threadIdx.x; asm volatile("" : "+v"(tid_));
    const int tid = tid_, wid = __builtin_amdgcn_readfirstlane(tid >> 6), lane = tid & 63, wr = wid >> 2, wc = wid & 3, fr = lane & 15, fq = lane >> 4;
    const int K = g.K, nt = K / BK;
    unsigned voffA[2], voffB[2];
#pragma unroll
    for (int i = 0; i < 2; ++i) { int R, C; stage_rc(tid * 16 + i * 8192, R, C); const int Rb = Epi::PERM ? ((R & ~31) + perm32(R & 31)) : R;
        voffA[i] = (unsigned)(R * K + C) * 2u; voffB[i] = (unsigned)(Rb * K + C) * 2u; }
    const size_t kstep = (size_t)(BK * 2);
    const size_t hstep = (size_t)HALF * K * 2;
    const size_t tstep = 2 * hstep;
    const unsigned ldsw = (unsigned)wid * 1024u;
    const int aoff = lds_byte(wr * 64 + fr, fq * 8), boff = lds_byte(wc * 32 + fr, fq * 8);
#define PG8_SA(b, h) (((b) * 2 + (h)) * HTB)
#define PG8_SB(b, h) ((4 + (b) * 2 + (h)) * HTB)
#define PG8_STAGE(bufoff, gbase, voff) do { _Pragma("unroll") for (int _i = 0; _i < 2; ++_i) \
        __builtin_amdgcn_global_load_lds((const unsigned*)((const char*)(gbase) + (voff)[_i]), (PG8_LAS unsigned*)(lds + (bufoff) + ldsw + _i * 8192), 16, 0, 0); } while (0)
#define PG8_LDA(dst, b, h) do { _Pragma("unroll") for (int m = 0; m < 4; ++m) _Pragma("unroll") for (int k = 0; k < 2; ++k) dst[m][k] = *(const PG8_LAS bf16x8*)(lds + PG8_SA(b, h) + aoff + m * 2048 + k * 1024); } while (0)
#define PG8_LDB(dst, b, h) do { _Pragma("unroll") for (int n = 0; n < 2; ++n) _Pragma("unroll") for (int k = 0; k < 2; ++k) dst[n][k] = *(const PG8_LAS bf16x8*)(lds + PG8_SB(b, h) + boff + n * 2048 + k * 1024); } while (0)
#define PG8_MMA(ai, bj, At, Bt) do { __builtin_amdgcn_s_setprio(1); _Pragma("unroll") for (int m = 0; m < 4; ++m) _Pragma("unroll") for (int n = 0; n < 2; ++n) _Pragma("unroll") for (int k = 0; k < 2; ++k) \
        acc[ai][bj][m][n] = __builtin_amdgcn_mfma_f32_16x16x32_bf16(Bt[n][k], At[m][k], acc[ai][bj][m][n], 0, 0, 0); __builtin_amdgcn_s_setprio(0); } while (0)
#define PG8_WAIT_V(n) asm volatile("s_waitcnt vmcnt(" #n ")" ::: "memory")
#define PG8_WAIT_L(n) asm volatile("s_waitcnt lgkmcnt(" #n ")" ::: "memory")
#define PG8_BAR __builtin_amdgcn_s_barrier()
#define PG8_SCHED __builtin_amdgcn_sched_barrier(0)
    Unit cur, nxt; int ui = 0;
    if (!S.next(0, cur)) return;
    f32x4 acc[2][2][4][2];
#pragma unroll
    for (int a = 0; a < 2; ++a)
#pragma unroll
        for (int b = 0; b < 2; ++b)
#pragma unroll
            for (int m = 0; m < 4; ++m)
#pragma unroll
                for (int n = 0; n < 2; ++n) acc[a][b][m][n] = (f32x4){0.f, 0.f, 0.f, 0.f};
    bf16x8 At[4][2], B0[2][2], B1[2][2];
    const char* cA = (const char*)g.A + (size_t)cur.pm * tstep; const char* cB = (const char*)g.Bt + (size_t)cur.pn * tstep;
    S.a_ready(cur);
    if constexpr (SP2) {
        PG8_STAGE(PG8_SB(0, 0), cB, voffB); PG8_STAGE(PG8_SB(0, 1), cB + hstep, voffB); PG8_STAGE(PG8_SA(0, 0), cA, voffA); PG8_STAGE(PG8_SA(0, 1), cA + hstep, voffA);
        if (wr == 1) PG8_BAR;
        PG8_WAIT_V(2); PG8_BAR;
        PG8_STAGE(PG8_SB(1, 0), cB + kstep, voffB); PG8_STAGE(PG8_SA(1, 0), cA + kstep, voffA); PG8_STAGE(PG8_SB(1, 1), cB + hstep + kstep, voffB);
        PG8_WAIT_V(6); PG8_BAR;
    } else {
        PG8_STAGE(PG8_SB(0, 0), cB, voffB); PG8_STAGE(PG8_SA(0, 0), cA, voffA); PG8_STAGE(PG8_SB(0, 1), cB + hstep, voffB); PG8_STAGE(PG8_SA(0, 1), cA + hstep, voffA);
        if (wr == 1) PG8_BAR;
        PG8_WAIT_V(4); PG8_BAR;
        PG8_STAGE(PG8_SB(1, 0), cB + kstep, voffB); PG8_STAGE(PG8_SA(1, 0), cA + kstep, voffA); PG8_STAGE(PG8_SB(1, 1), cB + hstep + kstep, voffB);
        PG8_WAIT_V(6); PG8_BAR;
    }
    for (;;) {
        const bool has_next = S.next(ui + 1, nxt);
        const char* nA = has_next ? (const char*)g.A + (size_t)nxt.pm * tstep : cA; const char* nB = has_next ? (const char*)g.Bt + (size_t)nxt.pn * tstep : cB;
        for (int t = 0; t < nt; t += 2) {
            const bool last = (t == nt - 2);
            const char* a1 = cA + (size_t)(t + 1) * kstep;
            const char* a2 = last ? nA : cA + (size_t)(t + 2) * kstep; const char* b2 = last ? nB : cB + (size_t)(t + 2) * kstep;
            const char* a3 = a2 + kstep; const char* b3 = b2 + kstep;
            if (last && has_next) S.a_ready(nxt);
            if constexpr (SP2) {
            PG8_LDB(B0, 0, 0); PG8_LDB(B1, 0, 1); PG8_SCHED; PG8_LDA(At, 0, 0); PG8_STAGE(PG8_SA(1, 1), a1 + hstep, voffA);
            PG8_WAIT_V(8); PG8_WAIT_L(0); PG8_BAR; PG8_MMA(0, 0, At, B0); PG8_MMA(0, 1, At, B1); PG8_BAR; PG8_SCHED;
            PG8_LDA(At, 0, 1); PG8_STAGE(PG8_SB(0, 0), b2, voffB); PG8_STAGE(PG8_SB(0, 1), b2 + hstep, voffB); PG8_STAGE(PG8_SA(0, 0), a2, voffA);
            PG8_WAIT_V(8); PG8_WAIT_L(0); PG8_BAR; PG8_MMA(1, 0, At, B0); PG8_MMA(1, 1, At, B1); PG8_BAR; PG8_SCHED;
            PG8_LDB(B0, 1, 0); PG8_LDB(B1, 1, 1); PG8_SCHED; PG8_LDA(At, 1, 0); PG8_STAGE(PG8_SA(0, 1), a2 + hstep, voffA);
            PG8_WAIT_V(8); PG8_WAIT_L(0); PG8_BAR; PG8_MMA(0, 0, At, B0); PG8_MMA(0, 1, At, B1); PG8_BAR; PG8_SCHED;
            PG8_LDA(At, 1, 1); PG8_STAGE(PG8_SB(1, 0), b3, voffB); PG8_STAGE(PG8_SB(1, 1), b3 + hstep, voffB); PG8_STAGE(PG8_SA(1, 0), a3, voffA);
            PG8_WAIT_V(8); PG8_WAIT_L(0); PG8_BAR; PG8_MMA(1, 0, At, B0); PG8_MMA(1, 1, At, B1); PG8_BAR; PG8_SCHED;
            } else {
            PG8_LDB(B0, 0, 0); PG8_SCHED; PG8_LDA(At, 0, 0); PG8_STAGE(PG8_SA(1, 1), a1 + hstep, voffA);
            PG8_WAIT_L(8); PG8_BAR; PG8_WAIT_L(0); PG8_MMA(0, 0, At, B0); PG8_BAR; PG8_SCHED;
            PG8_LDB(B1, 0, 1); PG8_STAGE(PG8_SB(0, 0), b2, voffB);
            PG8_BAR; PG8_WAIT_L(0); PG8_MMA(0, 1, At, B1); PG8_BAR;
            PG8_LDA(At, 0, 1); PG8_STAGE(PG8_SA(0, 0), a2, voffA);
            PG8_BAR; PG8_WAIT_L(0); PG8_MMA(1, 0, At, B0); PG8_BAR; PG8_SCHED;
            PG8_STAGE(PG8_SB(0, 1), b2 + hstep, voffB);
            PG8_WAIT_V(6); PG8_BAR; PG8_MMA(1, 1, At, B1); PG8_BAR;
            PG8_LDB(B0, 1, 0); PG8_SCHED; PG8_LDA(At, 1, 0); PG8_STAGE(PG8_SA(0, 1), a2 + hstep, voffA);
            PG8_WAIT_L(8); PG8_BAR; PG8_WAIT_L(0); PG8_MMA(0, 0, At, B0); PG8_BAR; PG8_SCHED;
            PG8_LDB(B1, 1, 1); PG8_STAGE(PG8_SB(1, 0), b3, voffB);
            PG8_BAR; PG8_WAIT_L(0); PG8_MMA(0, 1, At, B1); PG8_BAR;
            PG8_LDA(At, 1, 1); PG8_STAGE(PG8_SA(1, 0), a3, voffA);
            PG8_BAR; PG8_WAIT_L(0); PG8_MMA(1, 0, At, B0); PG8_BAR; PG8_SCHED;
            PG8_STAGE(PG8_SB(1, 1), b3 + hstep, voffB);
            PG8_WAIT_V(6); PG8_BAR; PG8_MMA(1, 1, At, B1); PG8_BAR;
            }
        }
        if constexpr (ALIGN_EPI) { if (wr == 0) PG8_BAR; }
        if constexpr (!Epi::AFTER_DRAIN) { E(acc, cur, wr, wc, fr, fq); S.done(cur); }
        if (!has_next) break;
#pragma unroll
        for (int a = 0; a < 2; ++a)
#pragma unroll
            for (int b = 0; b < 2; ++b)
#pragma unroll
                for (int m = 0; m < 4; ++m)
#pragma unroll
                    for (int n = 0; n < 2; ++n) acc[a][b][m][n] = (f32x4){0.f, 0.f, 0.f, 0.f};
        cur = nxt; cA = nA; cB = nB; ++ui;
        if constexpr (ALIGN_EPI) { if (wr == 1) PG8_BAR; }
    }
    PG8_WAIT_V(0);
    if constexpr (!ALIGN_EPI) { if (wr == 0) PG8_BAR; }
    PG8_BAR;
    if constexpr (Epi::AFTER_DRAIN) { E.fused(acc, cur, wr, wc, fr, fq, lds, wid, lane); S.done(cur); }
#undef PG8_SA
#undef PG8_SB
#undef PG8_STAGE
#undef PG8_LDA
#undef PG8_LDB
#undef PG8_MMA
#undef PG8_WAIT_V
#undef PG8_WAIT_L
#undef PG8_BAR
#undef PG8_SCHED
}
}
#define GAS __attribute__((address_space(1)))
#define LAS __attribute__((address_space(3)))
typedef unsigned short bf16;
typedef unsigned v4u __attribute__((ext_vector_type(4)));
typedef float f32x4 __attribute__((ext_vector_type(4)));
typedef short bf16x8 __attribute__((ext_vector_type(8)));
typedef GAS unsigned gu32;
typedef GAS unsigned long long gu64;
#define RLX_AGENT __ATOMIC_RELAXED, __HIP_MEMORY_SCOPE_AGENT
#define LDS_WAIT() asm volatile("s_waitcnt lgkmcnt(0)" ::: "memory")
#define VM_WAIT() asm volatile("s_waitcnt vmcnt(0)" ::: "memory")
__device__ __forceinline__ unsigned long long rt() { return __builtin_amdgcn_s_memrealtime(); }
__device__ __forceinline__ unsigned f2bf(float f) { unsigned u = __builtin_bit_cast(unsigned, f); return (u + 0x7fffu + ((u >> 16) & 1u)) >> 16; }
__device__ __forceinline__ unsigned pk2(float lo, float hi) { return f2bf(lo) | (f2bf(hi) << 16); }

#define XB_TMO      128
#define XB_XCNT(j)  (256  + 64 * (j))
#define XB_XSUB(j)  (1280 + 64 * (j))
#define XB_XGEN(j)  (2304 + 64 * (j))
#define XB_TOP      3328
#define XB_TOPGEN   3392
#define XCD_BAR_WORDS 3456
#define XB_SPIN_CAP (1u << 18)

__device__ __forceinline__ unsigned xb_ld(unsigned* p)              { return __hip_atomic_load(p, __ATOMIC_RELAXED, __HIP_MEMORY_SCOPE_AGENT); }
__device__ __forceinline__ unsigned xb_add(unsigned* p, unsigned v) { return __hip_atomic_fetch_add(p, v, __ATOMIC_RELAXED, __HIP_MEMORY_SCOPE_AGENT); }
__device__ __forceinline__ unsigned xb_xcc_id() { return (unsigned)__builtin_amdgcn_s_getreg((3 << 11) | 20) & 0xFu; }
#define XB_SPIN(cond, bar) do { unsigned _sp = 0; while (cond) { __builtin_amdgcn_s_sleep(1); \
    if ((++_sp & 255u) == 0u) { if (xb_ld(&(bar)[XB_TMO])) break; if (_sp > XB_SPIN_CAP) { atomicAdd(&(bar)[XB_TMO], 1u); break; } } } } while (0)

struct XcdBarrier {
    unsigned* bar; unsigned x;
    volatile LAS unsigned* st;
};

__device__ __forceinline__ XcdBarrier xcd_barrier_post(unsigned* bar, volatile LAS unsigned* st) {
    XcdBarrier b; b.bar = bar; b.x = xb_xcc_id(); b.st = st;
    if (threadIdx.x == 0) (void)xb_add(&bar[XB_XCNT(b.x)], 1u);
    return b;
}
__device__ __forceinline__ void xcd_barrier_complete(unsigned* bar, unsigned x, unsigned& nloc, unsigned& nx) {
    const unsigned G = gridDim.x * gridDim.y * gridDim.z;
    unsigned sum, cnt, mine, sp = 0u;
    for (;;) {
        sum = 0u; cnt = 0u; mine = 0u;
#pragma unroll
        for (unsigned j = 0; j < 16; ++j) { const unsigned c = xb_ld(&bar[XB_XCNT(j)]); sum += c; cnt += (c > 0u) ? 1u : 0u; mine = (j == x) ? c : mine; }
        if (sum == G) break;
        __builtin_amdgcn_s_sleep(1);
        if ((++sp & 255u) == 0u) { if (xb_ld(&bar[XB_TMO])) break; if (sp > XB_SPIN_CAP) { atomicAdd(&bar[XB_TMO], 1u); break; } }
    }
    nloc = mine > 0u ? mine : 1u; nx = cnt > 0u ? cnt : 1u;
}

__device__ __forceinline__ void xcd_barrier(const XcdBarrier& b) {
    asm volatile("s_waitcnt vmcnt(0)" ::: "memory");
    __syncthreads();
    if (threadIdx.x == 0) {
        unsigned* bar = b.bar;
        __builtin_amdgcn_s_waitcnt(0);
        unsigned nloc = b.st[0], nx = b.st[1];
        if (nloc == 0u) { xcd_barrier_complete(bar, b.x, nloc, nx); b.st[0] = nloc; b.st[1] = nx; }
        const unsigned old = xb_add(&bar[XB_XSUB(b.x)], 1u);
        const unsigned gen = old / nloc;
        if (old + 1u == (gen + 1u) * nloc) {
            __builtin_amdgcn_fence(__ATOMIC_RELEASE, "agent");
            asm volatile("s_waitcnt vmcnt(0)" ::: "memory");
            const unsigned og = xb_add(&bar[XB_TOP], 1u);
            const unsigned tg = og / nx;
            if (og + 1u == (tg + 1u) * nx) xb_add(&bar[XB_TOPGEN], 1u);
            else XB_SPIN(xb_ld(&bar[XB_TOPGEN]) == tg, bar);
            __builtin_amdgcn_fence(__ATOMIC_ACQUIRE, "agent");
            xb_add(&bar[XB_XGEN(b.x)], 1u);
            asm volatile("s_waitcnt vmcnt(0)" ::: "memory");
        } else {
            XB_SPIN(xb_ld(&bar[XB_XGEN(b.x)]) == gen, bar);
            __builtin_amdgcn_fence(__ATOMIC_ACQUIRE, "agent");
            asm volatile("s_waitcnt vmcnt(0)" ::: "memory");
        }
    }
    __syncthreads();
}

constexpr int NWAVES = 8;
constexpr int BATCH = 16, SEQ = 2048, DM = 1024, DEPTH = 2, DFF = 2816, NGU = 2 * DFF, NPROJ = 3328, RWKV_IN = 1792, NLORA = 1536, KLORA = 256;
constexpr int M = BATCH * SEQ;
constexpr int RET_OFF = RWKV_IN;
constexpr float LN_X_EPS = 64e-5f;
constexpr size_t MiB = 1u << 20;
constexpr size_t WS_CTL = 0, CTL_ZERO_BYTES = 1 * MiB;
constexpr size_t SZ_WGU = (size_t)NGU * DM * 2, SZ_WD = (size_t)DM * DFF * 2, SZ_WIN = (size_t)NPROJ * DM * 2, SZ_WLORA = (size_t)NLORA * KLORA * 2, SZ_WOUT = (size_t)DM * DM * 2;
constexpr size_t OFF_WGU1 = 0, OFF_WD1 = OFF_WGU1 + SZ_WGU, OFF_WIN = OFF_WD1 + SZ_WD, OFF_WLORA = OFF_WIN + SZ_WIN, OFF_WOUT = OFF_WLORA + SZ_WLORA, OFF_WGU2 = OFF_WOUT + SZ_WOUT, OFF_WD2 = OFF_WGU2 + SZ_WGU, SZ_LAYER = OFF_WD2 + SZ_WD;
constexpr size_t WS_W = 1 * MiB;
constexpr size_t WS_TRIG = WS_W + DEPTH * SZ_LAYER;
constexpr size_t WS_SSQ = 86 * MiB;
constexpr size_t WS_XB = 90 * MiB;
constexpr size_t WS_LORA = WS_XB;
constexpr size_t WS_MIXED = 218 * MiB;
constexpr size_t WS_H = 282 * MiB;
constexpr size_t WS_END = 490 * MiB;
static_assert(WS_TRIG + 2 * 2048 * 32 * 4 <= WS_SSQ && WS_SSQ + 2 * (size_t)M * 16 * 4 <= WS_XB && WS_LORA + (size_t)M * NLORA * 2 <= WS_MIXED && WS_H + (size_t)M * NPROJ * 2 <= WS_END, "d_ws map");
constexpr int CW_TMO = 0, CW_CODE = 1, CW_BAR = 4096;

constexpr int RING_OFF = 0, RING_BYTES = 131072;
constexpr int LDSCTL_OFF = RING_BYTES, MISC_OFF = LDSCTL_OFF + 320;
constexpr int LDS_BYTES = 147456;

struct Frame {
    LAS unsigned char* lds;
    volatile LAS unsigned* MISC;
    int tid, lane, wave;
    int vcu, G;
    unsigned char* ws;
};
struct LayerP {
    const float *mu, *w0, *a0, *k_k, *k_a, *r_k, *ln_w, *ln_b;
};
__device__ __forceinline__ float bf_lo(unsigned u) { return __builtin_bit_cast(float, u << 16); }
__device__ __forceinline__ float bf_hi(unsigned u) { return __builtin_bit_cast(float, u & 0xffff0000u); }
__device__ __forceinline__ unsigned cvtpk(float lo, float hi) { unsigned r; asm volatile("v_cvt_pk_bf16_f32 %0, %1, %2" : "=v"(r) : "v"(lo), "v"(hi)); return r; }
__device__ __forceinline__ float wave_sum(float v) {
#pragma unroll
    for (int o = 1; o < 64; o <<= 1) v += __shfl_xor(v, o);
    return v;
}
template <int CTRL> __device__ __forceinline__ float dpp_f(float v) { return __builtin_bit_cast(float, __builtin_amdgcn_update_dpp(0, __builtin_bit_cast(int, v), CTRL, 0xF, 0xF, true)); }
__device__ __forceinline__ float sum8(float v) { v += dpp_f<0xB1>(v); v += dpp_f<0x4E>(v); v += dpp_f<0x141>(v); return v; }
__device__ __forceinline__ float sum16(float v) { v = sum8(v); v += dpp_f<0x140>(v); return v; }
__device__ __forceinline__ float sigm(float x) { return __builtin_amdgcn_rcpf(1.0f + __expf(-x)); }

__device__ __forceinline__ void p0_transpose_item(const float* W, int K, int N, const float* gain, bf16* WT, int k0, int n0, int dst_row0, LAS float* scr, int lane) {
#pragma unroll 8
    for (int i = 0; i < 32; ++i) { const int kk = 2 * i + (lane >> 5); const float g = gain ? gain[k0 + kk] : 1.0f; scr[kk * 33 + (lane & 31)] = W[(size_t)(k0 + kk) * N + n0 + (lane & 31)] * g; }
    LDS_WAIT(); asm volatile("" ::: "memory");
    const int c = lane & 7;
#pragma unroll
    for (int j = 0; j < 4; ++j) { const int n = (lane >> 3) + 8 * j; const LAS float* s = scr + (8 * c) * 33 + n;
        v4u o; o.x = pk2(s[0 * 33], s[1 * 33]); o.y = pk2(s[2 * 33], s[3 * 33]); o.z = pk2(s[4 * 33], s[5 * 33]); o.w = pk2(s[6 * 33], s[7 * 33]);
        *(GAS v4u*)(WT + (size_t)(dst_row0 + n) * K + k0 + 8 * c) = o; }
    LDS_WAIT(); asm volatile("" ::: "memory");
}
struct Args { const float* in[24]; float* out; unsigned char* ws; int ph_lo, ph_hi; };
constexpr int ITEMS_FF = (DM / 64) * (DFF / 32), ITEMS_IN = (DM / 64) * (NPROJ / 32), ITEMS_OUT = (DM / 64) * (DM / 32);
constexpr int ITEMS_LAYER = 6 * ITEMS_FF + ITEMS_IN + ITEMS_OUT;
__device__ __forceinline__ void p0_prologue(const Frame& F, const Args& A) {
    LAS float* scr = (LAS float*)(F.lds + RING_OFF + F.wave * 16384);
    const int gw = F.vcu * NWAVES + F.wave, NGW = F.G * NWAVES;
    for (int it = gw; it < DEPTH * ITEMS_LAYER; it += NGW) {
        const int l = it / ITEMS_LAYER; int r = it % ITEMS_LAYER;
        bf16* wl = (bf16*)(F.ws + WS_W + (size_t)l * SZ_LAYER);
        const float* W; const float* gain = nullptr; bf16* WT; int K, N, mode = 0;
        if (r < ITEMS_FF)            { W = A.in[2] + (size_t)l * DM * DFF; gain = A.in[1] + l * DM; WT = (bf16*)((unsigned char*)wl + OFF_WGU1); K = DM; N = DFF; mode = 1; }
        else if ((r -= ITEMS_FF) < ITEMS_FF)  { W = A.in[3] + (size_t)l * DM * DFF; gain = A.in[1] + l * DM; WT = (bf16*)((unsigned char*)wl + OFF_WGU1); K = DM; N = DFF; mode = 2; }
        else if ((r -= ITEMS_FF) < ITEMS_FF)  { W = A.in[4] + (size_t)l * DFF * DM; WT = (bf16*)((unsigned char*)wl + OFF_WD1); K = DFF; N = DM; }
        else if ((r -= ITEMS_FF) < ITEMS_IN)  { W = A.in[6] + (size_t)l * DM * NPROJ; gain = A.in[5] + l * DM; WT = (bf16*)((unsigned char*)wl + OFF_WIN); K = DM; N = NPROJ; }
        else if ((r -= ITEMS_IN) < ITEMS_OUT) { W = A.in[18] + (size_t)l * DM * DM; WT = (bf16*)((unsigned char*)wl + OFF_WOUT); K = DM; N = DM; }
        else if ((r -= ITEMS_OUT) < ITEMS_FF) { W = A.in[20] + (size_t)l * DM * DFF; gain = A.in[19] + l * DM; WT = (bf16*)((unsigned char*)wl + OFF_WGU2); K = DM; N = DFF; mode = 1; }
        else if ((r -= ITEMS_FF) < ITEMS_FF)  { W = A.in[21] + (size_t)l * DM * DFF; gain = A.in[19] + l * DM; WT = (bf16*)((unsigned char*)wl + OFF_WGU2); K = DM; N = DFF; mode = 2; }
        else { r -= ITEMS_FF;                   W = A.in[22] + (size_t)l * DFF * DM; WT = (bf16*)((unsigned char*)wl + OFF_WD2); K = DFF; N = DM; }
        const int nblk = N / 32, kb = r / nblk, nb = r % nblk, k0 = 64 * kb, n0 = 32 * nb;
        const int dst = mode == 0 ? n0 : ((n0 >> 7) * 256 + (n0 & 127) + (mode == 2 ? 128 : 0));
        p0_transpose_item(W, K, N, gain, WT, k0, n0, dst, scr, F.lane);
    }
    const int gt = gw * 64 + F.lane, NGT = NGW * 64;
    for (int it = gt; it < DEPTH * NLORA * (KLORA / 8); it += NGT) {
        const int l = it / (NLORA * (KLORA / 8)), r = it % (NLORA * (KLORA / 8)), n = r >> 5, k8 = (r & 31) * 8;
        const int blk = n >> 9, nn = n & 511;
        const int klo = blk == 0 ? 0 : (blk == 1 ? 64 : 128), khi = blk == 0 ? 64 : (blk == 1 ? 128 : 256);
        const float* src = blk == 0 ? A.in[9] + (size_t)l * 64 * 512 : (blk == 1 ? A.in[11] + (size_t)l * 64 * 512 : A.in[12] + (size_t)l * 128 * 512);
        float v[8];
#pragma unroll
        for (int j = 0; j < 8; ++j) { const int k = k8 + j; v[j] = (k >= klo && k < khi) ? src[(size_t)(k - klo) * 512 + nn] : 0.0f; }
        v4u o; o.x = pk2(v[0], v[1]); o.y = pk2(v[2], v[3]); o.z = pk2(v[4], v[5]); o.w = pk2(v[6], v[7]);
        *(GAS v4u*)((bf16*)(F.ws + WS_W + (size_t)l * SZ_LAYER + OFF_WLORA) + (size_t)n * KLORA + k8) = o;
    }
    for (int it = gt; it < SEQ * 32; it += NGT) {
        const int pos = it >> 5, i = it & 31;
        const float x = (float)i * (1.0f / 31.0f);
        const float inv_freq = 1.0f / powf(10000.0f, x);
        const float ang = (float)pos * inv_freq;
        float sn, cs; sincosf(ang, &sn, &cs);
        ((float*)(F.ws + WS_TRIG))[it] = cs; ((float*)(F.ws + WS_TRIG))[SEQ * 32 + it] = sn;
    }
    const float* x = A.in[0]; float* out = A.out; bf16* xb = (bf16*)(F.ws + WS_XB); float* ssq = (float*)(F.ws + WS_SSQ);
    for (int m = gw; m < M; m += NGW) {
        const GAS f32x4* xr = (const GAS f32x4*)(x + (size_t)m * DM) + F.lane; GAS f32x4* orow = (GAS f32x4*)(out + (size_t)m * DM) + F.lane;
        GAS unsigned long long* o8 = (GAS unsigned long long*)(xb + (size_t)m * DM) + F.lane;
        float s = 0.f;
#pragma unroll
        for (int j = 0; j < 4; ++j) { const f32x4 v = xr[64 * j]; s += (v.x * v.x + v.y * v.y) + (v.z * v.z + v.w * v.w); orow[64 * j] = v;
            o8[64 * j] = (unsigned long long)pk2(v.x, v.y) | ((unsigned long long)pk2(v.z, v.w) << 32); }
        s = wave_sum(s);
        if (F.lane < 16) ssq[(size_t)m * 16 + F.lane] = (F.lane == 0) ? s : 0.0f;
    }
}
__device__ __forceinline__ void lora_prep(const Frame& F, const float* mu) {
    const bf16* proj = (const bf16*)(F.ws + WS_H); bf16* alora = (bf16*)(F.ws + WS_MIXED);
    const int gt = (F.vcu * NWAVES + F.wave) * 64 + F.lane, NGT = F.G * NWAVES * 64;
    for (int it = gt; it < M * 32; it += NGT) {
        const int m = it >> 5, c8 = (it & 31) * 8;
        const v4u pc = *(const GAS v4u*)(proj + (size_t)m * NPROJ + 1536 + c8);
        v4u pp = (v4u){0u, 0u, 0u, 0u};
        if ((m & (SEQ - 1)) != 0) pp = *(const GAS v4u*)(proj + (size_t)(m - 1) * NPROJ + 1536 + c8);
        const f32x4 m0 = *(const f32x4*)(mu + 1536 + c8), m1 = *(const f32x4*)(mu + 1536 + c8 + 4);
        float v[8];
#pragma unroll
        for (int j = 0; j < 4; ++j) { const unsigned a = pc[j], b = pp[j]; const float ml = j < 2 ? m0[2 * j] : m1[2 * j - 4], mh = j < 2 ? m0[2 * j + 1] : m1[2 * j - 3];
            const float cl = bf_lo(a), ch = bf_hi(a), pl = bf_lo(b), ph = bf_hi(b);
            v[2 * j] = cl + ml * (pl - cl); v[2 * j + 1] = ch + mh * (ph - ch); }
        if (c8 < 64) {
#pragma unroll
            for (int j = 0; j < 8; ++j) v[j] = 1.0f - 2.0f * __builtin_amdgcn_rcpf(1.0f + __expf(2.0f * v[j]));
        } else if (c8 >= 128) {
#pragma unroll
            for (int j = 0; j < 8; ++j) v[j] = sigm(v[j]);
        }
        v4u o; o.x = cvtpk(v[0], v[1]); o.y = cvtpk(v[2], v[3]); o.z = cvtpk(v[4], v[5]); o.w = cvtpk(v[6], v[7]);
        *(GAS v4u*)(alora + (size_t)m * KLORA + c8) = o;
    }
}
constexpr int RW_CT = 32, RW_BUF = 6 * RW_CT * 64;
__device__ __forceinline__ void rwkv_prep(const Frame& F, const LayerP& L, int b, int h, int c, LAS float* buf, LAS float* rk) {
    const int tt = F.tid >> 4, kq = F.tid & 15, k = kq * 4, t = c * RW_CT + tt, ch = h * 64 + k;
    const size_t m = (size_t)b * SEQ + t;
    const bf16* P = (const bf16*)(F.ws + WS_H) + m * NPROJ;
    typedef unsigned u2 __attribute__((ext_vector_type(2)));
    const u2 rc = *(const GAS u2*)(P + ch), kc_ = *(const GAS u2*)(P + 512 + ch), vc = *(const GAS u2*)(P + 1024 + ch);
    u2 rp = (u2){0u, 0u}, kp = rp, vp = rp;
    if (t > 0) { rp = *(const GAS u2*)(P - NPROJ + ch); kp = *(const GAS u2*)(P - NPROJ + 512 + ch); vp = *(const GAS u2*)(P - NPROJ + 1024 + ch); }
    const f32x4 mur = *(const f32x4*)(L.mu + ch), muk = *(const f32x4*)(L.mu + 512 + ch), muv = *(const f32x4*)(L.mu + 1024 + ch);
    const u2 dc = *(const GAS u2*)((const bf16*)(F.ws + WS_LORA) + m * NLORA + ch);
    const u2 ac = *(const GAS u2*)((const bf16*)(F.ws + WS_LORA) + m * NLORA + 512 + ch);
    const f32x4 w0p = *(const f32x4*)(L.w0 + ch), a0p = *(const f32x4*)(L.a0 + ch);
    const f32x4 kkp = *(const f32x4*)(L.k_k + ch), kap = *(const f32x4*)(L.k_a + ch), rkp = *(const f32x4*)(L.r_k + ch);
    f32x4 r, kk_, v, a;
    r[0] = bf_lo(rc[0]); r[1] = bf_hi(rc[0]); r[2] = bf_lo(rc[1]); r[3] = bf_hi(rc[1]);
    kk_[0] = bf_lo(kc_[0]); kk_[1] = bf_hi(kc_[0]); kk_[2] = bf_lo(kc_[1]); kk_[3] = bf_hi(kc_[1]);
    v[0] = bf_lo(vc[0]); v[1] = bf_hi(vc[0]); v[2] = bf_lo(vc[1]); v[3] = bf_hi(vc[1]);
    a[0] = sigm(a0p[0] + bf_lo(ac[0])); a[1] = sigm(a0p[1] + bf_hi(ac[0])); a[2] = sigm(a0p[2] + bf_lo(ac[1])); a[3] = sigm(a0p[3] + bf_hi(ac[1]));
    f32x4 rq, kq4, vq;
    rq[0] = bf_lo(rp[0]); rq[1] = bf_hi(rp[0]); rq[2] = bf_lo(rp[1]); rq[3] = bf_hi(rp[1]);
    kq4[0] = bf_lo(kp[0]); kq4[1] = bf_hi(kp[0]); kq4[2] = bf_lo(kp[1]); kq4[3] = bf_hi(kp[1]);
    vq[0] = bf_lo(vp[0]); vq[1] = bf_hi(vp[0]); vq[2] = bf_lo(vp[1]); vq[3] = bf_hi(vp[1]);
    r = r + mur * (rq - r); kk_ = kk_ + muk * (kq4 - kk_); v = v + muv * (vq - v);
    f32x4 dec;
    dec[0] = __expf(-0.6065306597126334f * sigm(w0p[0] + bf_lo(dc[0]))); dec[1] = __expf(-0.6065306597126334f * sigm(w0p[1] + bf_hi(dc[0])));
    dec[2] = __expf(-0.6065306597126334f * sigm(w0p[2] + bf_lo(dc[1]))); dec[3] = __expf(-0.6065306597126334f * sigm(w0p[3] + bf_hi(dc[1])));
    const f32x4 kraw = kk_ * kkp;
    float ss = (kraw[0] * kraw[0] + kraw[1] * kraw[1]) + (kraw[2] * kraw[2] + kraw[3] * kraw[3]);
    ss = sum16(ss);
    const float inv = 1.0f / sqrtf(fmaxf(ss, 1e-24f));
    const f32x4 kn = kraw * inv;
    const f32x4 kh = kk_ * (1.0f + (a - 1.0f) * kap);
    const f32x4 bb = kn * a;
    float bs = (r[0] * kh[0] * rkp[0] + r[1] * kh[1] * rkp[1]) + (r[2] * kh[2] * rkp[2] + r[3] * kh[3] * rkp[3]);
    bs = sum16(bs);
    LAS float* q = buf + tt * 64 + k;
    *(LAS f32x4*)(q + 0 * RW_CT * 64) = r; *(LAS f32x4*)(q + 1 * RW_CT * 64) = dec; *(LAS f32x4*)(q + 2 * RW_CT * 64) = kh;
    *(LAS f32x4*)(q + 3 * RW_CT * 64) = -kn; *(LAS f32x4*)(q + 4 * RW_CT * 64) = bb; *(LAS f32x4*)(q + 5 * RW_CT * 64) = v;
    if (kq == 0) rk[tt] = bs;
}
__device__ __forceinline__ void rwkv_unit(const Frame& F, const LayerP& L, int unit) {
    const int b = unit >> 3, h = unit & 7;
    LAS float* lds = (LAS float*)(F.lds + RING_OFF);
    LAS float* YB = lds + 2 * RW_BUF;
    LAS float* RK = YB + RW_CT * 64;
    const int row = F.tid >> 3, kc = F.tid & 7, k0 = kc * 8;
    const int ett = F.tid >> 4, erq = (F.tid & 15) * 4;
    float S[8];
#pragma unroll
    for (int j = 0; j < 8; ++j) S[j] = 0.f;
    const f32x4 lnw = *(const f32x4*)(L.ln_w + h * 64 + erq), lnb = *(const f32x4*)(L.ln_b + h * 64 + erq);
    rwkv_prep(F, L, b, h, 0, lds, RK);
    __syncthreads();
    for (int c = 0; c < SEQ / RW_CT; ++c) {
        LAS float* buf = lds + (c & 1) * RW_BUF;
        if (c + 1 < SEQ / RW_CT) rwkv_prep(F, L, b, h, c + 1, lds + ((c + 1) & 1) * RW_BUF, RK + ((c + 1) & 1) * RW_CT);
#pragma unroll 2
        for (int tt = 0; tt < RW_CT; ++tt) {
            const LAS float* q = buf + tt * 64 + k0;
            const f32x4 a0 = *(const LAS f32x4*)(q + 3 * RW_CT * 64), a1 = *(const LAS f32x4*)(q + 3 * RW_CT * 64 + 4);
            const f32x4 w0 = *(const LAS f32x4*)(q + 1 * RW_CT * 64), w1 = *(const LAS f32x4*)(q + 1 * RW_CT * 64 + 4);
            const f32x4 b0 = *(const LAS f32x4*)(q + 4 * RW_CT * 64), b1 = *(const LAS f32x4*)(q + 4 * RW_CT * 64 + 4);
            const f32x4 e0 = *(const LAS f32x4*)(q + 2 * RW_CT * 64), e1 = *(const LAS f32x4*)(q + 2 * RW_CT * 64 + 4);
            const f32x4 r0 = *(const LAS f32x4*)(q + 0 * RW_CT * 64), r1 = *(const LAS f32x4*)(q + 0 * RW_CT * 64 + 4);
            const float vv = buf[5 * RW_CT * 64 + tt * 64 + row];
            float sa = (S[0] * a0[0] + S[1] * a0[1]) + (S[2] * a0[2] + S[3] * a0[3]) + ((S[4] * a1[0] + S[5] * a1[1]) + (S[6] * a1[2] + S[7] * a1[3]));
            sa = sum8(sa);
#pragma unroll
            for (int j = 0; j < 4; ++j) { S[j] = S[j] * w0[j] + (sa * b0[j] + vv * e0[j]); S[4 + j] = S[4 + j] * w1[j] + (sa * b1[j] + vv * e1[j]); }
            float y = (S[0] * r0[0] + S[1] * r0[1]) + (S[2] * r0[2] + S[3] * r0[3]) + ((S[4] * r1[0] + S[5] * r1[1]) + (S[6] * r1[2] + S[7] * r1[3]));
            y = sum8(y);
            if (kc == 0) YB[tt * 64 + row] = y;
        }
        __syncthreads();
        {
            const size_t m = (size_t)b * SEQ + c * RW_CT + ett;
            const f32x4 y4 = *(const LAS f32x4*)(YB + ett * 64 + erq);
            const float mean = sum16((y4[0] + y4[1]) + (y4[2] + y4[3])) * (1.0f / 64.0f);
            const f32x4 d = y4 - mean;
            const float var = sum16((d[0] * d[0] + d[1] * d[1]) + (d[2] * d[2] + d[3] * d[3])) * (1.0f / 64.0f);
            const float rstd = 1.0f / sqrtf(var + LN_X_EPS);
            const f32x4 v4 = *(const LAS f32x4*)(buf + 5 * RW_CT * 64 + ett * 64 + erq);
            const float bonus = RK[(c & 1) * RW_CT + ett];
            typedef unsigned u2 __attribute__((ext_vector_type(2)));
            const u2 gc = *(const GAS u2*)((const bf16*)(F.ws + WS_LORA) + m * NLORA + 1024 + h * 64 + erq);
            f32x4 g; g[0] = bf_lo(gc[0]); g[1] = bf_hi(gc[0]); g[2] = bf_lo(gc[1]); g[3] = bf_hi(gc[1]);
            const f32x4 o = (d * rstd * lnw + lnb + v4 * bonus) * g;
            u2 w; w[0] = cvtpk(o[0], o[1]); w[1] = cvtpk(o[2], o[3]);
            *(GAS u2*)((bf16*)(F.ws + WS_MIXED) + m * DM + h * 64 + erq) = w;
        }
        __syncthreads();
    }
}
constexpr int RT_LD = 72;
constexpr int RT_QS = 0, RT_KS = RT_QS + 64 * RT_LD * 2, RT_KT = RT_KS + 64 * RT_LD * 2, RT_SC = RT_KT + 64 * RT_LD * 2, RT_VT = RT_SC + 64 * RT_LD * 2, RT_PT = RT_VT + 128 * RT_LD * 2,
              RT_OB = RT_PT + 128 * RT_LD * 2, RT_OLD = 132, RT_GP = RT_OB + 64 * RT_OLD * 4, RT_END = RT_GP + 80 * 4;
static_assert(RT_END <= RING_BYTES, "retention LDS");
__device__ __forceinline__ void ret_unit(const Frame& F, int unit) {
    const int b = unit >> 2, h = unit & 3;
    LAS unsigned char* lds = F.lds + RING_OFF;
    LAS bf16* QS = (LAS bf16*)(lds + RT_QS); LAS bf16* KS = (LAS bf16*)(lds + RT_KS); LAS bf16* KT = (LAS bf16*)(lds + RT_KT); LAS bf16* SC = (LAS bf16*)(lds + RT_SC);
    LAS bf16* VT = (LAS bf16*)(lds + RT_VT); LAS bf16* PT = (LAS bf16*)(lds + RT_PT); LAS float* OB = (LAS float*)(lds + RT_OB); LAS float* GP = (LAS float*)(lds + RT_GP);
    const int tid = F.tid, lane = F.lane, w = F.wave, lr = lane & 15, lq = lane >> 4;
    const float gamma = 1.0f - exp2f(-5.0f - (float)h), lg = log2f(gamma);
    if (tid < 80) GP[tid] = exp2f((float)tid * lg);
    for (int i = tid; i < 128 * RT_LD / 2; i += NWAVES * 64) ((LAS unsigned*)PT)[i] = 0u;
    __syncthreads();
    const float g64 = GP[64];
    f32x4 accP[4];
#pragma unroll
    for (int q = 0; q < 4; ++q) accP[q] = (f32x4){0.f, 0.f, 0.f, 0.f};
    const bf16* proj = (const bf16*)(F.ws + WS_H);
    const float* COS = (const float*)(F.ws + WS_TRIG); const float* SIN = COS + SEQ * 32;
    typedef unsigned u2 __attribute__((ext_vector_type(2)));
    for (int n = 0; n < SEQ / 64; ++n) {
        {
            const int i = tid >> 3, dq = tid & 7, d = dq * 4, pos = n * 64 + i; const size_t m = (size_t)b * SEQ + pos;
            const bf16* P = proj + m * NPROJ + RET_OFF;
            const f32x4 cs = *(const GAS f32x4*)(COS + pos * 32 + d), sn = *(const GAS f32x4*)(SIN + pos * 32 + d);
            const u2 q1 = *(const GAS u2*)(P + h * 64 + d), q2 = *(const GAS u2*)(P + h * 64 + 32 + d);
            const u2 k1 = *(const GAS u2*)(P + 256 + h * 64 + d), k2 = *(const GAS u2*)(P + 256 + h * 64 + 32 + d);
            f32x4 x1, x2;
            x1[0] = bf_lo(q1[0]); x1[1] = bf_hi(q1[0]); x1[2] = bf_lo(q1[1]); x1[3] = bf_hi(q1[1]);
            x2[0] = bf_lo(q2[0]); x2[1] = bf_hi(q2[0]); x2[2] = bf_lo(q2[1]); x2[3] = bf_hi(q2[1]);
            f32x4 o1 = x1 * cs - x2 * sn, o2 = x1 * sn + x2 * cs;
            u2 wv; wv[0] = cvtpk(o1[0], o1[1]); wv[1] = cvtpk(o1[2], o1[3]); *(LAS u2*)(QS + i * RT_LD + d) = wv;
            wv[0] = cvtpk(o2[0], o2[1]); wv[1] = cvtpk(o2[2], o2[3]); *(LAS u2*)(QS + i * RT_LD + 32 + d) = wv;
            x1[0] = bf_lo(k1[0]); x1[1] = bf_hi(k1[0]); x1[2] = bf_lo(k1[1]); x1[3] = bf_hi(k1[1]);
            x2[0] = bf_lo(k2[0]); x2[1] = bf_hi(k2[0]); x2[2] = bf_lo(k2[1]); x2[3] = bf_hi(k2[1]);
            o1 = (x1 * cs - x2 * sn) * 0.125f; o2 = (x1 * sn + x2 * cs) * 0.125f;
            wv[0] = cvtpk(o1[0], o1[1]); wv[1] = cvtpk(o1[2], o1[3]); *(LAS u2*)(KS + i * RT_LD + d) = wv;
            wv[0] = cvtpk(o2[0], o2[1]); wv[1] = cvtpk(o2[2], o2[3]); *(LAS u2*)(KS + i * RT_LD + 32 + d) = wv;
            const float kw = GP[63 - i];
#pragma unroll
            for (int ii = 0; ii < 4; ++ii) { KT[(d + ii) * RT_LD + i] = (bf16)f2bf(o1[ii] * kw); KT[(32 + d + ii) * RT_LD + i] = (bf16)f2bf(o2[ii] * kw); }
            const int e0 = dq * 16;
            const v4u va = *(const GAS v4u*)(P + 512 + h * 128 + e0), vb = *(const GAS v4u*)(P + 512 + h * 128 + e0 + 8);
#pragma unroll
            for (int ii = 0; ii < 4; ++ii) { VT[(e0 + 2 * ii) * RT_LD + i] = (bf16)(va[ii] & 0xffffu); VT[(e0 + 2 * ii + 1) * RT_LD + i] = (bf16)(va[ii] >> 16);
                VT[(e0 + 8 + 2 * ii) * RT_LD + i] = (bf16)(vb[ii] & 0xffffu); VT[(e0 + 9 + 2 * ii) * RT_LD + i] = (bf16)(vb[ii] >> 16); }
        }
        __syncthreads();
        {
            const int ti = w >> 1;
            const bf16x8 a0 = *(const LAS bf16x8*)(QS + (16 * ti + lr) * RT_LD + 8 * lq), a1 = *(const LAS bf16x8*)(QS + (16 * ti + lr) * RT_LD + 32 + 8 * lq);
#pragma unroll
            for (int q = 0; q < 2; ++q) { const int tj = (w & 1) * 2 + q;
                const bf16x8 b0 = *(const LAS bf16x8*)(KS + (16 * tj + lr) * RT_LD + 8 * lq), b1 = *(const LAS bf16x8*)(KS + (16 * tj + lr) * RT_LD + 32 + 8 * lq);
                f32x4 acc = (f32x4){0.f, 0.f, 0.f, 0.f};
                acc = __builtin_amdgcn_mfma_f32_16x16x32_bf16(a0, b0, acc, 0, 0, 0); acc = __builtin_amdgcn_mfma_f32_16x16x32_bf16(a1, b1, acc, 0, 0, 0);
#pragma unroll
                for (int rg = 0; rg < 4; ++rg) { const int i = 16 * ti + 4 * lq + rg, j = 16 * tj + lr; const int dd = i > j ? i - j : j - i;
                    SC[i * RT_LD + j] = (bf16)f2bf(acc[rg] * GP[dd]); } }
        }
        __syncthreads();
        {
            const int ti = w >> 1;
            const bf16x8 s0 = *(const LAS bf16x8*)(SC + (16 * ti + lr) * RT_LD + 8 * lq), s1 = *(const LAS bf16x8*)(SC + (16 * ti + lr) * RT_LD + 32 + 8 * lq);
            const bf16x8 q0 = *(const LAS bf16x8*)(QS + (16 * ti + lr) * RT_LD + 8 * lq), q1 = *(const LAS bf16x8*)(QS + (16 * ti + lr) * RT_LD + 32 + 8 * lq);
            const bf16x8 c0 = *(const LAS bf16x8*)(KT + (16 * ti + lr) * RT_LD + 8 * lq), c1 = *(const LAS bf16x8*)(KT + (16 * ti + lr) * RT_LD + 32 + 8 * lq);
#pragma unroll
            for (int q = 0; q < 4; ++q) { const int te = (w & 1) * 4 + q;
                const bf16x8 v0 = *(const LAS bf16x8*)(VT + (16 * te + lr) * RT_LD + 8 * lq), v1 = *(const LAS bf16x8*)(VT + (16 * te + lr) * RT_LD + 32 + 8 * lq);
                const bf16x8 p0 = *(const LAS bf16x8*)(PT + (16 * te + lr) * RT_LD + 8 * lq), p1 = *(const LAS bf16x8*)(PT + (16 * te + lr) * RT_LD + 32 + 8 * lq);
                f32x4 ai = (f32x4){0.f, 0.f, 0.f, 0.f}, ax = ai;
                ai = __builtin_amdgcn_mfma_f32_16x16x32_bf16(s0, v0, ai, 0, 0, 0); ai = __builtin_amdgcn_mfma_f32_16x16x32_bf16(s1, v1, ai, 0, 0, 0);
                ax = __builtin_amdgcn_mfma_f32_16x16x32_bf16(q0, p0, ax, 0, 0, 0); ax = __builtin_amdgcn_mfma_f32_16x16x32_bf16(q1, p1, ax, 0, 0, 0);
#pragma unroll
                for (int rg = 0; rg < 4; ++rg) { const int i = 16 * ti + 4 * lq + rg; OB[i * RT_OLD + 16 * te + lr] = ai[rg] + GP[i + 1] * ax[rg]; }
                accP[q] = accP[q] * g64;
                accP[q] = __builtin_amdgcn_mfma_f32_16x16x32_bf16(c0, v0, accP[q], 0, 0, 0); accP[q] = __builtin_amdgcn_mfma_f32_16x16x32_bf16(c1, v1, accP[q], 0, 0, 0); }
        }
        __syncthreads();
        {
#pragma unroll
            for (int q = 0; q < 4; ++q) { const int te = (w & 1) * 4 + q, td = w >> 1; u2 wv; wv[0] = cvtpk(accP[q][0], accP[q][1]); wv[1] = cvtpk(accP[q][2], accP[q][3]);
                *(LAS u2*)(PT + (16 * te + lr) * RT_LD + 16 * td + 4 * lq) = wv; }
            const int i = tid >> 3, e0 = (tid & 7) * 16; const size_t m = (size_t)b * SEQ + n * 64 + i;
            f32x4 o[4]; float ss = 0.f;
#pragma unroll
            for (int j = 0; j < 4; ++j) { o[j] = *(const LAS f32x4*)(OB + i * RT_OLD + e0 + 4 * j); ss += (o[j][0] * o[j][0] + o[j][1] * o[j][1]) + (o[j][2] * o[j][2] + o[j][3] * o[j][3]); }
            ss = sum8(ss);
            const float rstd = 1.0f / sqrtf(ss * (1.0f / 128.0f) + 1e-6f);
            const bf16* P = proj + m * NPROJ + RET_OFF + 1024 + h * 128 + e0;
            const v4u ga = *(const GAS v4u*)P, gb = *(const GAS v4u*)(P + 8);
            v4u oa, ob;
#pragma unroll
            for (int j = 0; j < 4; ++j) {
                const float g0 = bf_lo(ga[j]), g1 = bf_hi(ga[j]), g2 = bf_lo(gb[j]), g3 = bf_hi(gb[j]);
                const float x0 = o[j >> 1][(2 * j) & 3], x1 = o[j >> 1][(2 * j + 1) & 3], x2 = o[2 + (j >> 1)][(2 * j) & 3], x3 = o[2 + (j >> 1)][(2 * j + 1) & 3];
                oa[j] = cvtpk(x0 * rstd * g0 * sigm(g0), x1 * rstd * g1 * sigm(g1)); ob[j] = cvtpk(x2 * rstd * g2 * sigm(g2), x3 * rstd * g3 * sigm(g3)); }
            bf16* O = (bf16*)(F.ws + WS_MIXED) + m * DM + 512 + h * 128 + e0;
            *(GAS v4u*)O = oa; *(GAS v4u*)(O + 8) = ob;
        }
    }
    __syncthreads();
}
constexpr int PH_PER_LAYER = 9, PH_FINAL = 1 + DEPTH * PH_PER_LAYER, N_PHASES = PH_FINAL + 1;
__global__ void __launch_bounds__(NWAVES * 64, 2) mk_fwd(Args args) {
    extern __shared__ __attribute__((aligned(16))) unsigned char lds[];
    Frame F;
    F.lds = (LAS unsigned char*)lds;
    F.MISC = (volatile LAS unsigned*)(F.lds + MISC_OFF);
    F.tid = threadIdx.x; F.lane = F.tid & 63; F.wave = __builtin_amdgcn_readfirstlane(F.tid >> 6);
    F.G = gridDim.x; { const int bx = blockIdx.x; F.vcu = (F.G % 8 == 0) ? (bx % 8) * (F.G / 8) + bx / 8 : bx; }
    F.ws = args.ws;
    gu32* ctl = (gu32*)(F.ws + WS_CTL);
    for (int u = F.tid; u < (LDS_BYTES - LDSCTL_OFF) / 4; u += NWAVES * 64) ((LAS unsigned*)(F.lds + LDSCTL_OFF))[u] = 0u;
    __syncthreads();
    const int lo = args.ph_lo, hi = args.ph_hi;
    XcdBarrier bar; bar.bar = (unsigned*)(ctl + CW_BAR); bar.x = 0; bar.st = nullptr;
    if (hi - lo > 1) bar = xcd_barrier_post((unsigned*)(ctl + CW_BAR), F.MISC + 8);
#define IN(k) (lo <= (k) && (k) < hi)
#define PHASE_ENTER() do { int t_ = threadIdx.x; asm volatile("" : "+v"(t_)); F.tid = t_; F.lane = t_ & 63; } while (0)
#define SEAM(k) do { if (IN(k) && IN((k) + 1)) xcd_barrier(bar); } while (0)
    bf16* XB = (bf16*)(F.ws + WS_XB); bf16* HB = (bf16*)(F.ws + WS_H); bf16* PROJ = (bf16*)(F.ws + WS_H); bf16* MIXED = (bf16*)(F.ws + WS_MIXED); bf16* ALORA = (bf16*)(F.ws + WS_MIXED);
    float* SSQ = (float*)(F.ws + WS_SSQ);
    if (IN(0)) { PHASE_ENTER(); p0_prologue(F, args); SEAM(0); }
    for (int l = 0; l < DEPTH; ++l) {
        const int pb = 1 + PH_PER_LAYER * l;
        const unsigned char* wl = F.ws + WS_W + (size_t)l * SZ_LAYER;
        float* ssq_in = SSQ + (size_t)(l & 1) * M * 16; float* ssq_a = SSQ + (size_t)((l + 1) & 1) * M * 16; float* ssq_b = ssq_in; float* ssq_c = ssq_a;
        LayerP L; L.mu = args.in[7] + l * RWKV_IN; L.w0 = args.in[8] + l * 512; L.a0 = args.in[10] + l * 512; L.k_k = args.in[13] + l * 512; L.k_a = args.in[14] + l * 512;
        L.r_k = args.in[15] + l * 512; L.ln_w = args.in[16] + l * 512; L.ln_b = args.in[17] + l * 512;
        if (IN(pb + 0)) {
            pg8::Gemm g{XB, (const bf16*)(wl + OFF_WGU1), M, NGU, DM}; pg8::StaticOrder S; S.init(M, NGU, F.G, (int)blockIdx.x);
            pg8::EpiSwiglu E{HB, DFF, ssq_in};
            pg8::gemm_phase<pg8::EpiSwiglu, pg8::StaticOrder, true, true>(F.lds + RING_OFF, g, S, E);
            SEAM(pb + 0);
        }
        if (IN(pb + 1)) {
            pg8::Gemm g{HB, (const bf16*)(wl + OFF_WD1), M, DM, DFF}; pg8::StaticOrder S; S.init(M, DM, F.G, (int)blockIdx.x);
            pg8::EpiResid E{args.out, XB, ssq_a, 0.5f};
            pg8::gemm_phase<pg8::EpiResid, pg8::StaticOrder, true, true>(F.lds + RING_OFF, g, S, E);
            SEAM(pb + 1);
        }
        if (IN(pb + 2)) {
            pg8::Gemm g{XB, (const bf16*)(wl + OFF_WIN), M, NPROJ, DM}; pg8::StaticOrder S; S.init(M, NPROJ, F.G, (int)blockIdx.x);
            pg8::EpiProj<true> E{PROJ, NPROJ, ssq_a};
            pg8::gemm_phase<pg8::EpiProj<true>, pg8::StaticOrder, true, true>(F.lds + RING_OFF, g, S, E);
            SEAM(pb + 2);
        }
        if (IN(pb + 3)) { PHASE_ENTER(); lora_prep(F, L.mu); SEAM(pb + 3); }
        if (IN(pb + 4)) {
            int klora = KLORA; asm volatile("" : "+s"(klora));
            pg8::Gemm g{ALORA, (const bf16*)(wl + OFF_WLORA), M, NLORA, klora}; pg8::StaticOrder S; S.init(M, NLORA, F.G, (int)blockIdx.x);
            pg8::EpiProj<false> E{(bf16*)(F.ws + WS_LORA), NLORA, nullptr};
            pg8::gemm_phase<pg8::EpiProj<false>, pg8::StaticOrder, true, true>(F.lds + RING_OFF, g, S, E);
            SEAM(pb + 4);
        }
        if (IN(pb + 5)) {
            PHASE_ENTER();
            for (int u = F.vcu; u < 192; u += F.G) { if (u < 128) rwkv_unit(F, L, u); else ret_unit(F, u - 128); }
            SEAM(pb + 5);
        }
        if (IN(pb + 6)) {
            pg8::Gemm g{MIXED, (const bf16*)(wl + OFF_WOUT), M, DM, DM}; pg8::StaticOrder S; S.init(M, DM, F.G, (int)blockIdx.x);
            pg8::EpiResid E{args.out, XB, ssq_b, 1.0f};
            pg8::gemm_phase<pg8::EpiResid, pg8::StaticOrder, true, true>(F.lds + RING_OFF, g, S, E);
            SEAM(pb + 6);
        }
        if (IN(pb + 7)) {
            pg8::Gemm g{XB, (const bf16*)(wl + OFF_WGU2), M, NGU, DM}; pg8::StaticOrder S; S.init(M, NGU, F.G, (int)blockIdx.x);
            pg8::EpiSwiglu E{HB, DFF, ssq_b};
            pg8::gemm_phase<pg8::EpiSwiglu, pg8::StaticOrder, true, true>(F.lds + RING_OFF, g, S, E);
            SEAM(pb + 7);
        }
        if (IN(pb + 8)) {
            pg8::Gemm g{HB, (const bf16*)(wl + OFF_WD2), M, DM, DFF}; pg8::StaticOrder S; S.init(M, DM, F.G, (int)blockIdx.x);
            pg8::EpiResid E{args.out, XB, ssq_c, 0.5f};
            pg8::gemm_phase<pg8::EpiResid, pg8::StaticOrder, true, true>(F.lds + RING_OFF, g, S, E);
            SEAM(pb + 8);
        }
    }
    if (IN(PH_FINAL)) {
        PHASE_ENTER();
        const float* ssq = SSQ + (size_t)(DEPTH & 1) * M * 16; const float* gain = args.in[23];
        const unsigned tmo = __hip_atomic_load(ctl + CW_BAR + XB_TMO, RLX_AGENT);
        const int gw = F.vcu * NWAVES + F.wave, NGW = F.G * NWAVES;
        f32x4 gv[4];
#pragma unroll
        for (int j = 0; j < 4; ++j) gv[j] = *((const f32x4*)gain + F.lane + 64 * j);
        for (int m = gw; m < M; m += NGW) {
            const float rs = pg8::row_rstd(ssq, m) * (tmo ? __builtin_nanf("") : 1.0f);
            GAS f32x4* xr = (GAS f32x4*)(args.out + (size_t)m * DM) + F.lane;
#pragma unroll
            for (int j = 0; j < 4; ++j) { const f32x4 v = xr[64 * j]; xr[64 * j] = v * rs * gv[j]; }
        }
    }
#undef IN
#undef SEAM
}

#ifndef MK_PER_PHASE
#define MK_PER_PHASE 1
#endif
extern "C" void kernel_launch(void* const* d_in, const int* in_sizes, int n_in, void* d_out, int out_size, void* d_ws, size_t ws_size, hipStream_t stream) {
    static int grid = 0;
    if (grid == 0) {
        if (n_in != 24 || in_sizes[0] != M * DM || out_size != M * DM || ws_size < WS_END) { fprintf(stderr, "kernel_launch: unexpected shapes (n_in %d, in0 %d, out %d, ws %zu); nothing launched\n", n_in, n_in > 0 ? in_sizes[0] : -1, out_size, ws_size); grid = -1; return; }
        int dev = 0, cus = 0, per_cu = 0;
        if (hipGetDevice(&dev) != hipSuccess || hipDeviceGetAttribute(&cus, hipDeviceAttributeMultiprocessorCount, dev) != hipSuccess) { grid = -1; return; }
        if (hipFuncSetAttribute((const void*)mk_fwd, hipFuncAttributeMaxDynamicSharedMemorySize, LDS_BYTES) != hipSuccess) { fprintf(stderr, "kernel_launch: hipFuncSetAttribute failed\n"); grid = -1; return; }
        if (hipOccupancyMaxActiveBlocksPerMultiprocessor(&per_cu, (const void*)mk_fwd, NWAVES * 64, LDS_BYTES) != hipSuccess || per_cu < 1)
            fprintf(stderr, "kernel_launch: note: occupancy query reports %d workgroups per CU\n", per_cu);
        (void)hipGetLastError();
        grid = cus;
    }
    if (grid < 0) return;
    if (hipMemsetAsync((char*)d_ws + WS_CTL, 0, CTL_ZERO_BYTES, stream) != hipSuccess) return;
    Args a{};
    for (int i = 0; i < 24; ++i) a.in[i] = (const float*)d_in[i];
    a.out = (float*)d_out; a.ws = (unsigned char*)d_ws;
#if MK_PER_PHASE
    for (int p = 0; p < N_PHASES; ++p) { a.ph_lo = p; a.ph_hi = p + 1; hipLaunchKernelGGL(mk_fwd, dim3(grid), dim3(NWAVES * 64), LDS_BYTES, stream, a); }
#else
    a.ph_lo = 0; a.ph_hi = N_PHASES;
    hipLaunchKernelGGL(mk_fwd, dim3(grid), dim3(NWAVES * 64), LDS_BYTES, stream, a);
#endif
}
```

```cpp
#include <hip/hip_runtime.h>
#include <cstdio>
#include <cstdint>
#include <cmath>
namespace pg8 {
#define PG8_LAS __attribute__((address_space(3)))
typedef unsigned short bf16_t;
typedef short bf16x8 __attribute__((ext_vector_type(8)));
typedef float f32x4 __attribute__((ext_vector_type(4)));
typedef unsigned u32x4 __attribute__((ext_vector_type(4)));
constexpr int BM = 256, BK = 64, HALF = 128, HTB = HALF * BK * 2  , STAGE_BYTES = 8 * HTB, NXCD = 8, WGM = 8;

__host__ __device__ __forceinline__ int lds_byte(int r, int c) { const int st = (r >> 4) * 2 + (c >> 5), rr = r & 15, cc = c & 31, ob = rr * 64 + cc * 2; return st * 1024 + (ob ^ (((ob >> 9) & 1) << 5)); }
__host__ __device__ __forceinline__ void stage_rc(int b, int& R, int& C) { const int st = b / 1024, sb = b % 1024, swz = sb ^ (((sb >> 9) & 1) << 5); R = (st >> 1) * 16 + swz / 64; C = (st & 1) * 32 + (swz % 64) / 2; }
__host__ __device__ __forceinline__ int perm32(int rho) { const int n = rho >> 4, i = rho & 15; return 8 * (i >> 2) + 4 * n + (i & 3); }

struct Unit { int pm, pn; };
struct Gemm { const bf16_t* A; const bf16_t* Bt; int M, N, K; unsigned apad; };

struct StaticOrder {
    int nM, nN, nwg, G, c;
    __host__ __device__ void init(int M, int N, int G_, int c_) { nM = M / BM; nN = N / BM; nwg = nM * nN; G = G_; c = c_; }
    __host__ __device__ bool next(int i, Unit& u) const {
        const long L = (long)i * G + c; if (L >= nwg) return false;
        int wgid = (int)L; { const int q = nwg / NXCD, r = nwg % NXCD, xcd = wgid % NXCD, off = wgid / NXCD; wgid = (xcd < r ? xcd * (q + 1) : r * (q + 1) + (xcd - r) * q) + off; }
        const int nig = WGM * nN, gid = wgid / nig, fm = gid * WGM, gsz = (nM - fm) < WGM ? (nM - fm) : WGM;
        u.pm = fm + ((wgid % nig) % gsz); u.pn = (wgid % nig) / gsz; return true;
    }
    __device__ __forceinline__ void a_ready(const Unit&) const {}
    __device__ __forceinline__ void done(const Unit&) const {}
};
struct WinOrder {
    StaticOrder base; int c; bool fused;
    __host__ __device__ void init(int M, int N, int G_, int c_) { fused = (G_ == 256); c = c_; base.init(M, fused ? N - BM : N, G_, c_); }
    __host__ __device__ int pm6() const { return 16 * (c & 7) + ((c - 128) >> 3); }
    __host__ __device__ bool next(int i, Unit& u) const {
        if (!fused) return base.next(i, u);
        bool ok;
        if (c >= 128) { if (i == 0) { u.pm = pm6(); u.pn = 6; return true; } if (i > 5) return false; ok = base.next(i - 1, u); }
        else { if (i < 6) ok = base.next(i, u); else if (i == 6) { StaticOrder b2 = base; b2.c = c + 128; ok = b2.next(5, u); } else return false; }
        if (ok && u.pn >= 6) u.pn += 1;
        return ok;
    }
    __device__ __forceinline__ void a_ready(const Unit&) const {}
    __device__ __forceinline__ void done(const Unit&) const {}
};


__device__ __forceinline__ unsigned cvt_pk_bf16(float lo, float hi) { unsigned r; asm volatile("v_cvt_pk_bf16_f32 %0, %1, %2" : "=v"(r) : "v"(lo), "v"(hi)); return r; }
typedef unsigned u32x2 __attribute__((ext_vector_type(2)));
constexpr int SSQ_P = 16;
constexpr float RMS_EPS = 1e-6f;
__device__ __forceinline__ float fast_rcp(float x) { return __builtin_amdgcn_rcpf(x); }
__device__ __forceinline__ float sigmoid_f(float x) { return fast_rcp(1.0f + __expf(-x)); }
__device__ __forceinline__ float silu_f(float x) { return x * sigmoid_f(x); }
__device__ __forceinline__ float row_rstd(const float* ssq, int row) {
    const f32x4* p = (const f32x4*)(ssq + (size_t)row * SSQ_P);
    const f32x4 a = p[0], b = p[1], c = p[2], d = p[3];
    const f32x4 s = (a + b) + (c + d);
    const float t = (s[0] + s[1]) + (s[2] + s[3]);
    return 1.0f / sqrtf(t * (1.0f / 1024.0f) + RMS_EPS);
}
constexpr unsigned HPAD_EL = 256u * (3328u - 2816u);
struct EpiSwiglu {
    static constexpr bool PERM = true, AFTER_DRAIN = false;
    bf16_t* H; int ldh; const float* ssq; PG8_LAS float* tab;
    __device__ __forceinline__ void begin(int wid, int lane) const { if (lane == 0) ((PG8_LAS int*)(tab + 8 * 128))[wid] = -1; }
    __device__ __forceinline__ void operator()(const f32x4 (&acc)[2][2][4][2], const Unit& u, int wr, int wc, int fr, int fq) const {
        const int row0 = u.pm * BM + wr * 64 + fr, col0 = u.pn * HALF + wc * 32 + 8 * fq;
        PG8_LAS float* const tb = tab + (wr * 4 + wc) * 128; PG8_LAS int* const tg = (PG8_LAS int*)(tab + 8 * 128) + (wr * 4 + wc);
        if (__builtin_amdgcn_readfirstlane(*tg) != u.pm) { const int ln = fq * 16 + fr, rb = u.pm * BM + wr * 64 + ln;
            const float t0 = row_rstd(ssq, rb), t1 = row_rstd(ssq, rb + HALF); tb[ln] = t0; tb[64 + ln] = t1; if (ln == 0) *tg = u.pm; }
#pragma unroll
        for (int ai = 0; ai < 2; ++ai)
#pragma unroll
            for (int m = 0; m < 4; ++m) { const int row = row0 + ai * HALF + m * 16; const float rs = tb[ai * 64 + m * 16 + fr];
                typedef float f32x2v __attribute__((ext_vector_type(2)));
                const float c1 = rs * -1.4426950408889634f, c2 = rs * rs;
                f32x2v tp[4], hp[4];
#pragma unroll
                for (int n = 0; n < 2; ++n)
#pragma unroll
                    for (int i2 = 0; i2 < 2; ++i2) { const f32x2v g2 = {acc[ai][0][m][n][2 * i2], acc[ai][0][m][n][2 * i2 + 1]}, u2 = {acc[ai][1][m][n][2 * i2], acc[ai][1][m][n][2 * i2 + 1]};
                        tp[n * 2 + i2] = g2 * c1; hp[n * 2 + i2] = (g2 * u2) * c2; }
#pragma unroll
                for (int k = 0; k < 4; ++k) { tp[k].x = __builtin_amdgcn_exp2f(tp[k].x); tp[k].y = __builtin_amdgcn_exp2f(tp[k].y); }
#pragma unroll
                for (int k = 0; k < 4; ++k) tp[k] = tp[k] + 1.0f;
#pragma unroll
                for (int k = 0; k < 4; ++k) { tp[k].x = __builtin_amdgcn_rcpf(tp[k].x); tp[k].y = __builtin_amdgcn_rcpf(tp[k].y); }
                float hv[8];
#pragma unroll
                for (int k = 0; k < 4; ++k) { const f32x2v r2 = hp[k] * tp[k]; hv[2 * k] = r2.x; hv[2 * k + 1] = r2.y; }
                u32x4 w; w.x = cvt_pk_bf16(hv[0], hv[1]); w.y = cvt_pk_bf16(hv[2], hv[3]); w.z = cvt_pk_bf16(hv[4], hv[5]); w.w = cvt_pk_bf16(hv[6], hv[7]);
                *(u32x4*)(H + (size_t)row * ldh + (size_t)u.pm * HPAD_EL + col0) = w; }
    }
};
__device__ __forceinline__ float sum_fq(float x) {
    float a = x, b = x;
    asm volatile("s_nop 1\n\tv_permlane16_swap_b32 %0, %1" : "+v"(a), "+v"(b));
    a = a + b; b = a;
    asm volatile("s_nop 1\n\tv_permlane32_swap_b32 %0, %1" : "+v"(a), "+v"(b));
    return a + b;
}
struct EpiResid {
    static constexpr bool PERM = true, AFTER_DRAIN = false;
    bf16_t* xb; float* ssq; float scale;
    __device__ __forceinline__ void begin(int, int) const {}
    __device__ __forceinline__ void operator()(const f32x4 (&acc)[2][2][4][2], const Unit& u, int wr, int wc, int fr, int fq) const {
        const int row0 = u.pm * BM + wr * 64 + fr, col0 = u.pn * BM + wc * 32 + 8 * fq;
        u32x4 xo[4][2][2];
#define EPR_LOAD(g) do { _Pragma("unroll") for (int mm = 0; mm < 2; ++mm) _Pragma("unroll") for (int bj = 0; bj < 2; ++bj) \
            xo[g][mm][bj] = *(const u32x4*)(xb + (size_t)(row0 + ((g) >> 1) * HALF + (2 * ((g) & 1) + mm) * 16) * 1024 + col0 + bj * HALF); } while (0)
        EPR_LOAD(0); EPR_LOAD(1);
#pragma unroll
        for (int g = 0; g < 4; ++g) { const int ai = g >> 1;
            if (g == 0) EPR_LOAD(2); else if (g == 1) EPR_LOAD(3);
#pragma unroll
            for (int mm = 0; mm < 2; ++mm) { const int m = 2 * (g & 1) + mm; const int row = row0 + ai * HALF + m * 16; float ss = 0.f;
#pragma unroll
                for (int bj = 0; bj < 2; ++bj) { const u32x4 o = xo[g][mm][bj];
                    const f32x4 x0 = {__builtin_bit_cast(float, o.x << 16), __builtin_bit_cast(float, o.x & 0xffff0000u), __builtin_bit_cast(float, o.y << 16), __builtin_bit_cast(float, o.y & 0xffff0000u)};
                    const f32x4 x1 = {__builtin_bit_cast(float, o.z << 16), __builtin_bit_cast(float, o.z & 0xffff0000u), __builtin_bit_cast(float, o.w << 16), __builtin_bit_cast(float, o.w & 0xffff0000u)};
                    const f32x4 v0 = x0 + acc[ai][bj][m][0] * scale, v1 = x1 + acc[ai][bj][m][1] * scale;
                    u32x4 w; w.x = cvt_pk_bf16(v0[0], v0[1]); w.y = cvt_pk_bf16(v0[2], v0[3]); w.z = cvt_pk_bf16(v1[0], v1[1]); w.w = cvt_pk_bf16(v1[2], v1[3]);
                    *(u32x4*)(xb + (size_t)row * 1024 + col0 + bj * HALF) = w;
                    const float r0 = __builtin_bit_cast(float, w.x << 16), r1 = __builtin_bit_cast(float, w.x & 0xffff0000u), r2 = __builtin_bit_cast(float, w.y << 16), r3 = __builtin_bit_cast(float, w.y & 0xffff0000u);
                    const float r4 = __builtin_bit_cast(float, w.z << 16), r5 = __builtin_bit_cast(float, w.z & 0xffff0000u), r6 = __builtin_bit_cast(float, w.w << 16), r7 = __builtin_bit_cast(float, w.w & 0xffff0000u);
                    ss += ((r0 * r0 + r1 * r1) + (r2 * r2 + r3 * r3)) + ((r4 * r4 + r5 * r5) + (r6 * r6 + r7 * r7)); }
                ss = sum_fq(ss);
                if (fq == 0) ssq[(size_t)row * SSQ_P + u.pn * 4 + wc] = ss; }
        }
#undef EPR_LOAD
    }
};
template <bool SCALE> struct EpiProj {
    static constexpr bool PERM = true, AFTER_DRAIN = false;
    __device__ __forceinline__ void begin(int wid, int lane) const { if (lane == 0) ((PG8_LAS int*)(tab + 8 * 128))[wid] = -1; }
    bf16_t* O; int ldc; const float* ssq; PG8_LAS float* tab; bf16_t* side;
    __device__ __forceinline__ void operator()(const f32x4 (&acc)[2][2][4][2], const Unit& u, int wr, int wc, int fr, int fq) const {
        const int row0 = u.pm * BM + wr * 64 + fr, col0 = u.pn * BM + wc * 32 + 8 * fq;
        PG8_LAS float* const tb = tab + (wr * 4 + wc) * 128; PG8_LAS int* const tg = (PG8_LAS int*)(tab + 8 * 128) + (wr * 4 + wc);
        if (SCALE) { if (__builtin_amdgcn_readfirstlane(*tg) != u.pm) { const int ln = fq * 16 + fr, rb = u.pm * BM + wr * 64 + ln; const float t0 = row_rstd(ssq, rb), t1 = row_rstd(ssq, rb + HALF); tb[ln] = t0; tb[64 + ln] = t1; if (ln == 0) *tg = u.pm; } }
#pragma unroll
        for (int ai = 0; ai < 2; ++ai)
#pragma unroll
            for (int m = 0; m < 4; ++m) { const int row = row0 + ai * HALF + m * 16; const float rs = SCALE ? tb[ai * 64 + m * 16 + fr] : 1.0f;
#pragma unroll
                for (int bj = 0; bj < 2; ++bj) { const f32x4 v0 = acc[ai][bj][m][0] * rs, v1 = acc[ai][bj][m][1] * rs;
                    u32x4 w; w.x = cvt_pk_bf16(v0[0], v0[1]); w.y = cvt_pk_bf16(v0[2], v0[3]); w.z = cvt_pk_bf16(v1[0], v1[1]); w.w = cvt_pk_bf16(v1[2], v1[3]);
                    *(u32x4*)(O + (size_t)row * ldc + col0 + bj * HALF) = w;
                    if (side != nullptr && u.pn < 6 && fr == 15) *(u32x4*)(side + (size_t)(row >> 4) * 1536 + col0 + bj * HALF) = w; } }
    }
};

template <class Epi, class Sched, bool ALIGN_EPI = false, bool SP2 = false>
__device__ __forceinline__ void gemm_phase(PG8_LAS unsigned char* lds, const Gemm g, const Sched& S, const Epi& E) {
    int tid_ = threadIdx.x; asm volatile("" : "+v"(tid_));
    const int tid = tid_, wid = __builtin_amdgcn_readfirstlane(tid >> 6), lane = tid & 63, wr = wid >> 2, wc = wid & 3, fr = lane & 15, fq = lane >> 4;
    const int K = g.K, nt = K / BK;
    unsigned voffA[2], voffB[2];
#pragma unroll
    for (int i = 0; i < 2; ++i) { int R, C; stage_rc(tid * 16 + i * 8192, R, C); const int Rb = Epi::PERM ? ((R & ~31) + perm32(R & 31)) : R;
        voffA[i] = (unsigned)(R * K + C) * 2u; voffB[i] = (unsigned)(Rb * K + C) * 2u; }
    const unsigned kstep = (unsigned)(BK * 2);
    const unsigned hstep = (unsigned)HALF * (unsigned)K * 2u;
    const unsigned tstep = 2u * hstep;
    const unsigned tstepA = tstep + g.apad;
    const __amdgpu_buffer_rsrc_t rsA = __builtin_amdgcn_make_buffer_rsrc((void*)g.A, (short)0, (int)((size_t)g.M * K * 2 + (size_t)(g.M / BM) * g.apad), 0x00020000);
    const __amdgpu_buffer_rsrc_t rsB = __builtin_amdgcn_make_buffer_rsrc((void*)g.Bt, (short)0, (int)((size_t)g.N * K * 2), 0x00020000);
    const unsigned ldsw = (unsigned)wid * 1024u;
    const int aoff = lds_byte(wr * 64 + fr, fq * 8), boff = lds_byte(wc * 32 + fr, fq * 8);
#define PG8_SA(b, h) (((b) * 2 + (h)) * HTB)
#define PG8_SB(b, h) ((4 + (b) * 2 + (h)) * HTB)
#define PG8_STAGE_X(rs, bufoff, goff, voff) do { _Pragma("unroll") for (int _i = 0; _i < 2; ++_i) \
        __builtin_amdgcn_raw_ptr_buffer_load_lds(rs, (PG8_LAS unsigned*)(lds + (bufoff) + ldsw + _i * 8192), 16, (int)(voff)[_i], (int)(goff), 0, 0); } while (0)
#define PG8_STAGE_A(bufoff, goff, voff) PG8_STAGE_X(rsA, bufoff, goff, voff)
#define PG8_STAGE_B(bufoff, goff, voff) PG8_STAGE_X(rsB, bufoff, goff, voff)
#define PG8_LDA(dst, b, h) do { _Pragma("unroll") for (int m = 0; m < 4; ++m) _Pragma("unroll") for (int k = 0; k < 2; ++k) dst[m][k] = *(const PG8_LAS bf16x8*)(lds + PG8_SA(b, h) + aoff + m * 2048 + k * 1024); } while (0)
#define PG8_LDB(dst, b, h) do { _Pragma("unroll") for (int n = 0; n < 2; ++n) _Pragma("unroll") for (int k = 0; k < 2; ++k) dst[n][k] = *(const PG8_LAS bf16x8*)(lds + PG8_SB(b, h) + boff + n * 2048 + k * 1024); } while (0)
#define PG8_MMA(ai, bj, At, Bt) do { __builtin_amdgcn_s_setprio(1); _Pragma("unroll") for (int m = 0; m < 4; ++m) _Pragma("unroll") for (int n = 0; n < 2; ++n) _Pragma("unroll") for (int k = 0; k < 2; ++k) \
        acc[ai][bj][m][n] = __builtin_amdgcn_mfma_f32_16x16x32_bf16(Bt[n][k], At[m][k], acc[ai][bj][m][n], 0, 0, 0); __builtin_amdgcn_s_setprio(0); } while (0)
#define PG8_WAIT_V(n) asm volatile("s_waitcnt vmcnt(" #n ")" ::: "memory")
#define PG8_WAIT_L(n) asm volatile("s_waitcnt lgkmcnt(" #n ")" ::: "memory")
#define PG8_BAR __builtin_amdgcn_s_barrier()
#define PG8_SCHED __builtin_amdgcn_sched_barrier(0)
    E.begin(wid, lane);
    Unit cur, nxt; int ui = 0;
    if (!S.next(0, cur)) return;
    f32x4 acc[2][2][4][2];
#pragma unroll
    for (int a = 0; a < 2; ++a)
#pragma unroll
        for (int b = 0; b < 2; ++b)
#pragma unroll
            for (int m = 0; m < 4; ++m)
#pragma unroll
                for (int n = 0; n < 2; ++n) acc[a][b][m][n] = (f32x4){0.f, 0.f, 0.f, 0.f};
    bf16x8 At[4][2], B0[2][2], B1[2][2];
    unsigned cA = (unsigned)cur.pm * tstepA, cB = (unsigned)cur.pn * tstep;
    S.a_ready(cur);
    if constexpr (SP2) {
        PG8_STAGE_B(PG8_SB(0, 0), cB, voffB); PG8_STAGE_B(PG8_SB(0, 1), cB + hstep, voffB); PG8_STAGE_A(PG8_SA(0, 0), cA, voffA); PG8_STAGE_A(PG8_SA(0, 1), cA + hstep, voffA);
        if (wr == 1) PG8_BAR;
        PG8_WAIT_V(2); PG8_BAR;
        PG8_STAGE_B(PG8_SB(1, 0), cB + kstep, voffB); PG8_STAGE_A(PG8_SA(1, 0), cA + kstep, voffA); PG8_STAGE_B(PG8_SB(1, 1), cB + hstep + kstep, voffB);
        PG8_WAIT_V(6); PG8_BAR;
    } else {
        PG8_STAGE_B(PG8_SB(0, 0), cB, voffB); PG8_STAGE_A(PG8_SA(0, 0), cA, voffA); PG8_STAGE_B(PG8_SB(0, 1), cB + hstep, voffB); PG8_STAGE_A(PG8_SA(0, 1), cA + hstep, voffA);
        if (wr == 1) PG8_BAR;
        PG8_WAIT_V(4); PG8_BAR;
        PG8_STAGE_B(PG8_SB(1, 0), cB + kstep, voffB); PG8_STAGE_A(PG8_SA(1, 0), cA + kstep, voffA); PG8_STAGE_B(PG8_SB(1, 1), cB + hstep + kstep, voffB);
        PG8_WAIT_V(6); PG8_BAR;
    }
    for (;;) {
        const bool has_next = S.next(ui + 1, nxt);
        const unsigned nA = has_next ? (unsigned)nxt.pm * tstepA : cA, nB = has_next ? (unsigned)nxt.pn * tstep : cB;
        for (int t = 0; t < nt; t += 2) {
            const bool last = (t == nt - 2);
            const unsigned a1 = cA + (unsigned)(t + 1) * kstep;
            const unsigned a2 = last ? nA : cA + (unsigned)(t + 2) * kstep, b2 = last ? nB : cB + (unsigned)(t + 2) * kstep;
            const unsigned a3 = a2 + kstep, b3 = b2 + kstep;
            if (last && has_next) S.a_ready(nxt);
            if constexpr (SP2) {
            PG8_LDB(B0, 0, 0); PG8_LDB(B1, 0, 1); PG8_SCHED; PG8_LDA(At, 0, 0); PG8_STAGE_A(PG8_SA(1, 1), a1 + hstep, voffA);
            PG8_WAIT_V(8); PG8_WAIT_L(0); PG8_BAR; PG8_MMA(0, 0, At, B0); PG8_MMA(0, 1, At, B1); PG8_BAR; PG8_SCHED;
            PG8_LDA(At, 0, 1); PG8_STAGE_B(PG8_SB(0, 0), b2, voffB); PG8_STAGE_B(PG8_SB(0, 1), b2 + hstep, voffB); PG8_STAGE_A(PG8_SA(0, 0), a2, voffA);
            PG8_WAIT_V(8); PG8_WAIT_L(0); PG8_BAR; PG8_MMA(1, 0, At, B0); PG8_MMA(1, 1, At, B1); PG8_BAR; PG8_SCHED;
            PG8_LDB(B0, 1, 0); PG8_LDB(B1, 1, 1); PG8_SCHED; PG8_LDA(At, 1, 0); PG8_STAGE_A(PG8_SA(0, 1), a2 + hstep, voffA);
            PG8_WAIT_V(8); PG8_WAIT_L(0); PG8_BAR; PG8_MMA(0, 0, At, B0); PG8_MMA(0, 1, At, B1); PG8_BAR; PG8_SCHED;
            PG8_LDA(At, 1, 1); PG8_STAGE_B(PG8_SB(1, 0), b3, voffB); PG8_STAGE_B(PG8_SB(1, 1), b3 + hstep, voffB); PG8_STAGE_A(PG8_SA(1, 0), a3, voffA);
            PG8_WAIT_V(8); PG8_WAIT_L(0); PG8_BAR; PG8_MMA(1, 0, At, B0); PG8_MMA(1, 1, At, B1); PG8_BAR; PG8_SCHED;
            } else {
            PG8_LDB(B0, 0, 0); PG8_SCHED; PG8_LDA(At, 0, 0); PG8_STAGE_A(PG8_SA(1, 1), a1 + hstep, voffA);
            PG8_WAIT_L(8); PG8_BAR; PG8_WAIT_L(0); PG8_MMA(0, 0, At, B0); PG8_BAR; PG8_SCHED;
            PG8_LDB(B1, 0, 1); PG8_STAGE_B(PG8_SB(0, 0), b2, voffB);
            PG8_BAR; PG8_WAIT_L(0); PG8_MMA(0, 1, At, B1); PG8_BAR;
            PG8_LDA(At, 0, 1); PG8_STAGE_A(PG8_SA(0, 0), a2, voffA);
            PG8_BAR; PG8_WAIT_L(0); PG8_MMA(1, 0, At, B0); PG8_BAR; PG8_SCHED;
            PG8_STAGE_B(PG8_SB(0, 1), b2 + hstep, voffB);
            PG8_WAIT_V(6); PG8_BAR; PG8_MMA(1, 1, At, B1); PG8_BAR;
            PG8_LDB(B0, 1, 0); PG8_SCHED; PG8_LDA(At, 1, 0); PG8_STAGE_A(PG8_SA(0, 1), a2 + hstep, voffA);
            PG8_WAIT_L(8); PG8_BAR; PG8_WAIT_L(0); PG8_MMA(0, 0, At, B0); PG8_BAR; PG8_SCHED;
            PG8_LDB(B1, 1, 1); PG8_STAGE_B(PG8_SB(1, 0), b3, voffB);
            PG8_BAR; PG8_WAIT_L(0); PG8_MMA(0, 1, At, B1); PG8_BAR;
            PG8_LDA(At, 1, 1); PG8_STAGE_A(PG8_SA(1, 0), a3, voffA);
            PG8_BAR; PG8_WAIT_L(0); PG8_MMA(1, 0, At, B0); PG8_BAR; PG8_SCHED;
            PG8_STAGE_B(PG8_SB(1, 1), b3 + hstep, voffB);
            PG8_WAIT_V(6); PG8_BAR; PG8_MMA(1, 1, At, B1); PG8_BAR;
            }
        }
        if constexpr (ALIGN_EPI) { if (wr == 0) PG8_BAR; }
        if constexpr (!Epi::AFTER_DRAIN) { E(acc, cur, wr, wc, fr, fq); S.done(cur); }
        if (!has_next) break;
#pragma unroll
        for (int a = 0; a < 2; ++a)
#pragma unroll
            for (int b = 0; b < 2; ++b)
#pragma unroll
                for (int m = 0; m < 4; ++m)
#pragma unroll
                    for (int n = 0; n < 2; ++n) acc[a][b][m][n] = (f32x4){0.f, 0.f, 0.f, 0.f};
        cur = nxt; cA = nA; cB = nB; ++ui;
        if constexpr (ALIGN_EPI) { if (wr == 1) PG8_BAR; }
    }
    PG8_WAIT_V(0);
    if constexpr (!ALIGN_EPI) { if (wr == 0) PG8_BAR; }
    PG8_BAR;
    if constexpr (Epi::AFTER_DRAIN) { E.fused(acc, cur, wr, wc, fr, fq, lds, wid, lane); S.done(cur); }
#undef PG8_SA
#undef PG8_SB
#undef PG8_STAGE_X
#undef PG8_STAGE_A
#undef PG8_STAGE_B
#undef PG8_LDA
#undef PG8_LDB
#undef PG8_MMA
#undef PG8_WAIT_V
#undef PG8_WAIT_L
#undef PG8_BAR
#undef PG8_SCHED
}
}
#define GAS __attribute__((address_space(1)))
#define LAS __attribute__((address_space(3)))
typedef unsigned short bf16;
typedef unsigned v4u __attribute__((ext_vector_type(4)));
typedef float f32x4 __attribute__((ext_vector_type(4)));
typedef short bf16x8 __attribute__((ext_vector_type(8)));
typedef GAS unsigned gu32;
typedef GAS unsigned long long gu64;
#define RLX_AGENT __ATOMIC_RELAXED, __HIP_MEMORY_SCOPE_AGENT
#define LDS_WAIT() asm volatile("s_waitcnt lgkmcnt(0)" ::: "memory")
#define VM_WAIT() asm volatile("s_waitcnt vmcnt(0)" ::: "memory")
__device__ __forceinline__ unsigned long long rt() { return __builtin_amdgcn_s_memrealtime(); }
__device__ __forceinline__ unsigned f2bf(float f) { unsigned u = __builtin_bit_cast(unsigned, f); return (u + 0x7fffu + ((u >> 16) & 1u)) >> 16; }
__device__ __forceinline__ unsigned pk2(float lo, float hi) { return f2bf(lo) | (f2bf(hi) << 16); }

#define XB_TMO      128
#define XB_XCNT(j)  (256  + 64 * (j))
#define XB_XSUB(j)  (1280 + 64 * (j))
#define XB_XGEN(j)  (2304 + 64 * (j))
#define XB_TOP      3328
#define XB_TOPGEN   3392
#define XCD_BAR_WORDS 3456
#define GB_SUB(j)   (3456 + 64 * (j))
#define GB_GEN(j)   (3968 + 64 * (j))
#define GB_MASK(j)  (4480 + 64 * (j))
#define GB_WDONE    4992
#define GB_MDONE    5056
#define QB_SUB(j)   (5120 + 64 * (j))
#define QB_GEN(j)   (9216 + 64 * (j))
#define XB_SPIN_CAP (1u << 18)
#ifndef QSLEEP
#define QSLEEP 16
#endif

__device__ __forceinline__ unsigned xb_ld(unsigned* p)              { return __hip_atomic_load(p, __ATOMIC_RELAXED, __HIP_MEMORY_SCOPE_AGENT); }
__device__ __forceinline__ unsigned xb_add(unsigned* p, unsigned v) { return __hip_atomic_fetch_add(p, v, __ATOMIC_RELAXED, __HIP_MEMORY_SCOPE_AGENT); }
__device__ __forceinline__ unsigned xb_xcc_id() { return (unsigned)__builtin_amdgcn_s_getreg((3 << 11) | 20) & 0xFu; }
#define XB_SPIN(cond, bar) do { unsigned _sp = 0; while (cond) { __builtin_amdgcn_s_sleep(1); \
    if ((++_sp & 255u) == 0u) { if (xb_ld(&(bar)[XB_TMO])) break; if (_sp > XB_SPIN_CAP) { atomicAdd(&(bar)[XB_TMO], 1u); break; } } } } while (0)

struct XcdBarrier {
    unsigned* bar; unsigned x;
    volatile LAS unsigned* st;
};

__device__ __forceinline__ XcdBarrier xcd_barrier_post(unsigned* bar, volatile LAS unsigned* st) {
    XcdBarrier b; b.bar = bar; b.x = xb_xcc_id(); b.st = st;
    if (threadIdx.x == 0) (void)xb_add(&bar[XB_XCNT(b.x)], 1u);
    return b;
}
__device__ __forceinline__ void xcd_barrier_complete(unsigned* bar, unsigned x, unsigned& nloc, unsigned& nx) {
    const unsigned G = gridDim.x * gridDim.y * gridDim.z;
    unsigned sum, cnt, mine, sp = 0u;
    for (;;) {
        sum = 0u; cnt = 0u; mine = 0u;
#pragma unroll
        for (unsigned j = 0; j < 16; ++j) { const unsigned c = xb_ld(&bar[XB_XCNT(j)]); sum += c; cnt += (c > 0u) ? 1u : 0u; mine = (j == x) ? c : mine; }
        if (sum == G) break;
        __builtin_amdgcn_s_sleep(1);
        if ((++sp & 255u) == 0u) { if (xb_ld(&bar[XB_TMO])) break; if (sp > XB_SPIN_CAP) { atomicAdd(&bar[XB_TMO], 1u); break; } }
    }
    nloc = mine > 0u ? mine : 1u; nx = cnt > 0u ? cnt : 1u;
}

__device__ __forceinline__ void xcd_barrier(const XcdBarrier& b) {
    asm volatile("s_waitcnt vmcnt(0)" ::: "memory");
    __syncthreads();
    if (threadIdx.x == 0) {
        unsigned* bar = b.bar;
        __builtin_amdgcn_s_waitcnt(0);
        unsigned nloc = b.st[0], nx = b.st[1];
        if (nloc == 0u) { xcd_barrier_complete(bar, b.x, nloc, nx); b.st[0] = nloc; b.st[1] = nx; }
        const unsigned old = xb_add(&bar[XB_XSUB(b.x)], 1u);
        const unsigned gen = old / nloc;
        if (old + 1u == (gen + 1u) * nloc) {
            __builtin_amdgcn_fence(__ATOMIC_RELEASE, "agent");
            asm volatile("s_waitcnt vmcnt(0)" ::: "memory");
            const unsigned og = xb_add(&bar[XB_TOP], 1u);
            const unsigned tg = og / nx;
            if (og + 1u == (tg + 1u) * nx) xb_add(&bar[XB_TOPGEN], 1u);
            else XB_SPIN(xb_ld(&bar[XB_TOPGEN]) == tg, bar);
            __builtin_amdgcn_fence(__ATOMIC_ACQUIRE, "agent");
            xb_add(&bar[XB_XGEN(b.x)], 1u);
            asm volatile("s_waitcnt vmcnt(0)" ::: "memory");
        } else {
            XB_SPIN(xb_ld(&bar[XB_XGEN(b.x)]) == gen, bar);
            __builtin_amdgcn_fence(__ATOMIC_ACQUIRE, "agent");
            asm volatile("s_waitcnt vmcnt(0)" ::: "memory");
        }
    }
    __syncthreads();
}

__device__ __forceinline__ void grp_barrier(unsigned* bar, unsigned subw, unsigned genw, unsigned nloc, bool wb) {
    asm volatile("s_waitcnt vmcnt(0)" ::: "memory");
    __syncthreads();
    if (threadIdx.x == 0) {
        __builtin_amdgcn_s_waitcnt(0);
        if (wb) { __builtin_amdgcn_fence(__ATOMIC_RELEASE, "agent"); asm volatile("s_waitcnt vmcnt(0)" ::: "memory"); }
        const unsigned old = xb_add(&bar[subw], 1u);
        const unsigned gen = old / nloc;
        if (old + 1u == (gen + 1u) * nloc) xb_add(&bar[genw], 1u);
        else XB_SPIN(xb_ld(&bar[genw]) == gen, bar);
        __builtin_amdgcn_fence(__ATOMIC_ACQUIRE, "agent");
        asm volatile("s_waitcnt vmcnt(0)" ::: "memory");
    }
    __syncthreads();
}

constexpr int NWAVES = 8;
constexpr int BATCH = 16, SEQ = 2048, DM = 1024, DEPTH = 2, DFF = 2816, NGU = 2 * DFF, NPROJ = 3328, RWKV_IN = 1792, NLORA = 1536, KLORA = 256;
constexpr int M = BATCH * SEQ;
constexpr int RET_OFF = RWKV_IN;
constexpr float LN_X_EPS = 64e-5f;
constexpr size_t MiB = 1u << 20;
constexpr size_t WS_CTL = 0, CTL_ZERO_BYTES = 1 * MiB;
constexpr size_t SZ_WGU = (size_t)NGU * DM * 2, SZ_WD = (size_t)DM * DFF * 2, SZ_WIN = (size_t)NPROJ * DM * 2, SZ_WLORA = (size_t)NLORA * KLORA * 2, SZ_WOUT = (size_t)DM * DM * 2;
constexpr size_t OFF_WGU1 = 0, OFF_WD1 = OFF_WGU1 + SZ_WGU, OFF_WIN = OFF_WD1 + SZ_WD, OFF_WLORA = OFF_WIN + SZ_WIN, OFF_WOUT = OFF_WLORA + SZ_WLORA, OFF_WGU2 = OFF_WOUT + SZ_WOUT, OFF_WD2 = OFF_WGU2 + SZ_WGU, SZ_LAYER = OFF_WD2 + SZ_WD;
constexpr size_t WS_W = 1 * MiB;
constexpr size_t WS_TRIG = WS_W + DEPTH * SZ_LAYER;
constexpr size_t WS_SSQ = 86 * MiB;
constexpr size_t WS_XB = 90 * MiB;
constexpr size_t WS_SIDE = 186 * MiB;
constexpr size_t WS_DUMP = 192 * MiB;
constexpr size_t WS_ALORA = 154 * MiB;
constexpr size_t WS_MIXED = 218 * MiB;
constexpr size_t WS_H = 282 * MiB;
constexpr size_t WS_END = 490 * MiB;
static_assert(WS_TRIG + 2 * 2048 * 32 * 4 <= WS_SSQ && WS_SSQ + 2 * (size_t)M * 16 * 4 <= WS_XB && WS_XB + (size_t)M * DM * 2 <= WS_SIDE && (size_t)M * NLORA * 2 <= (size_t)M * DM * 4 && WS_H + (size_t)M * NPROJ * 2 <= WS_END, "d_ws map");
constexpr int CW_TMO = 0, CW_CODE = 1, CW_BAR = 4096;

constexpr int RING_OFF = 0, RING_BYTES = 131072;
constexpr int LDSCTL_OFF = 161792, MISC_OFF = LDSCTL_OFF + 320;
constexpr int EPI_TAB_OFF = 131072;
constexpr int LDS_BYTES = 163840;

__device__ __forceinline__ int opaque_bx() { int b = (int)blockIdx.x; asm volatile("" : "+s"(b)); return b; }
struct Frame {
    LAS unsigned char* lds;
    volatile LAS unsigned* MISC;
    int tid, lane, wave;
    int vcu, G;
    unsigned char* ws;
    unsigned char* lora;
};
struct LayerP {
    const float *mu, *w0, *a0, *k_k, *k_a, *r_k, *ln_w, *ln_b;
    const unsigned short* wlora;
};
__device__ __forceinline__ float bf_lo(unsigned u) { return __builtin_bit_cast(float, u << 16); }
__device__ __forceinline__ float bf_hi(unsigned u) { return __builtin_bit_cast(float, u & 0xffff0000u); }
typedef float f32x2_t __attribute__((ext_vector_type(2))); typedef __bf16 bf16x2_t __attribute__((ext_vector_type(2)));
__device__ __forceinline__ unsigned cvtpk(float lo, float hi) { f32x2_t v = {lo, hi}; bf16x2_t b = __builtin_convertvector(v, bf16x2_t); return __builtin_bit_cast(unsigned, b); }
__device__ __forceinline__ float wave_sum(float v) {
#pragma unroll
    for (int o = 1; o < 64; o <<= 1) v += __shfl_xor(v, o);
    return v;
}
template <int CTRL> __device__ __forceinline__ float dpp_f(float v) { return __builtin_bit_cast(float, __builtin_amdgcn_update_dpp(0, __builtin_bit_cast(int, v), CTRL, 0xF, 0xF, true)); }
__device__ __forceinline__ float sum8(float v) { v += dpp_f<0xB1>(v); v += dpp_f<0x4E>(v); v += dpp_f<0x141>(v); return v; }
__device__ __forceinline__ float sum16(float v) { v = sum8(v); v += dpp_f<0x140>(v); return v; }
__device__ __forceinline__ float sigm(float x) { return __builtin_amdgcn_rcpf(1.0f + __expf(-x)); }

constexpr int P0_SCR_BYTES = 64 * 65 * 4;
__device__ __forceinline__ void p0_transpose_item(const float* W, int K, int N, const float* gain, bf16* WT, int k0, int n0, int dst_row0, LAS float* scr, int lane) {
    const int n4 = (lane & 15) * 4, kr = lane >> 4;
#pragma unroll 8
    for (int i = 0; i < 16; ++i) { const int kk = 4 * i + kr; const float g = gain ? gain[k0 + kk] : 1.0f;
        const f32x4 v = *(const GAS f32x4*)(W + (size_t)(k0 + kk) * N + n0 + n4);
        LAS float* s = scr + kk * 65 + n4; s[0] = v.x * g; s[1] = v.y * g; s[2] = v.z * g; s[3] = v.w * g; }
    LDS_WAIT(); asm volatile("" ::: "memory");
    const int c = lane & 7;
#pragma unroll
    for (int j = 0; j < 8; ++j) { const int n = (lane >> 3) + 8 * j; const LAS float* s = scr + (8 * c) * 65 + n;
        v4u o; o.x = pk2(s[0 * 65], s[1 * 65]); o.y = pk2(s[2 * 65], s[3 * 65]); o.z = pk2(s[4 * 65], s[5 * 65]); o.w = pk2(s[6 * 65], s[7 * 65]);
        *(GAS v4u*)(WT + (size_t)(dst_row0 + n) * K + k0 + 8 * c) = o; }
    LDS_WAIT(); asm volatile("" ::: "memory");
}
struct Args { const float* in[24]; float* out; unsigned char* ws; int ph_lo, ph_hi; };
constexpr int ITEMS_FF = (DM / 64) * (DFF / 64), ITEMS_IN = (DM / 64) * (NPROJ / 64), ITEMS_OUT = (DM / 64) * (DM / 64);
constexpr int ITEMS_LAYER = 6 * ITEMS_FF + ITEMS_IN + ITEMS_OUT;
constexpr int ITEMS_EARLY = 2 * ITEMS_FF;
__device__ __forceinline__ void p0_weights(const Frame& F, const Args& A, int it_lo, int it_hi, int gw, int NGW) {
    LAS float* scr = (LAS float*)(F.lds + RING_OFF + F.wave * P0_SCR_BYTES);
    for (int it = it_lo + gw; it < it_hi; it += NGW) {
        const int l = it / ITEMS_LAYER; int r = it % ITEMS_LAYER;
        bf16* wl = (bf16*)(F.ws + WS_W + (size_t)l * SZ_LAYER);
        const float* W; const float* gain = nullptr; bf16* WT; int K, N, mode = 0;
        if (r < ITEMS_FF)            { W = A.in[2] + (size_t)l * DM * DFF; gain = A.in[1] + l * DM; WT = (bf16*)((unsigned char*)wl + OFF_WGU1); K = DM; N = DFF; mode = 1; }
        else if ((r -= ITEMS_FF) < ITEMS_FF)  { W = A.in[3] + (size_t)l * DM * DFF; gain = A.in[1] + l * DM; WT = (bf16*)((unsigned char*)wl + OFF_WGU1); K = DM; N = DFF; mode = 2; }
        else if ((r -= ITEMS_FF) < ITEMS_FF)  { W = A.in[4] + (size_t)l * DFF * DM; WT = (bf16*)((unsigned char*)wl + OFF_WD1); K = DFF; N = DM; }
        else if ((r -= ITEMS_FF) < ITEMS_IN)  { W = A.in[6] + (size_t)l * DM * NPROJ; gain = A.in[5] + l * DM; WT = (bf16*)((unsigned char*)wl + OFF_WIN); K = DM; N = NPROJ; }
        else if ((r -= ITEMS_IN) < ITEMS_OUT) { W = A.in[18] + (size_t)l * DM * DM; WT = (bf16*)((unsigned char*)wl + OFF_WOUT); K = DM; N = DM; }
        else if ((r -= ITEMS_OUT) < ITEMS_FF) { W = A.in[20] + (size_t)l * DM * DFF; gain = A.in[19] + l * DM; WT = (bf16*)((unsigned char*)wl + OFF_WGU2); K = DM; N = DFF; mode = 1; }
        else if ((r -= ITEMS_FF) < ITEMS_FF)  { W = A.in[21] + (size_t)l * DM * DFF; gain = A.in[19] + l * DM; WT = (bf16*)((unsigned char*)wl + OFF_WGU2); K = DM; N = DFF; mode = 2; }
        else { r -= ITEMS_FF;                   W = A.in[22] + (size_t)l * DFF * DM; WT = (bf16*)((unsigned char*)wl + OFF_WD2); K = DFF; N = DM; }
        const int nblk = N / 64, kb = r / nblk, nb = r % nblk, k0 = 64 * kb, n0 = 64 * nb;
        const int dst = mode == 0 ? n0 : ((n0 >> 7) * 256 + (n0 & 127) + (mode == 2 ? 128 : 0));
        p0_transpose_item(W, K, N, gain, WT, k0, n0, dst, scr, F.lane);
    }
}
__device__ __forceinline__ void p0_prologue(const Frame& F, const Args& A) {
    const int gw = F.vcu * NWAVES + F.wave, NGW = F.G * NWAVES;
    p0_weights(F, A, 0, F.G == 256 ? ITEMS_EARLY : DEPTH * ITEMS_LAYER, gw, NGW);
    const int gt = gw * 64 + F.lane, NGT = NGW * 64;
    for (int it = gt; it < DEPTH * NLORA * (KLORA / 8); it += NGT) {
        const int l = it / (NLORA * (KLORA / 8)), r = it % (NLORA * (KLORA / 8)), n = r >> 5, k8 = (r & 31) * 8;
        const int blk = n >> 9, nn = n & 511;
        const int klo = blk == 0 ? 0 : (blk == 1 ? 64 : 128), khi = blk == 0 ? 64 : (blk == 1 ? 128 : 256);
        const float* src = blk == 0 ? A.in[9] + (size_t)l * 64 * 512 : (blk == 1 ? A.in[11] + (size_t)l * 64 * 512 : A.in[12] + (size_t)l * 128 * 512);
        float v[8];
#pragma unroll
        for (int j = 0; j < 8; ++j) { const int k = k8 + j; v[j] = (k >= klo && k < khi) ? src[(size_t)(k - klo) * 512 + nn] : 0.0f; }
        v4u o; o.x = pk2(v[0], v[1]); o.y = pk2(v[2], v[3]); o.z = pk2(v[4], v[5]); o.w = pk2(v[6], v[7]);
        *(GAS v4u*)((bf16*)(F.ws + WS_W + (size_t)l * SZ_LAYER + OFF_WLORA) + (size_t)n * KLORA + k8) = o;
    }
    for (int it = gt; it < SEQ * 32; it += NGT) {
        const int pos = it >> 5, i = it & 31;
        const float x = (float)i * (1.0f / 31.0f);
        const float inv_freq = 1.0f / powf(10000.0f, x);
        const float ang = (float)pos * inv_freq;
        float sn, cs; sincosf(ang, &sn, &cs);
        ((float*)(F.ws + WS_TRIG))[it] = cs; ((float*)(F.ws + WS_TRIG))[SEQ * 32 + it] = sn;
    }
    const float* x = A.in[0]; bf16* xb = (bf16*)(F.ws + WS_XB); float* ssq = (float*)(F.ws + WS_SSQ);
    for (int m = gw; m < M; m += 4 * NGW) {
        f32x4 v[4][4]; int mr[4]; bool has[4];
#pragma unroll
        for (int r = 0; r < 4; ++r) { mr[r] = m + r * NGW; has[r] = mr[r] < M; if (!has[r]) mr[r] = m;
            const GAS f32x4* xr = (const GAS f32x4*)(x + (size_t)mr[r] * DM) + F.lane;
#pragma unroll
            for (int j = 0; j < 4; ++j) v[r][j] = xr[64 * j]; }
#pragma unroll
        for (int r = 0; r < 4; ++r) {
            GAS unsigned long long* o8 = (GAS unsigned long long*)(xb + (size_t)mr[r] * DM) + F.lane;
            float sq = 0.f;
#pragma unroll
            for (int j = 0; j < 4; ++j) { sq += (v[r][j].x * v[r][j].x + v[r][j].y * v[r][j].y) + (v[r][j].z * v[r][j].z + v[r][j].w * v[r][j].w);
                if (has[r]) o8[64 * j] = (unsigned long long)pk2(v[r][j].x, v[r][j].y) | ((unsigned long long)pk2(v[r][j].z, v[r][j].w) << 32); }
            sq = wave_sum(sq);
            if (has[r] && F.lane < 16) ssq[(size_t)mr[r] * 16 + F.lane] = (F.lane == 0) ? sq : 0.0f;
        }
    }
}
__device__ __forceinline__ void lora_prep(const Frame& F, const float* mu) {
    const bf16* proj = (const bf16*)(F.ws + WS_H); bf16* alora = (bf16*)(F.ws + WS_ALORA);
    const int gt = (F.vcu * NWAVES + F.wave) * 64 + F.lane, NGT = F.G * NWAVES * 64;
    for (int it = gt; it < M * 32; it += NGT) {
        const int m = it >> 5, c8 = (it & 31) * 8;
        const v4u pc = *(const GAS v4u*)(proj + (size_t)m * NPROJ + 1536 + c8);
        v4u pp = (v4u){0u, 0u, 0u, 0u};
        if ((m & (SEQ - 1)) != 0) pp = *(const GAS v4u*)(proj + (size_t)(m - 1) * NPROJ + 1536 + c8);
        const f32x4 m0 = *(const f32x4*)(mu + 1536 + c8), m1 = *(const f32x4*)(mu + 1536 + c8 + 4);
        float v[8];
#pragma unroll
        for (int j = 0; j < 4; ++j) { const unsigned a = pc[j], b = pp[j]; const float ml = j < 2 ? m0[2 * j] : m1[2 * j - 4], mh = j < 2 ? m0[2 * j + 1] : m1[2 * j - 3];
            const float cl = bf_lo(a), ch = bf_hi(a), pl = bf_lo(b), ph = bf_hi(b);
            v[2 * j] = cl + ml * (pl - cl); v[2 * j + 1] = ch + mh * (ph - ch); }
        if (c8 < 64) {
#pragma unroll
            for (int j = 0; j < 8; ++j) v[j] = 1.0f - 2.0f * __builtin_amdgcn_rcpf(1.0f + __expf(2.0f * v[j]));
        } else if (c8 >= 128) {
#pragma unroll
            for (int j = 0; j < 8; ++j) v[j] = sigm(v[j]);
        }
        v4u o; o.x = cvtpk(v[0], v[1]); o.y = cvtpk(v[2], v[3]); o.z = cvtpk(v[4], v[5]); o.w = cvtpk(v[6], v[7]);
        *(GAS v4u*)(alora + (size_t)m * KLORA + c8) = o;
    }
    bf16* side = (bf16*)(F.ws + WS_SIDE);
    for (int it = gt; it < (M / 16) * 192; it += NGT) {
        const int cidx = it / 192, c8 = (it % 192) * 8;
        *(GAS v4u*)(side + (size_t)cidx * 1536 + c8) = *(const GAS v4u*)(proj + ((size_t)cidx * 16 + 15) * NPROJ + c8);
    }
}
__device__ __forceinline__ void lora_prep_piece(const Frame& F, const float* mu, int m, int c8) {
    const bf16* proj = (const bf16*)(F.ws + WS_H); bf16* alora = (bf16*)(F.ws + WS_ALORA);
    const v4u pc = *(const GAS v4u*)(proj + (size_t)m * NPROJ + 1536 + c8);
    v4u pp = (v4u){0u, 0u, 0u, 0u};
    if ((m & (SEQ - 1)) != 0) pp = *(const GAS v4u*)(proj + (size_t)(m - 1) * NPROJ + 1536 + c8);
    const f32x4 m0 = *(const f32x4*)(mu + 1536 + c8), m1 = *(const f32x4*)(mu + 1536 + c8 + 4);
    float v[8];
#pragma unroll
    for (int j = 0; j < 4; ++j) { const unsigned a = pc[j], b = pp[j]; const float ml = j < 2 ? m0[2 * j] : m1[2 * j - 4], mh = j < 2 ? m0[2 * j + 1] : m1[2 * j - 3];
        const float cl = bf_lo(a), ch = bf_hi(a), pl = bf_lo(b), ph = bf_hi(b);
        v[2 * j] = cl + ml * (pl - cl); v[2 * j + 1] = ch + mh * (ph - ch); }
    if (c8 < 64) {
#pragma unroll
        for (int j = 0; j < 8; ++j) v[j] = 1.0f - 2.0f * __builtin_amdgcn_rcpf(1.0f + __expf(2.0f * v[j]));
    } else if (c8 >= 128) {
#pragma unroll
        for (int j = 0; j < 8; ++j) v[j] = sigm(v[j]);
    }
    v4u o; o.x = cvtpk(v[0], v[1]); o.y = cvtpk(v[2], v[3]); o.z = cvtpk(v[4], v[5]); o.w = cvtpk(v[6], v[7]);
    *(GAS v4u*)(alora + (size_t)m * KLORA + c8) = o;
}
__device__ __forceinline__ void lora_prep_panel(const Frame& F, const float* mu, int pm) {
    for (int it = F.tid; it < 256 * 32; it += NWAVES * 64) { const int r = it >> 5, m = pm * 256 + r;
        if (r == 0 && (m & (SEQ - 1)) != 0) continue;
        lora_prep_piece(F, mu, m, (it & 31) * 8); }
}
__device__ __forceinline__ void lora_prep_edges(const Frame& F, const float* mu, int n0) {
    if ((n0 & 15) == 0 && n0 != 0) { const int b = F.tid >> 5, m = b * SEQ + n0 * 16; lora_prep_piece(F, mu, m, (F.tid & 31) * 8); }
    asm volatile("s_waitcnt vmcnt(0)" ::: "memory");
    __syncthreads();
}
__device__ __forceinline__ void lora_prep_edges_grp(const Frame& F, const float* mu, int g, int q) {
    if (F.tid < 128) { const int e = F.tid >> 5, b = 2 * g + (e & 1), n = 32 * q + 16 * (e >> 1);
        if (n != 0) lora_prep_piece(F, mu, b * SEQ + n * 16, (F.tid & 31) * 8); }
    asm volatile("s_waitcnt vmcnt(0)" ::: "memory");
    __syncthreads();
}
constexpr int M1_PW = 14592;
constexpr int M1_EL = 0;
constexpr int M1_AT = 0, M1_BT = 2304, M1_KT = 4608, M1_RT = 6912;
constexpr int M1_TMP = 0, M1_SM = 2304, M1_AHT = 2304 + 8 * 1024;
constexpr int M1W_LD = 72, M1G_LD = 136;
constexpr int M1W_W = NWAVES * M1_PW, M1W_A = M1W_W + 64 * M1W_LD * 2, M1W_G = M1W_A + 64 * M1W_LD * 2, M1W_END = M1W_G + 64 * M1G_LD * 2;
constexpr int M1W_PRM = M1W_END;
static_assert(M1_AHT + 4096 == M1_PW && M1W_PRM + 8 * 64 * 4 <= LDSCTL_OFF && (M1W_W % 16) == 0 && (M1W_PRM % 16) == 0, "M1 LDS");
__device__ __forceinline__ float bfu(unsigned short x) { return __builtin_bit_cast(float, (unsigned)x << 16); }
__device__ __forceinline__ unsigned short bf1(float x) { return (unsigned short)(cvtpk(x, x) & 0xffffu); }
typedef unsigned u32x2_t __attribute__((ext_vector_type(2)));
__device__ __forceinline__ f32x4 bf4(u32x2_t u) { return (f32x4){bf_lo(u[0]), bf_hi(u[0]), bf_lo(u[1]), bf_hi(u[1])}; }
#define LBAR() do { asm volatile("s_waitcnt lgkmcnt(0)" ::: "memory"); __builtin_amdgcn_s_barrier(); asm volatile("" ::: "memory"); } while (0)
#define M1_WAIT() asm volatile("s_waitcnt lgkmcnt(0)" ::: "memory")
__device__ __forceinline__ bf16* slot_mix(const Frame& F, size_t m, int h) { return (bf16*)(F.ws + WS_MIXED) + m * DM + h * 64; }
__device__ __forceinline__ bf16* slot_lw(const Frame& F, size_t m, int h) { return (bf16*)(F.lora) + m * NLORA + h * 64; }
__device__ __forceinline__ bf16* slot_la(const Frame& F, size_t m, int h) { return (bf16*)(F.lora) + m * NLORA + 512 + h * 64; }
__device__ __forceinline__ bf16* slot_pr(const Frame& F, size_t m, int h) { return (bf16*)(F.ws + WS_H) + m * NPROJ + h * 64; }
__device__ __forceinline__ bf16* slot_pk(const Frame& F, size_t m, int h) { return (bf16*)(F.ws + WS_H) + m * NPROJ + 512 + h * 64; }
__device__ __forceinline__ bf16* slot_pv(const Frame& F, size_t m, int h) { return (bf16*)(F.ws + WS_H) + m * NPROJ + 1024 + h * 64; }
typedef short bf16x4 __attribute__((ext_vector_type(4)));
#define M2_K16(p) (*(const LAS bf16x4*)(p))
#define M2_MFMA16(a, b, c) __builtin_amdgcn_mfma_f32_16x16x16bf16_1k(a, b, c, 0, 0, 0)
#define M2_TR16(p) __builtin_amdgcn_ds_read_tr16_b64_v4i16((LAS bf16x4*)(p))
__device__ __forceinline__ bf16x4 m2_acc_op(const f32x4& d) { u32x2_t w_; w_[0] = cvtpk(d[0], d[1]); w_[1] = cvtpk(d[2], d[3]); return __builtin_bit_cast(bf16x4, w_); }
struct M1Alf { bf16x8 f[8]; };
__device__ __forceinline__ void m1_alf_issue(const Frame& F, int u, int lane, M1Alf& A) {
    const int n = u & 127, b = u >> 10; const size_t mb = (size_t)b * SEQ + n * 16;
    const bf16* AL = (const bf16*)(F.ws + WS_ALORA) + (mb + (lane & 15)) * KLORA + 8 * (lane >> 4);
#pragma unroll
    for (int ks = 0; ks < 8; ++ks) asm volatile("global_load_dwordx4 %0, %1, off" : "+v"(A.f[ks]) : "v"(AL + 32 * ks) : "memory");
}
#define M1_ALF_WAIT(A) asm volatile("s_waitcnt vmcnt(0)" : "+v"((A).f[0]), "+v"((A).f[1]), "+v"((A).f[2]), "+v"((A).f[3]), "+v"((A).f[4]), "+v"((A).f[5]), "+v"((A).f[6]), "+v"((A).f[7]) :: "memory")
__device__ __forceinline__ void rwkv_m1_unit(const Frame& F, const LayerP& L, int u, int u_next, M1Alf& ALF, LAS unsigned char* wl) {
    const int n = u & 127, h = (u >> 7) & 7, b = u >> 10;
    int ln_ = F.lane; asm volatile("" : "+v"(ln_));
    const int lane = ln_, lr = lane & 15, lq = lane >> 4, te = lane >> 2, c0 = (lane & 3) * 16, ch = h * 64 + c0;
    const size_t mb = (size_t)b * SEQ + n * 16, m = mb + te;
    const bf16* P = (const bf16*)(F.ws + WS_H) + m * NPROJ;
    const bool hasp = (te > 0) || (n > 0);
    const bf16* Pp = (te > 0) ? (P - NPROJ) : ((const bf16*)(F.ws + WS_SIDE) + ((size_t)b * 128 + (n > 0 ? n - 1 : 0)) * 1536);
    v4u rc[2], kc[2], vc[2], rp[2], kp[2], vp[2], lw[2], la[2];
#pragma unroll
    for (int hh = 0; hh < 2; ++hh) { rc[hh] = *(const GAS v4u*)(P + ch + 8 * hh); kc[hh] = *(const GAS v4u*)(P + 512 + ch + 8 * hh); vc[hh] = *(const GAS v4u*)(P + 1024 + ch + 8 * hh);
        rp[hh] = (v4u){0u, 0u, 0u, 0u}; kp[hh] = rp[hh]; vp[hh] = rp[hh];
        if (hasp) { rp[hh] = *(const GAS v4u*)(Pp + ch + 8 * hh); kp[hh] = *(const GAS v4u*)(Pp + 512 + ch + 8 * hh); vp[hh] = *(const GAS v4u*)(Pp + 1024 + ch + 8 * hh); } }
    {   bf16x8 alf[8];
#pragma unroll
        for (int ks = 0; ks < 8; ++ks) alf[ks] = ALF.f[ks];
        LAS bf16* WW = (LAS bf16*)(F.lds + M1W_W); LAS bf16* WA = (LAS bf16*)(F.lds + M1W_A); LAS bf16* WG = (LAS bf16*)(F.lds + M1W_G);
        LAS bf16* LWs = (LAS bf16*)(wl + M1_AT); LAS bf16* LAs = (LAS bf16*)(wl + M1_BT);
        const f32x4 z4l = (f32x4){0.f, 0.f, 0.f, 0.f};
#pragma unroll
        for (int ct = 0; ct < 4; ++ct) {
            f32x4 dw = z4l, da = z4l, dg = z4l;
#pragma unroll
            for (int ks = 0; ks < 2; ++ks) {
                dw = __builtin_amdgcn_mfma_f32_16x16x32_bf16(*(const LAS bf16x8*)(WW + (16 * ct + lr) * M1W_LD + 32 * ks + 8 * lq), alf[ks], dw, 0, 0, 0);
                da = __builtin_amdgcn_mfma_f32_16x16x32_bf16(*(const LAS bf16x8*)(WA + (16 * ct + lr) * M1W_LD + 32 * ks + 8 * lq), alf[2 + ks], da, 0, 0, 0); }
#pragma unroll
            for (int ks = 0; ks < 4; ++ks)
                dg = __builtin_amdgcn_mfma_f32_16x16x32_bf16(*(const LAS bf16x8*)(WG + (16 * ct + lr) * M1G_LD + 32 * ks + 8 * lq), alf[4 + ks], dg, 0, 0, 0);
            u32x2_t wv; wv[0] = cvtpk(dw[0], dw[1]); wv[1] = cvtpk(dw[2], dw[3]); *(LAS u32x2_t*)(LWs + lr * 72 + 16 * ct + 4 * lq) = wv;
            wv[0] = cvtpk(da[0], da[1]); wv[1] = cvtpk(da[2], da[3]); *(LAS u32x2_t*)(LAs + lr * 72 + 16 * ct + 4 * lq) = wv;
            wv[0] = cvtpk(dg[0], dg[1]); wv[1] = cvtpk(dg[2], dg[3]); *(GAS u32x2_t*)((bf16*)(F.lora) + (mb + lr) * NLORA + 1024 + h * 64 + 16 * ct + 4 * lq) = wv; }
        m1_alf_issue(F, u_next, lane, ALF);
        M1_WAIT();
#pragma unroll
        for (int hh = 0; hh < 2; ++hh) { lw[hh] = *(const LAS v4u*)(LWs + te * 72 + c0 + 8 * hh); la[hh] = *(const LAS v4u*)(LAs + te * 72 + c0 + 8 * hh); }
        M1_WAIT();
    }
    float r[16], kh[16], v[16], al[16], e[16], kraw[16]; float ss = 0.f, bs = 0.f;
#pragma unroll
    for (int q = 0; q < 4; ++q) { const int cc = ch + 4 * q; const int hh = q >> 1, w2 = (q & 1) * 2;
        const LAS float* PR = (const LAS float*)(F.lds + M1W_PRM) + c0 + 4 * q;
        const f32x4 mur = *(const LAS f32x4*)(PR), muk = *(const LAS f32x4*)(PR + 64), muv = *(const LAS f32x4*)(PR + 128), w0p = *(const LAS f32x4*)(PR + 192), a0p = *(const LAS f32x4*)(PR + 256);
        const f32x4 kkp = *(const LAS f32x4*)(PR + 320), kap = *(const LAS f32x4*)(PR + 384), rkp = *(const LAS f32x4*)(PR + 448);
#pragma unroll
        for (int j = 0; j < 4; ++j) { const int i = 4 * q + j; const unsigned sh = (j & 1) ? 0xffff0000u : 0u; const int wd = w2 + (j >> 1);
#define M1_BF(x) ((j & 1) ? bf_hi((x)[hh][wd]) : bf_lo((x)[hh][wd]))
            const float rcv = M1_BF(rc), kcv = M1_BF(kc), vcv = M1_BF(vc), rpv = M1_BF(rp), kpv = M1_BF(kp), vpv = M1_BF(vp), lwv = M1_BF(lw), lav = M1_BF(la);
#undef M1_BF
            (void)sh;
            r[i] = rcv + mur[j] * (rpv - rcv); const float ks = kcv + muk[j] * (kpv - kcv); v[i] = vcv + muv[j] * (vpv - vcv);
            al[i] = sigm(a0p[j] + lav); e[i] = 0.6065306597126334f * sigm(w0p[j] + lwv);
            kraw[i] = ks * kkp[j]; ss += kraw[i] * kraw[i];
            kh[i] = ks * (1.0f + (al[i] - 1.0f) * kap[j]); bs += r[i] * kh[i] * rkp[j]; } }
    ss += dpp_f<0xB1>(ss); ss += dpp_f<0x4E>(ss); bs += dpp_f<0xB1>(bs); bs += dpp_f<0x4E>(bs);
    const float inv = 1.0f / sqrtf(fmaxf(ss, 1e-24f));
    if ((lane & 3) == 0) ((GAS float*)slot_pv(F, mb + 14, h))[te] = bs;
    LAS float* EL = (LAS float*)(wl + M1_EL);
#pragma unroll
    for (int q = 0; q < 4; ++q) *(LAS f32x4*)(EL + te * 64 + c0 + 4 * q) = (f32x4){e[4 * q], e[4 * q + 1], e[4 * q + 2], e[4 * q + 3]};
    M1_WAIT();
    { float acc = 0.f;
#pragma unroll
      for (int t = 0; t < 16; ++t) { acc += EL[t * 64 + lane]; EL[t * 64 + lane] = acc; }
      ((GAS float*)slot_pv(F, mb + 12 + (lane >> 5), h))[lane & 31] = __expf(-acc); }
    M1_WAIT();
    float Lt[16], LC[16];
#pragma unroll
    for (int q = 0; q < 4; ++q) { const f32x4 a4 = *(const LAS f32x4*)(EL + te * 64 + c0 + 4 * q), b4 = *(const LAS f32x4*)(EL + 15 * 64 + c0 + 4 * q);
#pragma unroll
        for (int j = 0; j < 4; ++j) { Lt[4 * q + j] = a4[j]; LC[4 * q + j] = b4[j]; } }
    M1_WAIT();
    unsigned pat[8], pbt[8], pkt[8], prt[8], pbh[8], pkh[8], pv[8];
#pragma unroll
    for (int i2 = 0; i2 < 8; ++i2) { float at2[2], bt2[2], kt2[2], rt2[2], bh2[2], kh2[2];
#pragma unroll
        for (int s = 0; s < 2; ++s) { const int i = 2 * i2 + s; const float x1 = __expf(Lt[i]), x1i = __builtin_amdgcn_rcpf(x1), xm1 = x1i * __expf(e[i]), xc = __expf(Lt[i] - LC[i]);
            const float kn = kraw[i] * inv, ba = kn * al[i];
            at2[s] = -kn * xm1; bt2[s] = ba * x1; kt2[s] = kh[i] * x1; rt2[s] = r[i] * x1i; bh2[s] = ba * xc; kh2[s] = kh[i] * xc; }
        pat[i2] = cvtpk(at2[0], at2[1]); pbt[i2] = cvtpk(bt2[0], bt2[1]); pkt[i2] = cvtpk(kt2[0], kt2[1]); prt[i2] = cvtpk(rt2[0], rt2[1]);
        pbh[i2] = cvtpk(bh2[0], bh2[1]); pkh[i2] = cvtpk(kh2[0], kh2[1]); pv[i2] = cvtpk(v[2 * i2], v[2 * i2 + 1]); }
    LAS bf16* AT = (LAS bf16*)(wl + M1_AT); LAS bf16* BT = (LAS bf16*)(wl + M1_BT); LAS bf16* KT = (LAS bf16*)(wl + M1_KT); LAS bf16* RT = (LAS bf16*)(wl + M1_RT);
#pragma unroll
    for (int hh = 0; hh < 2; ++hh) {
        *(LAS v4u*)(AT + te * 72 + c0 + 8 * hh) = (v4u){pat[4 * hh], pat[4 * hh + 1], pat[4 * hh + 2], pat[4 * hh + 3]};
        *(LAS v4u*)(BT + te * 72 + c0 + 8 * hh) = (v4u){pbt[4 * hh], pbt[4 * hh + 1], pbt[4 * hh + 2], pbt[4 * hh + 3]};
        *(LAS v4u*)(KT + te * 72 + c0 + 8 * hh) = (v4u){pkt[4 * hh], pkt[4 * hh + 1], pkt[4 * hh + 2], pkt[4 * hh + 3]};
        const v4u rr = (v4u){prt[4 * hh], prt[4 * hh + 1], prt[4 * hh + 2], prt[4 * hh + 3]};
        *(LAS v4u*)(RT + te * 72 + c0 + 8 * hh) = rr; *(GAS v4u*)(slot_lw(F, m, h) + c0 + 8 * hh) = rr; }
    M1_WAIT();
    const bf16x8 at0 = *(const LAS bf16x8*)(AT + lr * 72 + 8 * lq), at1 = *(const LAS bf16x8*)(AT + lr * 72 + 32 + 8 * lq);
    const bf16x8 b0 = *(const LAS bf16x8*)(BT + lr * 72 + 8 * lq), b1 = *(const LAS bf16x8*)(BT + lr * 72 + 32 + 8 * lq);
    const bf16x8 k0 = *(const LAS bf16x8*)(KT + lr * 72 + 8 * lq), k1 = *(const LAS bf16x8*)(KT + lr * 72 + 32 + 8 * lq);
    const bf16x8 r0 = *(const LAS bf16x8*)(RT + lr * 72 + 8 * lq), r1 = *(const LAS bf16x8*)(RT + lr * 72 + 32 + 8 * lq);
    M1_WAIT();
    const f32x4 z4 = (f32x4){0.f, 0.f, 0.f, 0.f};
    f32x4 dL = z4, dLt = z4, dKt = z4, dRb = z4, dRk = z4;
    dL = __builtin_amdgcn_mfma_f32_16x16x32_bf16(b0, at0, dL, 0, 0, 0); dL = __builtin_amdgcn_mfma_f32_16x16x32_bf16(b1, at1, dL, 0, 0, 0);
    dLt = __builtin_amdgcn_mfma_f32_16x16x32_bf16(at0, b0, dLt, 0, 0, 0); dLt = __builtin_amdgcn_mfma_f32_16x16x32_bf16(at1, b1, dLt, 0, 0, 0);
    dKt = __builtin_amdgcn_mfma_f32_16x16x32_bf16(at0, k0, dKt, 0, 0, 0); dKt = __builtin_amdgcn_mfma_f32_16x16x32_bf16(at1, k1, dKt, 0, 0, 0);
    dRb = __builtin_amdgcn_mfma_f32_16x16x32_bf16(b0, r0, dRb, 0, 0, 0); dRb = __builtin_amdgcn_mfma_f32_16x16x32_bf16(b1, r1, dRb, 0, 0, 0);
    dRk = __builtin_amdgcn_mfma_f32_16x16x32_bf16(k0, r0, dRk, 0, 0, 0); dRk = __builtin_amdgcn_mfma_f32_16x16x32_bf16(k1, r1, dRk, 0, 0, 0);
    f32x4 eye;
#pragma unroll
    for (int i = 0; i < 4; ++i) { const int rr = 4 * lq + i; eye[i] = (rr == lr) ? 1.0f : 0.0f;
        dL[i] = (rr < lr) ? dL[i] : 0.f; dLt[i] = (lr < rr) ? dLt[i] : 0.f; dKt[i] = (lr < rr) ? dKt[i] : 0.f; dRb[i] = (rr <= lr) ? dRb[i] : 0.f; dRk[i] = (rr <= lr) ? dRk[i] : 0.f; }
    {
        u32x2_t wv; wv[0] = cvtpk(dRb[0], dRb[1]); wv[1] = cvtpk(dRb[2], dRb[3]); *(GAS u32x2_t*)(slot_pv(F, mb + 4 + (lr >> 2), h) + (lr & 3) * 16 + 4 * lq) = wv;
        wv[0] = cvtpk(dRk[0], dRk[1]); wv[1] = cvtpk(dRk[2], dRk[3]); *(GAS u32x2_t*)(slot_pv(F, mb + 8 + (lr >> 2), h) + (lr & 3) * 16 + 4 * lq) = wv; }
#pragma unroll
    for (int hh = 0; hh < 2; ++hh) {
        *(GAS v4u*)(slot_pr(F, m, h) + c0 + 8 * hh) = (v4u){pbh[4 * hh], pbh[4 * hh + 1], pbh[4 * hh + 2], pbh[4 * hh + 3]};
        *(GAS v4u*)(slot_pk(F, m, h) + c0 + 8 * hh) = (v4u){pkh[4 * hh], pkh[4 * hh + 1], pkh[4 * hh + 2], pkh[4 * hh + 3]};
        *(GAS v4u*)(slot_la(F, m, h) + c0 + 8 * hh) = (v4u){pv[4 * hh], pv[4 * hh + 1], pv[4 * hh + 2], pv[4 * hh + 3]}; }
    {
        const bf16x4 fL = m2_acc_op(dL), fLt = m2_acc_op(dLt);
        const f32x4 z4b = (f32x4){0.f, 0.f, 0.f, 0.f};
        const f32x4 dL2 = M2_MFMA16(fL, fLt, z4b), dL2t = M2_MFMA16(fLt, fL, z4b);
        f32x4 dTt = dL + eye;
        const bf16x4 fL2t = m2_acc_op(dL2), fL2 = m2_acc_op(dL2t);
        dTt = M2_MFMA16(fL2t, m2_acc_op(dTt), dTt);
        const f32x4 dL4 = M2_MFMA16(fL2, fL2t, z4b), dL4t = M2_MFMA16(fL2t, fL2, z4b);
        const bf16x4 fL4t = m2_acc_op(dL4), fL4 = m2_acc_op(dL4t);
        dTt = M2_MFMA16(fL4t, m2_acc_op(dTt), dTt);
        const f32x4 dL8 = M2_MFMA16(fL4, fL4t, z4b);
        dTt = M2_MFMA16(m2_acc_op(dL8), m2_acc_op(dTt), dTt);
        const bf16x4 tq = m2_acc_op(dTt);
        const f32x4 nn = M2_MFMA16(m2_acc_op(dKt), tq, z4b);
        u32x2_t wv; wv[0] = cvtpk(nn[0], nn[1]); wv[1] = cvtpk(nn[2], nn[3]); *(GAS u32x2_t*)(slot_pv(F, mb + (lr >> 2), h) + (lr & 3) * 16 + 4 * lq) = wv;
#pragma unroll
        for (int tc = 0; tc < 4; ++tc) { const bf16x4 ah = __builtin_amdgcn_ds_read_tr16_b64_v4i16((LAS bf16x4*)(AT + (4 * lq + (lr >> 2)) * 72 + 16 * tc + 4 * (lr & 3)));
            const f32x4 pq = M2_MFMA16(ah, tq, z4b);
            wv[0] = cvtpk(pq[0], pq[1]); wv[1] = cvtpk(pq[2], pq[3]); *(GAS u32x2_t*)(slot_mix(F, mb + lr, h) + 16 * tc + 4 * lq) = wv; }
    }
    M1_WAIT();
    M1_ALF_WAIT(ALF);
}

__device__ __forceinline__ void rwkv_m1_phase(const Frame& F, const LayerP& L) {
    LAS unsigned char* wl = F.lds + RING_OFF + F.wave * M1_PW;
    const int NGW = F.G * NWAVES; int hcur = -1;
    const bool GL = (F.G == 256); const int grp = F.vcu >> 5, li = F.vcu & 31;
    if (GL) lora_prep_edges_grp(F, L.mu, grp, li & 3);
    M1Alf ALF;
#pragma unroll
    for (int ks = 0; ks < 8; ++ks) ALF.f[ks] = (bf16x8){0, 0, 0, 0, 0, 0, 0, 0};
    {   int ul_ = F.lane; asm volatile("" : "+v"(ul_));
        const int uf = (GL ? (((2 * grp) << 10) | ((li >> 2) << 7) | (32 * (li & 3))) : F.vcu * NWAVES) + F.wave;
        m1_alf_issue(F, uf < BATCH * 8 * 128 ? uf : 0, ul_, ALF); M1_ALF_WAIT(ALF); }
    for (int r = 0;; ++r) {
        const int u0 = GL ? (((2 * grp + (r & 1)) << 10) | ((li >> 2) << 7) | (32 * (li & 3) + 8 * (r >> 1))) : F.vcu * NWAVES + r * NGW;
        if (GL ? (r >= 8) : (u0 >= BATCH * 8 * 128)) break;
        const int h = (u0 >> 7) & 7;
        if (h != hcur) {
            if (hcur >= 0) __syncthreads();
            const bf16* W = L.wlora; const int t = F.tid, row = t >> 3, pc = (t & 7) * 8;
            *(LAS v4u*)(F.lds + M1W_W + (row * M1W_LD + pc) * 2) = *(const GAS v4u*)(W + (size_t)(h * 64 + row) * KLORA + pc);
            *(LAS v4u*)(F.lds + M1W_A + (row * M1W_LD + pc) * 2) = *(const GAS v4u*)(W + (size_t)(512 + h * 64 + row) * KLORA + 64 + pc);
#pragma unroll
            for (int j = 0; j < 2; ++j) *(LAS v4u*)(F.lds + M1W_G + (row * M1G_LD + 64 * j + pc) * 2) = *(const GAS v4u*)(W + (size_t)(1024 + h * 64 + row) * KLORA + 128 + 64 * j + pc);
            if (t < 128) { const int pr = t >> 4, c4 = (t & 15) * 4;
                const float* src = pr == 0 ? L.mu : (pr == 1 ? L.mu + 512 : (pr == 2 ? L.mu + 1024 : (pr == 3 ? L.w0 : (pr == 4 ? L.a0 : (pr == 5 ? L.k_k : (pr == 6 ? L.k_a : L.r_k))))));
                *(LAS f32x4*)((LAS float*)(F.lds + M1W_PRM) + pr * 64 + c4) = *(const f32x4*)(src + h * 64 + c4); }
            __syncthreads(); hcur = h; }
        const int u = u0 + F.wave;
        int un = GL ? ((((2 * grp + ((r + 1) & 1)) << 10) | ((li >> 2) << 7) | (32 * (li & 3) + 8 * ((r + 1) >> 1))) + F.wave) : u + NGW;
        if (GL ? (r + 1 >= 8) : (un >= BATCH * 8 * 128)) un = u;
        if (u < BATCH * 8 * 128) rwkv_m1_unit(F, L, u, un, ALF, wl);
    }
}
constexpr int S2_PM = 0, S2_NM = S2_PM + 2304, S2_RT = S2_NM + 1280, S2_MRB = S2_RT + 2304, S2_MRK = S2_MRB + 1280, S2_BH = S2_MRK + 1280, S2_KH = S2_BH + 2560, S2_VS = S2_KH + 2560,
              S2_GC = S2_VS + 2560, S2_RK = S2_GC + 256, S2_SET = S2_RK + 64;
constexpr int S2_SAT = 3 * S2_SET, S2_S = S2_SAT + 5120, S2_YB = S2_S + 2 * 9216, S2_PRM = S2_YB + 2 * 4352, S2_END = S2_PRM + 512;
static_assert(S2_END <= RING_BYTES && (S2_SET % 16) == 0 && (S2_S % 16) == 0 && (S2_YB % 16) == 0, "M2 LDS");
struct M2Raw { v4u a, b, c; };
struct M2Ptr { const bf16 *pa, *pb, *pc; };
__device__ __forceinline__ void m2_ptr0(const Frame& F, int b, int h, int i, M2Ptr& P) {
    const size_t mb = (size_t)b * SEQ; const int i7 = i & 127, row = i7 >> 3, chk = i7 & 7;
    P.pa = (i < 128 ? slot_mix(F, mb + row, h) : slot_lw(F, mb + row, h)) + chk * 8;
    P.pb = (i < 128 ? slot_la(F, mb + row, h) : slot_pr(F, mb + row, h)) + chk * 8;
    const int k1 = i - 128, k2 = i - 224, k3 = i - 240;
    const int tok = i < 128 ? row : (i < 224 ? (k1 >> 3) : (i < 240 ? 12 + (k2 >> 3) : 14));
    const int col = i < 128 ? 512 + chk * 8 : 1024 + (i < 224 ? (k1 & 7) : (i < 240 ? (k2 & 7) : (k3 & 3))) * 8;
    P.pc = (const bf16*)(F.ws + WS_H) + (mb + tok) * NPROJ + h * 64 + col;
}
__device__ __forceinline__ void m2_adv(M2Ptr& P, int i) { P.pa += (i < 128 ? 16 * DM : 16 * NLORA); P.pb += (i < 128 ? 16 * NLORA : 16 * NPROJ); P.pc += 16 * NPROJ; }
__device__ __forceinline__ void m2_load(const M2Ptr& P, M2Raw& R) {
    asm volatile("global_load_dwordx4 %0, %1, off" : "+v"(R.a) : "v"(P.pa) : "memory");
    asm volatile("global_load_dwordx4 %0, %1, off" : "+v"(R.b) : "v"(P.pb) : "memory");
    asm volatile("global_load_dwordx4 %0, %1, off" : "+v"(R.c) : "v"(P.pc) : "memory");
}
#define M2_WAIT_R(R, N) asm volatile("s_waitcnt vmcnt(" #N ")" : "+v"((R).a), "+v"((R).b), "+v"((R).c) :: "memory")
#define M2_WAIT_G(G, N) asm volatile("s_waitcnt vmcnt(" #N ")" : "+v"(G) :: "memory")
__device__ __forceinline__ void g_load(const bf16* p, u32x2_t& G) { asm volatile("global_load_dwordx2 %0, %1, off" : "+v"(G) : "v"(p) : "memory"); }
struct M2Off { int a, b, c; };
__device__ __forceinline__ void m2_off(int i, M2Off& O) {
    const int i7 = i & 127, row = i7 >> 3, chk = i7 & 7;
    O.a = (i < 128 ? S2_PM : S2_RT) + (row * 72 + chk * 8) * 2;
    O.b = (i < 128 ? S2_VS : S2_BH) + (row * 80 + chk * 8) * 2;
    int c = -1;
    if (i < 128) c = S2_KH + (row * 80 + chk * 8) * 2;
    else if (i < 224) { const int k = i - 128, mat = k >> 5, kk = k & 31, t = kk >> 1, hf = kk & 1;
        c = (mat == 0 ? S2_NM : (mat == 1 ? S2_MRB : S2_MRK)) + (t * 40 + hf * 8) * 2; }
    else if (i < 240) c = S2_GC + (i - 224) * 16;
    else if (i < 244) c = S2_RK + (i - 240) * 16;
    O.c = c;
}
__device__ __forceinline__ void m2_store(LAS unsigned char* set, const M2Off& O, const M2Raw& R) {
    *(LAS v4u*)(set + O.a) = R.a; *(LAS v4u*)(set + O.b) = R.b;
    if (O.c >= 0) *(LAS v4u*)(set + O.c) = R.c;
}
#define M2_LDR_ITER(RSET, GSET) \
    { \
        const int pt = tl_ & 255, te = pt >> 4, c4 = (pt & 15) * 4; \
        { \
            LAS unsigned char* SP = lds + ((n + 2) % 3) * S2_SET; \
            const LAS float* PRM = (const LAS float*)(lds + S2_PRM) + c4; \
            const u32x2_t vraw = *(const LAS u32x2_t*)((const LAS bf16*)(SP + S2_VS) + te * 80 + c4); \
            const f32x4 y = *(const LAS f32x4*)((LAS float*)(lds + S2_YB) + ((n + 1) & 1) * 1088 + te * 68 + c4); \
            const f32x4 lnw = *(const LAS f32x4*)(PRM), lnb = *(const LAS f32x4*)(PRM + 64); \
            const f32x4 vv = bf4(vraw); \
            const float bonus = ((const LAS float*)(SP + S2_RK))[te]; \
            __builtin_amdgcn_sched_barrier(0); \
            float s1 = (y[0] + y[1]) + (y[2] + y[3]), s2 = (y[0] * y[0] + y[1] * y[1]) + (y[2] * y[2] + y[3] * y[3]);        \
            s1 += dpp_f<0xB1>(s1); s2 += dpp_f<0xB1>(s2); s1 += dpp_f<0x4E>(s1); s2 += dpp_f<0x4E>(s2); s1 += dpp_f<0x141>(s1); s2 += dpp_f<0x141>(s2); s1 += dpp_f<0x140>(s1); s2 += dpp_f<0x140>(s2); \
            const float mean = s1 * (1.0f / 64.0f), var = fmaxf(s2 * (1.0f / 64.0f) - mean * mean, 0.0f); \
            const f32x4 d = y - mean; \
            const float rstd = __builtin_amdgcn_rsqf(var + LN_X_EPS); \
            M2_WAIT_G(GSET, 18); \
            const f32x4 o = (d * rstd * lnw + lnb + vv * bonus) * bf4(GSET); \
            u32x2_t wv; wv[0] = cvtpk(o[0], o[1]); wv[1] = cvtpk(o[2], o[3]); \
            const bool live = n >= 1 && n <= NCH;                                     \
            GAS u32x2_t* dst = live ? (GAS u32x2_t*)(op) : (GAS u32x2_t*)(dump); \
            *dst = wv; \
            if (live) op += 16 * DM; \
            g_load(gq, GSET); if (n + 4 < NCH) gq += 16 * NLORA; \
        } \
        M2_WAIT_R(RSET, 17); \
        if (n + 1 < NCH) m2_store(lds + ((n + 1) % 3) * S2_SET, OFF, RSET); \
        m2_load(P, RSET); if (n + 6 < NCH) m2_adv(P, pt); \
        LBAR(); \
    }
#define M2_ST_ITER() \
    { \
        const int lane = tl_ & 63, lr = lane & 15, lq = lane >> 4, q = w - 4; \
        if (n < NCH) { \
            LAS unsigned char* SC = lds + (n % 3) * S2_SET; \
            LAS bf16* PM = (LAS bf16*)(SC + S2_PM); LAS bf16* NM = (LAS bf16*)(SC + S2_NM); LAS bf16* VS = (LAS bf16*)(SC + S2_VS); LAS bf16* RT = (LAS bf16*)(SC + S2_RT); \
            LAS bf16* MRB = (LAS bf16*)(SC + S2_MRB); LAS bf16* MRK = (LAS bf16*)(SC + S2_MRK); LAS bf16* BH = (LAS bf16*)(SC + S2_BH); LAS bf16* KH = (LAS bf16*)(SC + S2_KH); \
            const int trow = (4 * lq + (lr >> 2)) * 80 + 4 * (lr & 3);                  \
            bf16x4 pf[4], rf[4], bhf[4], khf[4]; f32x4 gc[4]; \
            _Pragma("unroll") \
            for (int kt = 0; kt < 4; ++kt) { pf[kt] = M2_K16(PM + lr * 72 + 16 * kt + 4 * lq); rf[kt] = M2_K16(RT + lr * 72 + 16 * kt + 4 * lq); \
                bhf[kt] = M2_TR16(BH + trow + 16 * kt); khf[kt] = M2_TR16(KH + trow + 16 * kt); \
                gc[kt] = *(const LAS f32x4*)((LAS float*)(SC + S2_GC) + 16 * kt + 4 * lq); } \
            const bf16x4 nf = M2_K16(NM + lr * 40 + 4 * lq), mbf = M2_K16(MRB + lr * 40 + 4 * lq), mkf = M2_K16(MRK + lr * 40 + 4 * lq), vf = M2_TR16(VS + trow + 16 * q); \
            __builtin_amdgcn_sched_barrier(0); \
            bf16x4 so[4]; \
            _Pragma("unroll") \
            for (int kt = 0; kt < 4; ++kt) so[kt] = m2_acc_op(accS[kt]); \
            const f32x4 z4_ = (f32x4){0.f, 0.f, 0.f, 0.f}; \
            f32x4 sa = M2_MFMA16(nf, vf, z4_), sb = z4_, ya = M2_MFMA16(mkf, vf, z4_), yb = z4_; \
            sa = M2_MFMA16(pf[0], so[0], sa); sb = M2_MFMA16(pf[1], so[1], sb); sa = M2_MFMA16(pf[2], so[2], sa); sb = M2_MFMA16(pf[3], so[3], sb); \
            ya = M2_MFMA16(rf[0], so[0], ya); yb = M2_MFMA16(rf[1], so[1], yb); ya = M2_MFMA16(rf[2], so[2], ya); yb = M2_MFMA16(rf[3], so[3], yb); \
            sa = sa + sb; \
            const bf16x4 sao = m2_acc_op(sa); \
            ya = M2_MFMA16(mbf, sao, ya); \
            _Pragma("unroll") \
            for (int kt = 0; kt < 4; ++kt) { accS[kt] = accS[kt] * gc[kt]; accS[kt] = M2_MFMA16(bhf[kt], sao, accS[kt]); accS[kt] = M2_MFMA16(khf[kt], vf, accS[kt]); } \
            ya = ya + yb;                                                            \
            LAS float* YBs = (LAS float*)(lds + S2_YB) + (n & 1) * 1088 + 16 * q + lr; \
            _Pragma("unroll") \
            for (int i = 0; i < 4; ++i) YBs[(4 * lq + i) * 68] = ya[i]; \
        } \
        LBAR(); \
    }
__device__ __forceinline__ void rwkv_m2_unit(const Frame& F, const LayerP& L, int unit) {
    const int b = unit >> 3, h = unit & 7;
    LAS unsigned char* lds = F.lds + RING_OFF;
    const int tid = F.tid, w = F.wave;
    const bool ldr = w < 4;
    constexpr int NCH = SEQ / 16;
    int tl_ = tid; asm volatile("" : "+v"(tl_));
    for (int i = tid; i < S2_PRM / 4; i += NWAVES * 64) ((LAS unsigned*)lds)[i] = 0u;
    if (tid < 32) { const int row = tid >> 4, c = (tid & 15) * 4; *(LAS f32x4*)((LAS float*)(lds + S2_PRM) + row * 64 + c) = *(const f32x4*)((row == 0 ? L.ln_w : L.ln_b) + h * 64 + c); }
    __syncthreads();
    if (ldr) {
        M2Raw R0, R1, R2, R3; R0.a = (v4u){0u, 0u, 0u, 0u}; R0.b = R0.a; R0.c = R0.a; R1 = R0; R2 = R0; R3 = R0;
        u32x2_t G0 = (u32x2_t){0u, 0u}, G1 = G0, G2 = G0, G3 = G0;
        const int pt = tid, te = pt >> 4, c4 = (pt & 15) * 4, ch = h * 64 + c4;
        M2Ptr P; m2_ptr0(F, b, h, pt, P);
        M2Off OFF; m2_off(pt, OFF);
        { M2Raw T = R0; m2_load(P, T); m2_adv(P, pt); M2_WAIT_R(T, 0); m2_store(lds, OFF, T); }
        const bf16* gq = (const bf16*)(F.lora) + ((size_t)b * SEQ + te) * NLORA + 1024 + ch;
        bf16* op = (bf16*)(F.ws + WS_MIXED) + ((size_t)b * SEQ + te) * DM + ch;
        bf16* dump = (bf16*)(F.ws + WS_DUMP) + ((size_t)F.vcu * 256 + pt) * 4;
#define M2_FILL(RSET, GSET, GADV) { *(GAS u32x2_t*)dump = (u32x2_t){0u, 0u}; g_load(gq, GSET); if (GADV) gq += 16 * NLORA; m2_load(P, RSET); m2_adv(P, pt); }
        M2_FILL(R1, G3, false) M2_FILL(R2, G0, true) M2_FILL(R3, G1, true) M2_FILL(R0, G2, true)
#undef M2_FILL
        __syncthreads();
        for (int n0 = 0; n0 <= NCH; n0 += 4) {
            { const int n = n0;     M2_LDR_ITER(R1, G3) }
            { const int n = n0 + 1; M2_LDR_ITER(R2, G0) }
            { const int n = n0 + 2; M2_LDR_ITER(R3, G1) }
            { const int n = n0 + 3; M2_LDR_ITER(R0, G2) }
        }
        asm volatile("s_waitcnt vmcnt(0)" ::: "memory");
    } else {
        f32x4 accS[4];
#pragma unroll
        for (int q = 0; q < 4; ++q) accS[q] = (f32x4){0.f, 0.f, 0.f, 0.f};
        __syncthreads();
        for (int n0 = 0; n0 <= NCH; n0 += 4) {
            { const int n = n0;     M2_ST_ITER() }
            { const int n = n0 + 1; M2_ST_ITER() }
            { const int n = n0 + 2; M2_ST_ITER() }
            { const int n = n0 + 3; M2_ST_ITER() }
        }
    }
    __syncthreads();
}
constexpr int RT_LD = 72, RT_K2LD = 80, RT_VLD = 144, RT_OLD = 132;
constexpr int RT_QS = 0, RT_KS = RT_QS + 64 * RT_LD * 2, RT_K2 = RT_KS + 64 * RT_LD * 2, RT_SC = RT_K2 + 64 * RT_K2LD * 2, RT_VS = RT_SC + 64 * RT_LD * 2, RT_PT = RT_VS + 64 * RT_VLD * 2,
              RT_OB = RT_PT + 128 * RT_LD * 2, RT_END = RT_OB + 64 * RT_OLD * 4;
static_assert(RT_END <= RING_BYTES && (RT_K2 % 16) == 0 && (RT_VS % 16) == 0 && (RT_OB % 16) == 0, "retention LDS");
typedef unsigned ret_u2 __attribute__((ext_vector_type(2)));
typedef short ret_s4 __attribute__((ext_vector_type(4)));
struct RetA { ret_u2 q1, q2, k1, k2; v4u va, vb; f32x4 cs, sn; };
struct RetG { v4u ga, gb; };
#define RET_LD2(dst, ptr) asm volatile("global_load_dwordx2 %0, %1, off" : "+v"(dst) : "v"(ptr) : "memory")
#define RET_LD4(dst, ptr) asm volatile("global_load_dwordx4 %0, %1, off" : "+v"(dst) : "v"(ptr) : "memory")
__device__ __forceinline__ void ret_load_a(const bf16* P, const float* CS, const float* SN, int h, int dq, RetA& R) {
    const int d = dq * 4, e0 = dq * 16;
    RET_LD2(R.q1, P + h * 64 + d); RET_LD2(R.q2, P + h * 64 + 32 + d); RET_LD2(R.k1, P + 256 + h * 64 + d); RET_LD2(R.k2, P + 256 + h * 64 + 32 + d);
    RET_LD4(R.va, P + 512 + h * 128 + e0); RET_LD4(R.vb, P + 512 + h * 128 + e0 + 8); RET_LD4(R.cs, CS + d); RET_LD4(R.sn, SN + d);
}
__device__ __forceinline__ void ret_load_g(const bf16* P, int h, int dq, RetG& R) { const int e0 = dq * 16; RET_LD4(R.ga, P + 1024 + h * 128 + e0); RET_LD4(R.gb, P + 1024 + h * 128 + e0 + 8); }
#define RET_WAIT_A(R, N) asm volatile("s_waitcnt vmcnt(" #N ")" : "+v"((R).q1), "+v"((R).q2), "+v"((R).k1), "+v"((R).k2), "+v"((R).va), "+v"((R).vb), "+v"((R).cs), "+v"((R).sn) :: "memory")
#define RET_WAIT_G(R, N) asm volatile("s_waitcnt vmcnt(" #N ")" : "+v"((R).ga), "+v"((R).gb) :: "memory")
__device__ __forceinline__ bf16x8 ret_tr(const LAS bf16* img, int ld, int r0, int c0, int lr, int lq) {
    const LAS bf16* p = img + (r0 + 4 * lq + (lr >> 2)) * ld + c0 + 4 * (lr & 3);
    const ret_s4 a = __builtin_amdgcn_ds_read_tr16_b64_v4i16((LAS ret_s4*)p), b = __builtin_amdgcn_ds_read_tr16_b64_v4i16((LAS ret_s4*)(p + 16 * ld));
    return __builtin_shufflevector(a, b, 0, 1, 2, 3, 4, 5, 6, 7);
}
__device__ __forceinline__ bf16x8 ret_rowp(const LAS bf16* row, int k0, int lq) {
    const ret_s4 a = *(const LAS ret_s4*)(row + k0 + 4 * lq), b = *(const LAS ret_s4*)(row + k0 + 16 + 4 * lq);
    return __builtin_shufflevector(a, b, 0, 1, 2, 3, 4, 5, 6, 7);
}
#define RET_ITER(A, G) \
    { \
        int tl_ = tid; asm volatile("" : "+v"(tl_)); \
        const int lane = tl_ & 63, lr = lane & 15, lq = lane >> 4, i = tl_ >> 3, dq = tl_ & 7, d = dq * 4, e0 = dq * 16; \
        const int n2 = (n + 2 < SEQ / 64) ? n + 2 : SEQ / 64 - 1; \
        const bf16* P2 = prow + (size_t)n2 * 64 * NPROJ; \
        {     \
            RET_WAIT_A(A, 16); \
            const f32x4 cs = A.cs, sn = A.sn; \
            f32x4 x1, x2; \
            x1[0] = bf_lo(A.q1[0]); x1[1] = bf_hi(A.q1[0]); x1[2] = bf_lo(A.q1[1]); x1[3] = bf_hi(A.q1[1]); \
            x2[0] = bf_lo(A.q2[0]); x2[1] = bf_hi(A.q2[0]); x2[2] = bf_lo(A.q2[1]); x2[3] = bf_hi(A.q2[1]); \
            f32x4 o1 = x1 * cs - x2 * sn, o2 = x1 * sn + x2 * cs; \
            ret_u2 wv; wv[0] = cvtpk(o1[0], o1[1]); wv[1] = cvtpk(o1[2], o1[3]); *(LAS ret_u2*)(QS + i * RT_LD + d) = wv; \
            wv[0] = cvtpk(o2[0], o2[1]); wv[1] = cvtpk(o2[2], o2[3]); *(LAS ret_u2*)(QS + i * RT_LD + 32 + d) = wv; \
            x1[0] = bf_lo(A.k1[0]); x1[1] = bf_hi(A.k1[0]); x1[2] = bf_lo(A.k1[1]); x1[3] = bf_hi(A.k1[1]); \
            x2[0] = bf_lo(A.k2[0]); x2[1] = bf_hi(A.k2[0]); x2[2] = bf_lo(A.k2[1]); x2[3] = bf_hi(A.k2[1]); \
            o1 = (x1 * cs - x2 * sn) * 0.125f; o2 = (x1 * sn + x2 * cs) * 0.125f; \
            wv[0] = cvtpk(o1[0], o1[1]); wv[1] = cvtpk(o1[2], o1[3]); *(LAS ret_u2*)(KS + i * RT_LD + d) = wv; \
            wv[0] = cvtpk(o2[0], o2[1]); wv[1] = cvtpk(o2[2], o2[3]); *(LAS ret_u2*)(KS + i * RT_LD + 32 + d) = wv; \
            o1 = o1 * kwi; o2 = o2 * kwi; \
            wv[0] = cvtpk(o1[0], o1[1]); wv[1] = cvtpk(o1[2], o1[3]); *(LAS ret_u2*)(K2 + i * RT_K2LD + d) = wv; \
            wv[0] = cvtpk(o2[0], o2[1]); wv[1] = cvtpk(o2[2], o2[3]); *(LAS ret_u2*)(K2 + i * RT_K2LD + 32 + d) = wv; \
            *(LAS v4u*)(VS + i * RT_VLD + e0) = A.va; *(LAS v4u*)(VS + i * RT_VLD + e0 + 8) = A.vb; \
            ret_load_a(P2, COS + n2 * 64 * 32, SIN + n2 * 64 * 32, h, dq, A); \
        } \
        LBAR(); \
        if (!warm) { \
        {     \
            const int ti = w >> 1, ii = 16 * ti + lr; \
            const bf16x8 b0 = *(const LAS bf16x8*)(QS + ii * RT_LD + 8 * lq), b1 = *(const LAS bf16x8*)(QS + ii * RT_LD + 32 + 8 * lq); \
            _Pragma("unroll") \
            for (int q = 0; q < 2; ++q) { const int tj = (w & 1) * 2 + q; \
                const bf16x8 a0 = *(const LAS bf16x8*)(KS + (16 * tj + lr) * RT_LD + 8 * lq), a1 = *(const LAS bf16x8*)(KS + (16 * tj + lr) * RT_LD + 32 + 8 * lq); \
                f32x4 acc = (f32x4){0.f, 0.f, 0.f, 0.f}; \
                acc = __builtin_amdgcn_mfma_f32_16x16x32_bf16(a0, b0, acc, 0, 0, 0); acc = __builtin_amdgcn_mfma_f32_16x16x32_bf16(a1, b1, acc, 0, 0, 0); \
                _Pragma("unroll") \
                for (int rg = 0; rg < 4; ++rg) { const int j = 16 * tj + 4 * lq + rg; const int dd = ii > j ? ii - j : j - ii; acc[rg] *= __builtin_amdgcn_exp2f(lg * (float)dd); } \
                ret_u2 wv; wv[0] = cvtpk(acc[0], acc[1]); wv[1] = cvtpk(acc[2], acc[3]); *(LAS ret_u2*)(SC + ii * RT_LD + 16 * tj + 4 * lq) = wv; } \
        } \
        LBAR(); \
        } \
        if (!warm) \
        {     \
            const int ti = w >> 1, ii = 16 * ti + lr; \
            const LAS bf16* scr = SC + ii * RT_LD; \
            const bf16x8 sb0 = ret_rowp(scr, 0, lq), sb1 = ret_rowp(scr, 32, lq); \
            const bf16x8 qb0 = *(const LAS bf16x8*)(QS + ii * RT_LD + 8 * lq), qb1 = *(const LAS bf16x8*)(QS + ii * RT_LD + 32 + 8 * lq); \
            const bf16x8 ka0 = ret_tr(K2, RT_K2LD, 0, 16 * ti, lr, lq), ka1 = ret_tr(K2, RT_K2LD, 32, 16 * ti, lr, lq); \
            const float gi = __builtin_amdgcn_exp2f(lg * (float)(ii + 1)); \
            _Pragma("unroll") \
            for (int hq = 0; hq < 2; ++hq) { \
                bf16x8 va0[2], va1[2], pa0[2], pa1[2]; \
                _Pragma("unroll") \
                for (int q = 0; q < 2; ++q) { const int te = (w & 1) * 4 + 2 * hq + q; \
                    va0[q] = ret_tr(VS, RT_VLD, 0, 16 * te, lr, lq); va1[q] = ret_tr(VS, RT_VLD, 32, 16 * te, lr, lq); \
                    pa0[q] = *(const LAS bf16x8*)(PT + (16 * te + lr) * RT_LD + 8 * lq); pa1[q] = *(const LAS bf16x8*)(PT + (16 * te + lr) * RT_LD + 32 + 8 * lq); } \
                __builtin_amdgcn_sched_barrier(0); \
                _Pragma("unroll") \
                for (int q = 0; q < 2; ++q) { const int te = (w & 1) * 4 + 2 * hq + q, qq = 2 * hq + q; \
                    f32x4 ai = (f32x4){0.f, 0.f, 0.f, 0.f}, ax = ai; \
                    ai = __builtin_amdgcn_mfma_f32_16x16x32_bf16(va0[q], sb0, ai, 0, 0, 0); ax = __builtin_amdgcn_mfma_f32_16x16x32_bf16(pa0[q], qb0, ax, 0, 0, 0); \
                    ai = __builtin_amdgcn_mfma_f32_16x16x32_bf16(va1[q], sb1, ai, 0, 0, 0); ax = __builtin_amdgcn_mfma_f32_16x16x32_bf16(pa1[q], qb1, ax, 0, 0, 0); \
                    accP[qq] = accP[qq] * g64; \
                    accP[qq] = __builtin_amdgcn_mfma_f32_16x16x32_bf16(ka0, va0[q], accP[qq], 0, 0, 0); accP[qq] = __builtin_amdgcn_mfma_f32_16x16x32_bf16(ka1, va1[q], accP[qq], 0, 0, 0); \
                    *(LAS f32x4*)(OB + ii * RT_OLD + 16 * te + 4 * lq) = ai + ax * gi; } \
                __builtin_amdgcn_sched_barrier(0); \
            } \
        } \
        else {     \
            const int ti = w >> 1; \
            const bf16x8 ka0 = ret_tr(K2, RT_K2LD, 0, 16 * ti, lr, lq), ka1 = ret_tr(K2, RT_K2LD, 32, 16 * ti, lr, lq); \
            _Pragma("unroll") \
            for (int q = 0; q < 4; ++q) { const int te = (w & 1) * 4 + q; \
                const bf16x8 va0 = ret_tr(VS, RT_VLD, 0, 16 * te, lr, lq), va1 = ret_tr(VS, RT_VLD, 32, 16 * te, lr, lq); \
                accP[q] = accP[q] * g64; \
                accP[q] = __builtin_amdgcn_mfma_f32_16x16x32_bf16(ka0, va0, accP[q], 0, 0, 0); accP[q] = __builtin_amdgcn_mfma_f32_16x16x32_bf16(ka1, va1, accP[q], 0, 0, 0); } \
        } \
        LBAR(); \
        {     \
            _Pragma("unroll") \
            for (int q = 0; q < 4; ++q) { const int te = (w & 1) * 4 + q, td = w >> 1; ret_u2 wv; wv[0] = cvtpk(accP[q][0], accP[q][1]); wv[1] = cvtpk(accP[q][2], accP[q][3]); \
                *(LAS ret_u2*)(PT + (16 * te + lr) * RT_LD + 16 * td + 4 * lq) = wv; } \
            RET_WAIT_G(G, 20);                                                        \
            if (warm) { dumpp[0] = (v4u){0u, 0u, 0u, 0u}; dumpp[1] = (v4u){0u, 0u, 0u, 0u}; } else { \
            f32x4 o[4]; float ss = 0.f; \
            _Pragma("unroll") \
            for (int j = 0; j < 4; ++j) { o[j] = *(const LAS f32x4*)(OB + i * RT_OLD + e0 + 4 * j); ss += (o[j][0] * o[j][0] + o[j][1] * o[j][1]) + (o[j][2] * o[j][2] + o[j][3] * o[j][3]); } \
            ss = sum8(ss); \
            const float rstd = __builtin_amdgcn_rsqf(ss * (1.0f / 128.0f) + 1e-6f); \
            v4u oa, ob; \
            _Pragma("unroll") \
            for (int j = 0; j < 4; ++j) { \
                const float g0 = bf_lo(G.ga[j]), g1 = bf_hi(G.ga[j]), g2 = bf_lo(G.gb[j]), g3 = bf_hi(G.gb[j]); \
                const float x0 = o[j >> 1][(2 * j) & 3], x1 = o[j >> 1][(2 * j + 1) & 3], x2 = o[2 + (j >> 1)][(2 * j) & 3], x3 = o[2 + (j >> 1)][(2 * j + 1) & 3]; \
                oa[j] = cvtpk(x0 * rstd * g0 * sigm(g0), x1 * rstd * g1 * sigm(g1)); ob[j] = cvtpk(x2 * rstd * g2 * sigm(g2), x3 * rstd * g3 * sigm(g3)); } \
            bf16* O = orow + (size_t)n * 64 * DM; \
            *(GAS v4u*)O = oa; *(GAS v4u*)(O + 8) = ob; } \
            ret_load_g(P2, h, dq, G); \
        } \
          \
    }
__device__ __forceinline__ void ret_unit(const Frame& F, int unit) {
    const int b = unit >> 3, h = (unit >> 1) & 3, half = unit & 1;
    LAS unsigned char* lds = F.lds + RING_OFF;
    LAS bf16* QS = (LAS bf16*)(lds + RT_QS); LAS bf16* KS = (LAS bf16*)(lds + RT_KS); LAS bf16* K2 = (LAS bf16*)(lds + RT_K2); LAS bf16* SC = (LAS bf16*)(lds + RT_SC);
    LAS bf16* VS = (LAS bf16*)(lds + RT_VS); LAS bf16* PT = (LAS bf16*)(lds + RT_PT); LAS float* OB = (LAS float*)(lds + RT_OB);
    const int tid = F.tid, w = F.wave;
    const float gamma = 1.0f - exp2f(-5.0f - (float)h), lg = log2f(gamma), g64 = exp2f(64.0f * lg);
    for (int i = tid; i < 128 * RT_LD / 2; i += NWAVES * 64) ((LAS unsigned*)PT)[i] = 0u;
    f32x4 accP[4];
#pragma unroll
    for (int q = 0; q < 4; ++q) accP[q] = (f32x4){0.f, 0.f, 0.f, 0.f};
    const float* COS = (const float*)(F.ws + WS_TRIG) + (tid >> 3) * 32; const float* SIN = COS + SEQ * 32;
    const bf16* prow = (const bf16*)(F.ws + WS_H) + ((size_t)b * SEQ + (tid >> 3)) * NPROJ + RET_OFF;
    bf16* orow = (bf16*)(F.ws + WS_MIXED) + ((size_t)b * SEQ + (tid >> 3)) * DM + 512 + h * 128 + (tid & 7) * 16;
    const float kwi = exp2f(lg * (float)(63 - (tid >> 3)));
    GAS v4u* dumpp = (GAS v4u*)(F.ws + WS_DUMP + 1 * MiB) + ((size_t)F.vcu * 512 + tid) * 2;
    const int nend = half ? SEQ / 64 : SEQ / 128;
    RetA A0, A1; RetG G0, G1;
    A0.q1 = (ret_u2){0u, 0u}; A0.q2 = A0.q1; A0.k1 = A0.q1; A0.k2 = A0.q1; A0.va = (v4u){0u, 0u, 0u, 0u}; A0.vb = A0.va; A0.cs = (f32x4){0.f, 0.f, 0.f, 0.f}; A0.sn = A0.cs; A1 = A0;
    G0.ga = (v4u){0u, 0u, 0u, 0u}; G0.gb = G0.ga; G1 = G0;
    {
        const int dq = tid & 7;
        ret_load_a(prow, COS, SIN, h, dq, A0); dumpp[0] = (v4u){0u, 0u, 0u, 0u}; dumpp[1] = (v4u){0u, 0u, 0u, 0u}; ret_load_g(prow, h, dq, G0);
        const bf16* p1 = prow + (size_t)64 * NPROJ;
        ret_load_a(p1, COS + 64 * 32, SIN + 64 * 32, h, dq, A1); dumpp[0] = (v4u){0u, 0u, 0u, 0u}; dumpp[1] = (v4u){0u, 0u, 0u, 0u}; ret_load_g(p1, h, dq, G1);
    }
    __syncthreads();
    for (int n0 = 0; n0 < nend; n0 += 2) {
        const bool warm = half && n0 < SEQ / 128;
        { const int n = n0;     RET_ITER(A0, G0) }
        { const int n = n0 + 1; RET_ITER(A1, G1) }
    }
    asm volatile("s_waitcnt vmcnt(0)" ::: "memory");
    __syncthreads();
}
#ifndef MK_PER_PHASE
#define MK_PER_PHASE 0
#endif
constexpr int PH_PER_LAYER = 10, PH_FINAL = 1 + DEPTH * PH_PER_LAYER, N_PHASES = PH_FINAL + 1;
__global__ void __launch_bounds__(NWAVES * 64, 2) mk_fwd(Args args) {
    extern __shared__ __attribute__((aligned(16))) unsigned char lds[];
    Frame F;
    F.lds = (LAS unsigned char*)lds;
    F.MISC = (volatile LAS unsigned*)(F.lds + MISC_OFF);
    F.tid = threadIdx.x; F.lane = F.tid & 63; F.wave = __builtin_amdgcn_readfirstlane(F.tid >> 6);
    F.G = gridDim.x; { const int bx = blockIdx.x; F.vcu = (F.G % 8 == 0) ? (bx % 8) * (F.G / 8) + bx / 8 : bx; }
    F.ws = args.ws; F.lora = (unsigned char*)args.out;
    gu32* ctl = (gu32*)(F.ws + WS_CTL);
    for (int u = F.tid; u < (LDS_BYTES - LDSCTL_OFF) / 4; u += NWAVES * 64) ((LAS unsigned*)(F.lds + LDSCTL_OFF))[u] = 0u;
    __syncthreads();
#if MK_PER_PHASE
    const int lo = args.ph_lo, hi = args.ph_hi;
#else
    constexpr int lo = 0, hi = N_PHASES;
#endif
    XcdBarrier bar; bar.bar = (unsigned*)(ctl + CW_BAR); bar.x = 0; bar.st = nullptr;
    if (hi - lo > 1) bar = xcd_barrier_post((unsigned*)(ctl + CW_BAR), F.MISC + 8);
    const bool GL = (F.G == 256) && (hi - lo > 1);
    const unsigned grp = (unsigned)(F.vcu >> 5) & 7u;
    if (GL && threadIdx.x == 0) (void)__hip_atomic_fetch_or((unsigned*)(ctl + CW_BAR) + GB_MASK(grp), 1u << bar.x, RLX_AGENT);
#define IN(k) (lo <= (k) && (k) < hi)
#define PHASE_ENTER() do { int t_ = threadIdx.x; asm volatile("" : "+v"(t_)); F.tid = t_; F.lane = t_ & 63; } while (0)
#define SEAM(k) do { if (IN(k) && IN((k) + 1)) { XcdBarrier b_ = bar; asm volatile("" : "+s"(b_.bar), "+s"(b_.x)); xcd_barrier(b_); } } while (0)
#define GSEAM(k) do { if (IN(k) && IN((k) + 1)) { if (GL) { unsigned* gb_ = (unsigned*)(ctl + CW_BAR); unsigned gg_ = grp; asm volatile("" : "+s"(gb_), "+s"(gg_)); grp_barrier(gb_, GB_SUB(gg_), GB_GEN(gg_), 32u, F.MISC[10] != 0u); } \
        else { XcdBarrier b_ = bar; asm volatile("" : "+s"(b_.bar), "+s"(b_.x)); xcd_barrier(b_); } } } while (0)
#define QSEAM(k) do { if (IN(k) && IN((k) + 1)) { if (GL) { unsigned* gb_ = (unsigned*)(ctl + CW_BAR); unsigned qq_ = grp * 8u + ((unsigned)F.vcu & 7u); asm volatile("" : "+s"(gb_), "+s"(qq_)); grp_barrier(gb_, QB_SUB(qq_), QB_GEN(qq_), 4u, F.MISC[10] != 0u); } \
        else { XcdBarrier b_ = bar; asm volatile("" : "+s"(b_.bar), "+s"(b_.x)); xcd_barrier(b_); } } } while (0)
#define QSTAGGER() do { if (GL) for (unsigned i_ = 0; i_ < ((unsigned)F.vcu & 7u); ++i_) __builtin_amdgcn_s_sleep(QSLEEP); } while (0)
#define CTR_WAIT(word, below, acq) do { if (threadIdx.x == 0) { unsigned* gb_ = (unsigned*)(ctl + CW_BAR); asm volatile("" : "+s"(gb_)); XB_SPIN(xb_ld(&gb_[word]) < (below), gb_); \
        if (acq) { __builtin_amdgcn_fence(__ATOMIC_ACQUIRE, "agent"); asm volatile("s_waitcnt vmcnt(0)" ::: "memory"); } } __syncthreads(); } while (0)
#define CTR_POST(word) do { if (threadIdx.x == 0) { unsigned* gb_ = (unsigned*)(ctl + CW_BAR); asm volatile("" : "+s"(gb_)); __builtin_amdgcn_fence(__ATOMIC_RELEASE, "agent"); asm volatile("s_waitcnt vmcnt(0)" ::: "memory"); \
        (void)xb_add(&gb_[word], 1u); } } while (0)
    bf16* XB = (bf16*)(F.ws + WS_XB); bf16* HB = (bf16*)(F.ws + WS_H); bf16* PROJ = (bf16*)(F.ws + WS_H); bf16* MIXED = (bf16*)(F.ws + WS_MIXED); bf16* ALORA = (bf16*)(F.ws + WS_MIXED);
    float* SSQ = (float*)(F.ws + WS_SSQ);
    bf16* HBg = HB;
    if (IN(0)) { PHASE_ENTER(); p0_prologue(F, args); SEAM(0); }
    if (GL) {
        if (threadIdx.x == 0) { const unsigned mk = xb_ld((unsigned*)(ctl + CW_BAR) + GB_MASK(grp)); F.MISC[10] = (mk & (mk - 1u)) != 0u ? 1u : 0u; }
        {   constexpr int LATE = DEPTH * ITEMS_LAYER - ITEMS_EARLY; const int g = (int)grp;
            const int it0 = ITEMS_EARLY + (int)(((long)LATE * (g * (g - 1) / 2)) / 28), it1 = ITEMS_EARLY + (int)(((long)LATE * (g * (g + 1) / 2)) / 28);
            PHASE_ENTER(); p0_weights(F, args, it0, it1, (F.vcu & 31) * NWAVES + F.wave, 32 * NWAVES);
            asm volatile("s_waitcnt vmcnt(0)" ::: "memory"); __syncthreads(); CTR_POST(GB_WDONE); }
        for (unsigned i = 0; i < grp; ++i) __builtin_amdgcn_s_sleep(64);
        QSTAGGER();
    }
    for (int l = 0; l < DEPTH; ++l) {
        const int pb = 1 + PH_PER_LAYER * l;
        const unsigned char* wl = F.ws + WS_W + (size_t)l * SZ_LAYER;
        float* ssq_in = SSQ + (size_t)(l & 1) * M * 16; float* ssq_a = SSQ + (size_t)((l + 1) & 1) * M * 16; float* ssq_b = ssq_in; float* ssq_c = ssq_a;
        LayerP L; L.mu = args.in[7] + l * RWKV_IN; L.w0 = args.in[8] + l * 512; L.a0 = args.in[10] + l * 512; L.k_k = args.in[13] + l * 512; L.k_a = args.in[14] + l * 512;
        L.r_k = args.in[15] + l * 512; L.ln_w = args.in[16] + l * 512; L.ln_b = args.in[17] + l * 512; L.wlora = (const bf16*)(wl + OFF_WLORA);
        if (IN(pb + 0)) {
            pg8::Gemm g{XB, (const bf16*)(wl + OFF_WGU1), M, NGU, DM, 0u}; pg8::StaticOrder S; S.init(M, NGU, F.G, opaque_bx());
            pg8::EpiSwiglu E{HBg, DFF, ssq_in, (LAS float*)(F.lds + EPI_TAB_OFF)};
            pg8::gemm_phase<pg8::EpiSwiglu, pg8::StaticOrder, true, true>(F.lds + RING_OFF, g, S, E);
            QSEAM(pb + 0);
        }
        if (IN(pb + 1)) {
            if (GL && l == 0) CTR_WAIT(GB_WDONE, (unsigned)F.G, true);
            pg8::Gemm g{HBg, (const bf16*)(wl + OFF_WD1), M, DM, DFF, pg8::HPAD_EL * 2u}; pg8::StaticOrder S; S.init(M, DM, F.G, opaque_bx());
            pg8::EpiResid E{XB, ssq_a, 0.5f};
            pg8::gemm_phase<pg8::EpiResid, pg8::StaticOrder, true, true>(F.lds + RING_OFF, g, S, E);
            QSEAM(pb + 1);
        }
        if (IN(pb + 2)) {
            pg8::Gemm g{XB, (const bf16*)(wl + OFF_WIN), M, NPROJ, DM, 0u}; pg8::WinOrder S; S.init(M, NPROJ, F.G, opaque_bx());
            pg8::EpiProj<true> E{PROJ, NPROJ, ssq_a, (LAS float*)(F.lds + EPI_TAB_OFF), S.fused ? (bf16*)(F.ws + WS_SIDE) : nullptr};
            pg8::gemm_phase<pg8::EpiProj<true>, pg8::WinOrder, true, true>(F.lds + RING_OFF, g, S, E);
            if (S.fused && S.c >= 128) { PHASE_ENTER(); lora_prep_panel(F, L.mu, S.pm6());
            }
            GSEAM(pb + 2);
        }
        if (IN(pb + 3) && F.G != 256) { PHASE_ENTER(); lora_prep(F, L.mu); GSEAM(pb + 3); }
        if (IN(pb + 5)) {
            PHASE_ENTER();
            rwkv_m1_phase(F, L);
            GSEAM(pb + 5);
        }
        if (IN(pb + 6)) {
            PHASE_ENTER();
            for (int u = F.vcu; u < 256; u += F.G) { int uu = u;
                if (GL) { const int li = u & 31, g16 = (u >> 5) * 16; uu = li < 16 ? g16 + li : 128 + g16 + (li - 16); }
                if (uu < 128) rwkv_m2_unit(F, L, uu); else ret_unit(F, uu - 128); }
            GSEAM(pb + 6);
            QSTAGGER();
            if (GL && l == DEPTH - 1) CTR_POST(GB_MDONE);
        }
        if (IN(pb + 7)) {
            pg8::Gemm g{MIXED, (const bf16*)(wl + OFF_WOUT), M, DM, DM, 0u}; pg8::StaticOrder S; S.init(M, DM, F.G, opaque_bx());
            pg8::EpiResid E{XB, ssq_b, 1.0f};
            pg8::gemm_phase<pg8::EpiResid, pg8::StaticOrder, true, true>(F.lds + RING_OFF, g, S, E);
            QSEAM(pb + 7);
        }
        if (IN(pb + 8)) {
            pg8::Gemm g{XB, (const bf16*)(wl + OFF_WGU2), M, NGU, DM, 0u}; pg8::StaticOrder S; S.init(M, NGU, F.G, opaque_bx());
            pg8::EpiSwiglu E{HBg, DFF, ssq_b, (LAS float*)(F.lds + EPI_TAB_OFF)};
            pg8::gemm_phase<pg8::EpiSwiglu, pg8::StaticOrder, true, true>(F.lds + RING_OFF, g, S, E);
            QSEAM(pb + 8);
        }
        if (IN(pb + 9)) {
            pg8::Gemm g{HBg, (const bf16*)(wl + OFF_WD2), M, DM, DFF, pg8::HPAD_EL * 2u}; pg8::StaticOrder S; S.init(M, DM, F.G, opaque_bx());
            pg8::EpiResid E{XB, ssq_c, 0.5f};
            pg8::gemm_phase<pg8::EpiResid, pg8::StaticOrder, true, true>(F.lds + RING_OFF, g, S, E);
            QSEAM(pb + 9);
        }
    }
    if (IN(PH_FINAL)) {
        PHASE_ENTER();
        const float* ssq = SSQ + (size_t)(DEPTH & 1) * M * 16; const float* gain = args.in[23];
        const unsigned tmo = __hip_atomic_load(ctl + CW_BAR + XB_TMO, RLX_AGENT);
        const int gw = F.vcu * NWAVES + F.wave, NGW = F.G * NWAVES;
        if (GL) CTR_WAIT(GB_MDONE, (unsigned)F.G, false);
        f32x4 gv[4];
#pragma unroll
        for (int j = 0; j < 4; ++j) gv[j] = *((const f32x4*)gain + 2 * F.lane + (j & 1) + 128 * (j >> 1));
        for (int k = 0;; k += 4) {
            int mr[4]; bool ok[4];
#pragma unroll
            for (int r = 0; r < 4; ++r) { mr[r] = GL ? ((int)grp * 16 + (F.vcu & 7) + 8 * ((k + r) >> 3)) * 256 + (((F.vcu & 31) >> 3) * NWAVES + F.wave) + 32 * ((k + r) & 7) : gw + (k + r) * NGW;     ok[r] = GL ? (k + r < 16) : (mr[r] < M); if (!ok[r]) mr[r] = 0; }
            if (!ok[0]) break;
            f32x4 sq[4][4]; v4u xv[4][2];
#pragma unroll
            for (int r = 0; r < 4; ++r) { const f32x4* sp = (const f32x4*)(ssq + (size_t)mr[r] * pg8::SSQ_P);
#pragma unroll
                for (int j = 0; j < 4; ++j) sq[r][j] = sp[j];
                const GAS v4u* xr = (const GAS v4u*)(XB + (size_t)mr[r] * DM) + F.lane; xv[r][0] = xr[0]; xv[r][1] = xr[64]; }
#pragma unroll
            for (int r = 0; r < 4; ++r) { if (!ok[r]) continue;
                const f32x4 s4 = (sq[r][0] + sq[r][1]) + (sq[r][2] + sq[r][3]); const float tt = (s4[0] + s4[1]) + (s4[2] + s4[3]);
                const float rs = (1.0f / sqrtf(tt * (1.0f / 1024.0f) + pg8::RMS_EPS)) * (tmo ? __builtin_nanf("") : 1.0f);
                GAS f32x4* orow = (GAS f32x4*)(args.out + (size_t)mr[r] * DM) + 2 * F.lane;
#pragma unroll
                for (int j = 0; j < 2; ++j) { const v4u v = xv[r][j];
                    const f32x4 a = {bf_lo(v.x), bf_hi(v.x), bf_lo(v.y), bf_hi(v.y)}, c = {bf_lo(v.z), bf_hi(v.z), bf_lo(v.w), bf_hi(v.w)};
                    orow[128 * j] = a * rs * gv[2 * j]; orow[128 * j + 1] = c * rs * gv[2 * j + 1]; } }
        }
    }
#undef IN
#undef SEAM
}

extern "C" void kernel_launch(void* const* d_in, const int* in_sizes, int n_in, void* d_out, int out_size, void* d_ws, size_t ws_size, hipStream_t stream) {
    static int grid = 0;
    if (grid == 0) {
        if (n_in != 24 || in_sizes[0] != M * DM || out_size != M * DM || ws_size < WS_END) { fprintf(stderr, "kernel_launch: unexpected shapes (n_in %d, in0 %d, out %d, ws %zu); nothing launched\n", n_in, n_in > 0 ? in_sizes[0] : -1, out_size, ws_size); grid = -1; return; }
        int dev = 0, cus = 0, per_cu = 0;
        if (hipGetDevice(&dev) != hipSuccess || hipDeviceGetAttribute(&cus, hipDeviceAttributeMultiprocessorCount, dev) != hipSuccess) { grid = -1; return; }
        if (hipFuncSetAttribute((const void*)mk_fwd, hipFuncAttributeMaxDynamicSharedMemorySize, LDS_BYTES) != hipSuccess) { fprintf(stderr, "kernel_launch: hipFuncSetAttribute failed\n"); grid = -1; return; }
        if (hipOccupancyMaxActiveBlocksPerMultiprocessor(&per_cu, (const void*)mk_fwd, NWAVES * 64, LDS_BYTES) != hipSuccess || per_cu < 1)
            fprintf(stderr, "kernel_launch: note: occupancy query reports %d workgroups per CU\n", per_cu);
        (void)hipGetLastError();
        grid = cus;
    }
    if (grid < 0) return;
    if (hipMemsetAsync((char*)d_ws + WS_CTL, 0, CTL_ZERO_BYTES, stream) != hipSuccess) return;
    Args a{};
    for (int i = 0; i < 24; ++i) a.in[i] = (const float*)d_in[i];
    a.out = (float*)d_out; a.ws = (unsigned char*)d_ws;
#if MK_PER_PHASE
    for (int p = 0; p < N_PHASES; ++p) { a.ph_lo = p; a.ph_hi = p + 1; hipLaunchKernelGGL(mk_fwd, dim3(grid), dim3(NWAVES * 64), LDS_BYTES, stream, a); }
#else
    a.ph_lo = 0; a.ph_hi = N_PHASES;
    hipLaunchKernelGGL(mk_fwd, dim3(grid), dim3(NWAVES * 64), LDS_BYTES, stream, a);
#endif
}
```

```cpp
#include <hip/hip_runtime.h>
#include <cstdio>
#include <cstdint>
#include <cmath>
namespace pg8 {
#define PG8_LAS __attribute__((address_space(3)))
typedef unsigned short bf16_t;
typedef short bf16x8 __attribute__((ext_vector_type(8)));
typedef float f32x4 __attribute__((ext_vector_type(4)));
typedef unsigned u32x4 __attribute__((ext_vector_type(4)));
constexpr int BM = 256, BK = 64, HALF = 128, HTB = HALF * BK * 2  , STAGE_BYTES = 8 * HTB, NXCD = 8, WGM = 8;

__host__ __device__ __forceinline__ int lds_byte(int r, int c) { const int st = (r >> 4) * 2 + (c >> 5), rr = r & 15, cc = c & 31, ob = rr * 64 + cc * 2; return st * 1024 + (ob ^ (((ob >> 9) & 1) << 5)); }
__host__ __device__ __forceinline__ void stage_rc(int b, int& R, int& C) { const int st = b / 1024, sb = b % 1024, swz = sb ^ (((sb >> 9) & 1) << 5); R = (st >> 1) * 16 + swz / 64; C = (st & 1) * 32 + (swz % 64) / 2; }
__host__ __device__ __forceinline__ int perm32(int rho) { const int n = rho >> 4, i = rho & 15; return 8 * (i >> 2) + 4 * n + (i & 3); }

struct Unit { int pm, pn; };
struct Gemm { const bf16_t* A; const bf16_t* Bt; int M, N, K; unsigned apad; };

struct StaticOrder {
    int nM, nN, nwg, G, c;
    __host__ __device__ void init(int M, int N, int G_, int c_) { nM = M / BM; nN = N / BM; nwg = nM * nN; G = G_; c = c_; }
    __host__ __device__ bool next(int i, Unit& u) const {
        const long L = (long)i * G + c; if (L >= nwg) return false;
        int wgid = (int)L; { const int q = nwg / NXCD, r = nwg % NXCD, xcd = wgid % NXCD, off = wgid / NXCD; wgid = (xcd < r ? xcd * (q + 1) : r * (q + 1) + (xcd - r) * q) + off; }
        const int nig = WGM * nN, gid = wgid / nig, fm = gid * WGM, gsz = (nM - fm) < WGM ? (nM - fm) : WGM;
        u.pm = fm + ((wgid % nig) % gsz); u.pn = (wgid % nig) / gsz; return true;
    }
    __device__ __forceinline__ void a_ready(const Unit&) const {}
    __device__ __forceinline__ void done(const Unit&) const {}
};
struct WinOrder {
    StaticOrder base; int c; bool fused;
    __host__ __device__ void init(int M, int N, int G_, int c_) { fused = (G_ == 256); c = c_; base.init(M, fused ? N - BM : N, G_, c_); }
    __host__ __device__ int pm6() const { return 16 * (c & 7) + ((c - 128) >> 3); }
    __host__ __device__ bool next(int i, Unit& u) const {
        if (!fused) return base.next(i, u);
        bool ok;
        if (c >= 128) { if (i == 0) { u.pm = pm6(); u.pn = 6; return true; } if (i > 5) return false; ok = base.next(i - 1, u); }
        else { if (i < 6) ok = base.next(i, u); else if (i == 6) { StaticOrder b2 = base; b2.c = c + 128; ok = b2.next(5, u); } else return false; }
        if (ok && u.pn >= 6) u.pn += 1;
        return ok;
    }
    __device__ __forceinline__ void a_ready(const Unit&) const {}
    __device__ __forceinline__ void done(const Unit&) const {}
};


__device__ __forceinline__ unsigned cvt_pk_bf16(float lo, float hi) { unsigned r; asm volatile("v_cvt_pk_bf16_f32 %0, %1, %2" : "=v"(r) : "v"(lo), "v"(hi)); return r; }
typedef unsigned u32x2 __attribute__((ext_vector_type(2)));
constexpr int SSQ_P = 16;
constexpr float RMS_EPS = 1e-6f;
__device__ __forceinline__ float fast_rcp(float x) { return __builtin_amdgcn_rcpf(x); }
__device__ __forceinline__ float sigmoid_f(float x) { return fast_rcp(1.0f + __expf(-x)); }
__device__ __forceinline__ float silu_f(float x) { return x * sigmoid_f(x); }
__device__ __forceinline__ float row_rstd(const float* ssq, int row) {
    const f32x4* p = (const f32x4*)(ssq + (size_t)row * SSQ_P);
    const f32x4 a = p[0], b = p[1], c = p[2], d = p[3];
    const f32x4 s = (a + b) + (c + d);
    const float t = (s[0] + s[1]) + (s[2] + s[3]);
    return 1.0f / sqrtf(t * (1.0f / 1024.0f) + RMS_EPS);
}
constexpr unsigned HPAD_EL = 256u * (3328u - 2816u);
struct EpiSwiglu {
    static constexpr bool PERM = true, AFTER_DRAIN = false;
    bf16_t* H; int ldh; const float* ssq; PG8_LAS float* tab;
    __device__ __forceinline__ void begin(int wid, int lane) const { if (lane == 0) ((PG8_LAS int*)(tab + 8 * 128))[wid] = -1; }
    __device__ __forceinline__ void operator()(const f32x4 (&acc)[2][2][4][2], const Unit& u, int wr, int wc, int fr, int fq) const {
        const int row0 = u.pm * BM + wr * 64 + fr, col0 = u.pn * HALF + wc * 32 + 8 * fq;
        PG8_LAS float* const tb = tab + (wr * 4 + wc) * 128; PG8_LAS int* const tg = (PG8_LAS int*)(tab + 8 * 128) + (wr * 4 + wc);
        if (__builtin_amdgcn_readfirstlane(*tg) != u.pm) { const int ln = fq * 16 + fr, rb = u.pm * BM + wr * 64 + ln;
            const float t0 = row_rstd(ssq, rb), t1 = row_rstd(ssq, rb + HALF); tb[ln] = t0; tb[64 + ln] = t1; if (ln == 0) *tg = u.pm; }
#pragma unroll
        for (int ai = 0; ai < 2; ++ai)
#pragma unroll
            for (int m = 0; m < 4; ++m) { const int row = row0 + ai * HALF + m * 16; const float rs = tb[ai * 64 + m * 16 + fr];
                typedef float f32x2v __attribute__((ext_vector_type(2)));
                const float c1 = rs * -1.4426950408889634f, c2 = rs * rs;
                f32x2v tp[4], hp[4];
#pragma unroll
                for (int n = 0; n < 2; ++n)
#pragma unroll
                    for (int i2 = 0; i2 < 2; ++i2) { const f32x2v g2 = {acc[ai][0][m][n][2 * i2], acc[ai][0][m][n][2 * i2 + 1]}, u2 = {acc[ai][1][m][n][2 * i2], acc[ai][1][m][n][2 * i2 + 1]};
                        tp[n * 2 + i2] = g2 * c1; hp[n * 2 + i2] = (g2 * u2) * c2; }
#pragma unroll
                for (int k = 0; k < 4; ++k) { tp[k].x = __builtin_amdgcn_exp2f(tp[k].x); tp[k].y = __builtin_amdgcn_exp2f(tp[k].y); }
#pragma unroll
                for (int k = 0; k < 4; ++k) tp[k] = tp[k] + 1.0f;
#pragma unroll
                for (int k = 0; k < 4; ++k) { tp[k].x = __builtin_amdgcn_rcpf(tp[k].x); tp[k].y = __builtin_amdgcn_rcpf(tp[k].y); }
                float hv[8];
#pragma unroll
                for (int k = 0; k < 4; ++k) { const f32x2v r2 = hp[k] * tp[k]; hv[2 * k] = r2.x; hv[2 * k + 1] = r2.y; }
                u32x4 w; w.x = cvt_pk_bf16(hv[0], hv[1]); w.y = cvt_pk_bf16(hv[2], hv[3]); w.z = cvt_pk_bf16(hv[4], hv[5]); w.w = cvt_pk_bf16(hv[6], hv[7]);
                *(u32x4*)(H + (size_t)row * ldh + (size_t)u.pm * HPAD_EL + col0) = w; }
    }
};
__device__ __forceinline__ float sum_fq(float x) {
    float a = x, b = x;
    asm volatile("s_nop 1\n\tv_permlane16_swap_b32 %0, %1" : "+v"(a), "+v"(b));
    a = a + b; b = a;
    asm volatile("s_nop 1\n\tv_permlane32_swap_b32 %0, %1" : "+v"(a), "+v"(b));
    return a + b;
}
struct EpiResid {
    static constexpr bool PERM = true, AFTER_DRAIN = false;
    bf16_t* xb; float* ssq; float scale;
    __device__ __forceinline__ void begin(int, int) const {}
    __device__ __forceinline__ void operator()(const f32x4 (&acc)[2][2][4][2], const Unit& u, int wr, int wc, int fr, int fq) const {
        const int row0 = u.pm * BM + wr * 64 + fr, col0 = u.pn * BM + wc * 32 + 8 * fq;
        u32x4 xo[4][2][2];
#define EPR_LOAD(g) do { _Pragma("unroll") for (int mm = 0; mm < 2; ++mm) _Pragma("unroll") for (int bj = 0; bj < 2; ++bj) \
            xo[g][mm][bj] = *(const u32x4*)(xb + (size_t)(row0 + ((g) >> 1) * HALF + (2 * ((g) & 1) + mm) * 16) * 1024 + col0 + bj * HALF); } while (0)
        EPR_LOAD(0); EPR_LOAD(1); EPR_LOAD(2); EPR_LOAD(3);
#pragma unroll
        for (int g = 0; g < 4; ++g) { const int ai = g >> 1;
#pragma unroll
            for (int mm = 0; mm < 2; ++mm) { const int m = 2 * (g & 1) + mm; const int row = row0 + ai * HALF + m * 16; float ss = 0.f;
#pragma unroll
                for (int bj = 0; bj < 2; ++bj) { const u32x4 o = xo[g][mm][bj];
                    const f32x4 x0 = {__builtin_bit_cast(float, o.x << 16), __builtin_bit_cast(float, o.x & 0xffff0000u), __builtin_bit_cast(float, o.y << 16), __builtin_bit_cast(float, o.y & 0xffff0000u)};
                    const f32x4 x1 = {__builtin_bit_cast(float, o.z << 16), __builtin_bit_cast(float, o.z & 0xffff0000u), __builtin_bit_cast(float, o.w << 16), __builtin_bit_cast(float, o.w & 0xffff0000u)};
                    const f32x4 v0 = x0 + acc[ai][bj][m][0] * scale, v1 = x1 + acc[ai][bj][m][1] * scale;
                    u32x4 w; w.x = cvt_pk_bf16(v0[0], v0[1]); w.y = cvt_pk_bf16(v0[2], v0[3]); w.z = cvt_pk_bf16(v1[0], v1[1]); w.w = cvt_pk_bf16(v1[2], v1[3]);
                    *(u32x4*)(xb + (size_t)row * 1024 + col0 + bj * HALF) = w;
                    const float r0 = __builtin_bit_cast(float, w.x << 16), r1 = __builtin_bit_cast(float, w.x & 0xffff0000u), r2 = __builtin_bit_cast(float, w.y << 16), r3 = __builtin_bit_cast(float, w.y & 0xffff0000u);
                    const float r4 = __builtin_bit_cast(float, w.z << 16), r5 = __builtin_bit_cast(float, w.z & 0xffff0000u), r6 = __builtin_bit_cast(float, w.w << 16), r7 = __builtin_bit_cast(float, w.w & 0xffff0000u);
                    ss += ((r0 * r0 + r1 * r1) + (r2 * r2 + r3 * r3)) + ((r4 * r4 + r5 * r5) + (r6 * r6 + r7 * r7)); }
                ss = sum_fq(ss);
                if (fq == 0) ssq[(size_t)row * SSQ_P + u.pn * 4 + wc] = ss; }
        }
#undef EPR_LOAD
    }
};
template <bool SCALE> struct EpiProj {
    static constexpr bool PERM = true, AFTER_DRAIN = false;
    __device__ __forceinline__ void begin(int wid, int lane) const { if (lane == 0) ((PG8_LAS int*)(tab + 8 * 128))[wid] = -1; }
    bf16_t* O; int ldc; const float* ssq; PG8_LAS float* tab; bf16_t* side;
    __device__ __forceinline__ void operator()(const f32x4 (&acc)[2][2][4][2], const Unit& u, int wr, int wc, int fr, int fq) const {
        const int row0 = u.pm * BM + wr * 64 + fr, col0 = u.pn * BM + wc * 32 + 8 * fq;
        PG8_LAS float* const tb = tab + (wr * 4 + wc) * 128; PG8_LAS int* const tg = (PG8_LAS int*)(tab + 8 * 128) + (wr * 4 + wc);
        if (SCALE) { if (__builtin_amdgcn_readfirstlane(*tg) != u.pm) { const int ln = fq * 16 + fr, rb = u.pm * BM + wr * 64 + ln; const float t0 = row_rstd(ssq, rb), t1 = row_rstd(ssq, rb + HALF); tb[ln] = t0; tb[64 + ln] = t1; if (ln == 0) *tg = u.pm; } }
#pragma unroll
        for (int ai = 0; ai < 2; ++ai)
#pragma unroll
            for (int m = 0; m < 4; ++m) { const int row = row0 + ai * HALF + m * 16; const float rs = SCALE ? tb[ai * 64 + m * 16 + fr] : 1.0f;
#pragma unroll
                for (int bj = 0; bj < 2; ++bj) { const f32x4 v0 = acc[ai][bj][m][0] * rs, v1 = acc[ai][bj][m][1] * rs;
                    u32x4 w; w.x = cvt_pk_bf16(v0[0], v0[1]); w.y = cvt_pk_bf16(v0[2], v0[3]); w.z = cvt_pk_bf16(v1[0], v1[1]); w.w = cvt_pk_bf16(v1[2], v1[3]);
                    *(u32x4*)(O + (size_t)row * ldc + col0 + bj * HALF) = w;
                    if (side != nullptr && u.pn < 6 && fr == 15) *(u32x4*)(side + (size_t)(row >> 4) * 1536 + col0 + bj * HALF) = w; } }
    }
};

template <class Epi, class Sched, bool ALIGN_EPI = false, bool SP2 = false>
__device__ __forceinline__ void gemm_phase(PG8_LAS unsigned char* lds, const Gemm g, const Sched& S, const Epi& E) {
    int tid_ = threadIdx.x; asm volatile("" : "+v"(tid_));
    const int tid = tid_, wid = __builtin_amdgcn_readfirstlane(tid >> 6), lane = tid & 63, wr = wid >> 2, wc = wid & 3, fr = lane & 15, fq = lane >> 4;
    const int K = g.K, nt = K / BK;
    unsigned voffA[2], voffB[2];
#pragma unroll
    for (int i = 0; i < 2; ++i) { int R, C; stage_rc(tid * 16 + i * 8192, R, C); const int Rb = Epi::PERM ? ((R & ~31) + perm32(R & 31)) : R;
        voffA[i] = (unsigned)(R * K + C) * 2u; voffB[i] = (unsigned)(Rb * K + C) * 2u; }
    const unsigned kstep = (unsigned)(BK * 2);
    const unsigned hstep = (unsigned)HALF * (unsigned)K * 2u;
    const unsigned tstep = 2u * hstep;
    const unsigned tstepA = tstep + g.apad;
    const __amdgpu_buffer_rsrc_t rsA = __builtin_amdgcn_make_buffer_rsrc((void*)g.A, (short)0, (int)((size_t)g.M * K * 2 + (size_t)(g.M / BM) * g.apad), 0x00020000);
    const __amdgpu_buffer_rsrc_t rsB = __builtin_amdgcn_make_buffer_rsrc((void*)g.Bt, (short)0, (int)((size_t)g.N * K * 2), 0x00020000);
    const unsigned ldsw = (unsigned)wid * 1024u;
    const int aoff = lds_byte(wr * 64 + fr, fq * 8), boff = lds_byte(wc * 32 + fr, fq * 8);
#define PG8_SA(b, h) (((b) * 2 + (h)) * HTB)
#define PG8_SB(b, h) ((4 + (b) * 2 + (h)) * HTB)
#define PG8_STAGE_X(rs, bufoff, goff, voff) do { _Pragma("unroll") for (int _i = 0; _i < 2; ++_i) \
        __builtin_amdgcn_raw_ptr_buffer_load_lds(rs, (PG8_LAS unsigned*)(lds + (bufoff) + ldsw + _i * 8192), 16, (int)(voff)[_i], (int)(goff), 0, 0); } while (0)
#define PG8_STAGE_A(bufoff, goff, voff) PG8_STAGE_X(rsA, bufoff, goff, voff)
#define PG8_STAGE_B(bufoff, goff, voff) PG8_STAGE_X(rsB, bufoff, goff, voff)
#define PG8_LDA(dst, b, h) do { _Pragma("unroll") for (int m = 0; m < 4; ++m) _Pragma("unroll") for (int k = 0; k < 2; ++k) dst[m][k] = *(const PG8_LAS bf16x8*)(lds + PG8_SA(b, h) + aoff + m * 2048 + k * 1024); } while (0)
#define PG8_LDB(dst, b, h) do { _Pragma("unroll") for (int n = 0; n < 2; ++n) _Pragma("unroll") for (int k = 0; k < 2; ++k) dst[n][k] = *(const PG8_LAS bf16x8*)(lds + PG8_SB(b, h) + boff + n * 2048 + k * 1024); } while (0)
#define PG8_MMA(ai, bj, At, Bt) do { __builtin_amdgcn_s_setprio(1); _Pragma("unroll") for (int m = 0; m < 4; ++m) _Pragma("unroll") for (int n = 0; n < 2; ++n) _Pragma("unroll") for (int k = 0; k < 2; ++k) \
        acc[ai][bj][m][n] = __builtin_amdgcn_mfma_f32_16x16x32_bf16(Bt[n][k], At[m][k], acc[ai][bj][m][n], 0, 0, 0); __builtin_amdgcn_s_setprio(0); } while (0)
#define PG8_WAIT_V(n) asm volatile("s_waitcnt vmcnt(" #n ")" ::: "memory")
#define PG8_WAIT_L(n) asm volatile("s_waitcnt lgkmcnt(" #n ")" ::: "memory")
#define PG8_BAR __builtin_amdgcn_s_barrier()
#define PG8_SCHED __builtin_amdgcn_sched_barrier(0)
    E.begin(wid, lane);
    Unit cur, nxt; int ui = 0;
    if (!S.next(0, cur)) return;
    f32x4 acc[2][2][4][2];
#pragma unroll
    for (int a = 0; a < 2; ++a)
#pragma unroll
        for (int b = 0; b < 2; ++b)
#pragma unroll
            for (int m = 0; m < 4; ++m)
#pragma unroll
                for (int n = 0; n < 2; ++n) acc[a][b][m][n] = (f32x4){0.f, 0.f, 0.f, 0.f};
    bf16x8 At[4][2], B0[2][2], B1[2][2];
    unsigned cA = (unsigned)cur.pm * tstepA, cB = (unsigned)cur.pn * tstep;
    S.a_ready(cur);
    if constexpr (SP2) {
        PG8_STAGE_B(PG8_SB(0, 0), cB, voffB); PG8_STAGE_B(PG8_SB(0, 1), cB + hstep, voffB); PG8_STAGE_A(PG8_SA(0, 0), cA, voffA); PG8_STAGE_A(PG8_SA(0, 1), cA + hstep, voffA);
        if (wr == 1) PG8_BAR;
        PG8_WAIT_V(2); PG8_BAR;
        PG8_STAGE_B(PG8_SB(1, 0), cB + kstep, voffB); PG8_STAGE_A(PG8_SA(1, 0), cA + kstep, voffA); PG8_STAGE_B(PG8_SB(1, 1), cB + hstep + kstep, voffB);
        PG8_WAIT_V(6); PG8_BAR;
    } else {
        PG8_STAGE_B(PG8_SB(0, 0), cB, voffB); PG8_STAGE_A(PG8_SA(0, 0), cA, voffA); PG8_STAGE_B(PG8_SB(0, 1), cB + hstep, voffB); PG8_STAGE_A(PG8_SA(0, 1), cA + hstep, voffA);
        if (wr == 1) PG8_BAR;
        PG8_WAIT_V(4); PG8_BAR;
        PG8_STAGE_B(PG8_SB(1, 0), cB + kstep, voffB); PG8_STAGE_A(PG8_SA(1, 0), cA + kstep, voffA); PG8_STAGE_B(PG8_SB(1, 1), cB + hstep + kstep, voffB);
        PG8_WAIT_V(6); PG8_BAR;
    }
    for (;;) {
        const bool has_next = S.next(ui + 1, nxt);
        const unsigned nA = has_next ? (unsigned)nxt.pm * tstepA : cA, nB = has_next ? (unsigned)nxt.pn * tstep : cB;
        for (int t = 0; t < nt; t += 2) {
            const bool last = (t == nt - 2);
            const unsigned a1 = cA + (unsigned)(t + 1) * kstep;
            const unsigned a2 = last ? nA : cA + (unsigned)(t + 2) * kstep, b2 = last ? nB : cB + (unsigned)(t + 2) * kstep;
            const unsigned a3 = a2 + kstep, b3 = b2 + kstep;
            if (last && has_next) S.a_ready(nxt);
            if constexpr (SP2) {
            PG8_LDB(B0, 0, 0); PG8_LDB(B1, 0, 1); PG8_SCHED; PG8_LDA(At, 0, 0); PG8_STAGE_A(PG8_SA(1, 1), a1 + hstep, voffA);
            PG8_WAIT_V(8); PG8_WAIT_L(0); PG8_BAR; PG8_MMA(0, 0, At, B0); PG8_MMA(0, 1, At, B1); PG8_BAR; PG8_SCHED;
            PG8_LDA(At, 0, 1); PG8_STAGE_B(PG8_SB(0, 0), b2, voffB); PG8_STAGE_B(PG8_SB(0, 1), b2 + hstep, voffB); PG8_STAGE_A(PG8_SA(0, 0), a2, voffA);
            PG8_WAIT_V(8); PG8_WAIT_L(0); PG8_BAR; PG8_MMA(1, 0, At, B0); PG8_MMA(1, 1, At, B1); PG8_BAR; PG8_SCHED;
            PG8_LDB(B0, 1, 0); PG8_LDB(B1, 1, 1); PG8_SCHED; PG8_LDA(At, 1, 0); PG8_STAGE_A(PG8_SA(0, 1), a2 + hstep, voffA);
            PG8_WAIT_V(8); PG8_WAIT_L(0); PG8_BAR; PG8_MMA(0, 0, At, B0); PG8_MMA(0, 1, At, B1); PG8_BAR; PG8_SCHED;
            PG8_LDA(At, 1, 1); PG8_STAGE_B(PG8_SB(1, 0), b3, voffB); PG8_STAGE_B(PG8_SB(1, 1), b3 + hstep, voffB); PG8_STAGE_A(PG8_SA(1, 0), a3, voffA);
            PG8_WAIT_V(8); PG8_WAIT_L(0); PG8_BAR; PG8_MMA(1, 0, At, B0); PG8_MMA(1, 1, At, B1); PG8_BAR; PG8_SCHED;
            } else {
            PG8_LDB(B0, 0, 0); PG8_SCHED; PG8_LDA(At, 0, 0); PG8_STAGE_A(PG8_SA(1, 1), a1 + hstep, voffA);
            PG8_WAIT_L(8); PG8_BAR; PG8_WAIT_L(0); PG8_MMA(0, 0, At, B0); PG8_BAR; PG8_SCHED;
            PG8_LDB(B1, 0, 1); PG8_STAGE_B(PG8_SB(0, 0), b2, voffB);
            PG8_BAR; PG8_WAIT_L(0); PG8_MMA(0, 1, At, B1); PG8_BAR;
            PG8_LDA(At, 0, 1); PG8_STAGE_A(PG8_SA(0, 0), a2, voffA);
            PG8_BAR; PG8_WAIT_L(0); PG8_MMA(1, 0, At, B0); PG8_BAR; PG8_SCHED;
            PG8_STAGE_B(PG8_SB(0, 1), b2 + hstep, voffB);
            PG8_WAIT_V(6); PG8_BAR; PG8_MMA(1, 1, At, B1); PG8_BAR;
            PG8_LDB(B0, 1, 0); PG8_SCHED; PG8_LDA(At, 1, 0); PG8_STAGE_A(PG8_SA(0, 1), a2 + hstep, voffA);
            PG8_WAIT_L(8); PG8_BAR; PG8_WAIT_L(0); PG8_MMA(0, 0, At, B0); PG8_BAR; PG8_SCHED;
            PG8_LDB(B1, 1, 1); PG8_STAGE_B(PG8_SB(1, 0), b3, voffB);
            PG8_BAR; PG8_WAIT_L(0); PG8_MMA(0, 1, At, B1); PG8_BAR;
            PG8_LDA(At, 1, 1); PG8_STAGE_A(PG8_SA(1, 0), a3, voffA);
            PG8_BAR; PG8_WAIT_L(0); PG8_MMA(1, 0, At, B0); PG8_BAR; PG8_SCHED;
            PG8_STAGE_B(PG8_SB(1, 1), b3 + hstep, voffB);
            PG8_WAIT_V(6); PG8_BAR; PG8_MMA(1, 1, At, B1); PG8_BAR;
            }
        }
        if constexpr (ALIGN_EPI) { if (wr == 0) PG8_BAR; }
        if constexpr (!Epi::AFTER_DRAIN) { E(acc, cur, wr, wc, fr, fq); S.done(cur); }
        if (!has_next) break;
#pragma unroll
        for (int a = 0; a < 2; ++a)
#pragma unroll
            for (int b = 0; b < 2; ++b)
#pragma unroll
                for (int m = 0; m < 4; ++m)
#pragma unroll
                    for (int n = 0; n < 2; ++n) acc[a][b][m][n] = (f32x4){0.f, 0.f, 0.f, 0.f};
        cur = nxt; cA = nA; cB = nB; ++ui;
        if constexpr (ALIGN_EPI) { if (wr == 1) PG8_BAR; }
    }
    PG8_WAIT_V(0);
    if constexpr (!ALIGN_EPI) { if (wr == 0) PG8_BAR; }
    PG8_BAR;
    if constexpr (Epi::AFTER_DRAIN) { E.fused(acc, cur, wr, wc, fr, fq, lds, wid, lane); S.done(cur); }
#undef PG8_SA
#undef PG8_SB
#undef PG8_STAGE_X
#undef PG8_STAGE_A
#undef PG8_STAGE_B
#undef PG8_LDA
#undef PG8_LDB
#undef PG8_MMA
#undef PG8_WAIT_V
#undef PG8_WAIT_L
#undef PG8_BAR
#undef PG8_SCHED
}
}
#define GAS __attribute__((address_space(1)))
#define LAS __attribute__((address_space(3)))
typedef unsigned short bf16;
typedef unsigned v4u __attribute__((ext_vector_type(4)));
typedef float f32x4 __attribute__((ext_vector_type(4)));
typedef short bf16x8 __attribute__((ext_vector_type(8)));
typedef GAS unsigned gu32;
typedef GAS unsigned long long gu64;
#define RLX_AGENT __ATOMIC_RELAXED, __HIP_MEMORY_SCOPE_AGENT
#define LDS_WAIT() asm volatile("s_waitcnt lgkmcnt(0)" ::: "memory")
#define VM_WAIT() asm volatile("s_waitcnt vmcnt(0)" ::: "memory")
__device__ __forceinline__ unsigned long long rt() { return __builtin_amdgcn_s_memrealtime(); }
__device__ __forceinline__ unsigned f2bf(float f) { unsigned u = __builtin_bit_cast(unsigned, f); return (u + 0x7fffu + ((u >> 16) & 1u)) >> 16; }
__device__ __forceinline__ unsigned pk2(float lo, float hi) { return f2bf(lo) | (f2bf(hi) << 16); }

#define XB_TMO      128
#define XB_XCNT(j)  (256  + 64 * (j))
#define XB_XSUB(j)  (1280 + 64 * (j))
#define XB_XGEN(j)  (2304 + 64 * (j))
#define XB_TOP      3328
#define XB_TOPGEN   3392
#define XCD_BAR_WORDS 3456
#define GB_SUB(j)   (3456 + 64 * (j))
#define GB_GEN(j)   (3968 + 64 * (j))
#define GB_MASK(j)  (4480 + 64 * (j))
#define GB_WDONE    4992
#define GB_MDONE    5056
#define QB_SUB(j)   (5120 + 64 * (j))
#define QB_GEN(j)   (9216 + 64 * (j))
#define XB_SPIN_CAP (1u << 18)
#ifndef QSLEEP
#define QSLEEP 16
#endif

__device__ __forceinline__ unsigned xb_ld(unsigned* p)              { return __hip_atomic_load(p, __ATOMIC_RELAXED, __HIP_MEMORY_SCOPE_AGENT); }
__device__ __forceinline__ unsigned xb_add(unsigned* p, unsigned v) { return __hip_atomic_fetch_add(p, v, __ATOMIC_RELAXED, __HIP_MEMORY_SCOPE_AGENT); }
__device__ __forceinline__ unsigned xb_xcc_id() { return (unsigned)__builtin_amdgcn_s_getreg((3 << 11) | 20) & 0xFu; }
#define XB_SPIN(cond, bar) do { unsigned _sp = 0; while (cond) { __builtin_amdgcn_s_sleep(1); \
    if ((++_sp & 255u) == 0u) { if (xb_ld(&(bar)[XB_TMO])) break; if (_sp > XB_SPIN_CAP) { atomicAdd(&(bar)[XB_TMO], 1u); break; } } } } while (0)

struct XcdBarrier {
    unsigned* bar; unsigned x;
    volatile LAS unsigned* st;
};

__device__ __forceinline__ XcdBarrier xcd_barrier_post(unsigned* bar, volatile LAS unsigned* st) {
    XcdBarrier b; b.bar = bar; b.x = xb_xcc_id(); b.st = st;
    if (threadIdx.x == 0) (void)xb_add(&bar[XB_XCNT(b.x)], 1u);
    return b;
}
__device__ __forceinline__ void xcd_barrier_complete(unsigned* bar, unsigned x, unsigned& nloc, unsigned& nx) {
    const unsigned G = gridDim.x * gridDim.y * gridDim.z;
    unsigned sum, cnt, mine, sp = 0u;
    for (;;) {
        sum = 0u; cnt = 0u; mine = 0u;
#pragma unroll
        for (unsigned j = 0; j < 16; ++j) { const unsigned c = xb_ld(&bar[XB_XCNT(j)]); sum += c; cnt += (c > 0u) ? 1u : 0u; mine = (j == x) ? c : mine; }
        if (sum == G) break;
        __builtin_amdgcn_s_sleep(1);
        if ((++sp & 255u) == 0u) { if (xb_ld(&bar[XB_TMO])) break; if (sp > XB_SPIN_CAP) { atomicAdd(&bar[XB_TMO], 1u); break; } }
    }
    nloc = mine > 0u ? mine : 1u; nx = cnt > 0u ? cnt : 1u;
}

__device__ __forceinline__ void xcd_barrier(const XcdBarrier& b) {
    asm volatile("s_waitcnt vmcnt(0)" ::: "memory");
    __syncthreads();
    if (threadIdx.x == 0) {
        unsigned* bar = b.bar;
        __builtin_amdgcn_s_waitcnt(0);
        unsigned nloc = b.st[0], nx = b.st[1];
        if (nloc == 0u) { xcd_barrier_complete(bar, b.x, nloc, nx); b.st[0] = nloc; b.st[1] = nx; }
        const unsigned old = xb_add(&bar[XB_XSUB(b.x)], 1u);
        const unsigned gen = old / nloc;
        if (old + 1u == (gen + 1u) * nloc) {
            __builtin_amdgcn_fence(__ATOMIC_RELEASE, "agent");
            asm volatile("s_waitcnt vmcnt(0)" ::: "memory");
            const unsigned og = xb_add(&bar[XB_TOP], 1u);
            const unsigned tg = og / nx;
            if (og + 1u == (tg + 1u) * nx) xb_add(&bar[XB_TOPGEN], 1u);
            else XB_SPIN(xb_ld(&bar[XB_TOPGEN]) == tg, bar);
            __builtin_amdgcn_fence(__ATOMIC_ACQUIRE, "agent");
            xb_add(&bar[XB_XGEN(b.x)], 1u);
            asm volatile("s_waitcnt vmcnt(0)" ::: "memory");
        } else {
            XB_SPIN(xb_ld(&bar[XB_XGEN(b.x)]) == gen, bar);
            __builtin_amdgcn_fence(__ATOMIC_ACQUIRE, "agent");
            asm volatile("s_waitcnt vmcnt(0)" ::: "memory");
        }
    }
    __syncthreads();
}

__device__ __forceinline__ void grp_barrier(unsigned* bar, unsigned subw, unsigned genw, unsigned nloc, bool wb) {
    asm volatile("s_waitcnt vmcnt(0)" ::: "memory");
    __syncthreads();
    if (threadIdx.x == 0) {
        __builtin_amdgcn_s_waitcnt(0);
        if (wb) { __builtin_amdgcn_fence(__ATOMIC_RELEASE, "agent"); asm volatile("s_waitcnt vmcnt(0)" ::: "memory"); }
        const unsigned old = xb_add(&bar[subw], 1u);
        const unsigned gen = old / nloc;
        if (old + 1u == (gen + 1u) * nloc) xb_add(&bar[genw], 1u);
        else XB_SPIN(xb_ld(&bar[genw]) == gen, bar);
        __builtin_amdgcn_fence(__ATOMIC_ACQUIRE, "agent");
        asm volatile("s_waitcnt vmcnt(0)" ::: "memory");
    }
    __syncthreads();
}

constexpr int NWAVES = 8;
constexpr int BATCH = 16, SEQ = 2048, DM = 1024, DEPTH = 2, DFF = 2816, NGU = 2 * DFF, NPROJ = 3328, RWKV_IN = 1792, NLORA = 1536, KLORA = 256;
constexpr int M = BATCH * SEQ;
constexpr int RET_OFF = RWKV_IN;
constexpr float LN_X_EPS = 64e-5f;
constexpr size_t MiB = 1u << 20;
constexpr size_t WS_CTL = 0, CTL_ZERO_BYTES = 1 * MiB;
constexpr size_t SZ_WGU = (size_t)NGU * DM * 2, SZ_WD = (size_t)DM * DFF * 2, SZ_WIN = (size_t)NPROJ * DM * 2, SZ_WLORA = (size_t)NLORA * KLORA * 2, SZ_WOUT = (size_t)DM * DM * 2;
constexpr size_t OFF_WGU1 = 0, OFF_WD1 = OFF_WGU1 + SZ_WGU, OFF_WIN = OFF_WD1 + SZ_WD, OFF_WLORA = OFF_WIN + SZ_WIN, OFF_WOUT = OFF_WLORA + SZ_WLORA, OFF_WGU2 = OFF_WOUT + SZ_WOUT, OFF_WD2 = OFF_WGU2 + SZ_WGU, SZ_LAYER = OFF_WD2 + SZ_WD;
constexpr size_t WS_W = 1 * MiB;
constexpr size_t WS_TRIG = WS_W + DEPTH * SZ_LAYER;
constexpr size_t WS_SSQ = 86 * MiB;
constexpr size_t WS_XB = 90 * MiB;
constexpr size_t WS_SIDE = 186 * MiB;
constexpr size_t WS_DUMP = 192 * MiB;
constexpr size_t WS_ALORA = 154 * MiB;
constexpr size_t WS_MIXED = 218 * MiB;
constexpr size_t WS_H = 282 * MiB;
constexpr size_t WS_END = 490 * MiB;
static_assert(WS_TRIG + 2 * 2048 * 32 * 4 <= WS_SSQ && WS_SSQ + 2 * (size_t)M * 16 * 4 <= WS_XB && WS_XB + (size_t)M * DM * 2 <= WS_SIDE && (size_t)M * NLORA * 2 <= (size_t)M * DM * 4 && WS_H + (size_t)M * NPROJ * 2 <= WS_END, "d_ws map");
constexpr int CW_TMO = 0, CW_CODE = 1, CW_BAR = 4096;

constexpr int RING_OFF = 0, RING_BYTES = 131072;
constexpr int LDSCTL_OFF = 161792, MISC_OFF = LDSCTL_OFF + 320;
constexpr int EPI_TAB_OFF = 131072;
constexpr int LDS_BYTES = 163840;

__device__ __forceinline__ int opaque_bx() { int b = (int)blockIdx.x; asm volatile("" : "+s"(b)); return b; }
struct Frame {
    LAS unsigned char* lds;
    volatile LAS unsigned* MISC;
    int tid, lane, wave;
    int vcu, G;
    unsigned char* ws;
    unsigned char* lora;
};
struct LayerP {
    const float *mu, *w0, *a0, *k_k, *k_a, *r_k, *ln_w, *ln_b;
    const unsigned short* wlora;
};
__device__ __forceinline__ float bf_lo(unsigned u) { return __builtin_bit_cast(float, u << 16); }
__device__ __forceinline__ float bf_hi(unsigned u) { return __builtin_bit_cast(float, u & 0xffff0000u); }
typedef float f32x2_t __attribute__((ext_vector_type(2))); typedef __bf16 bf16x2_t __attribute__((ext_vector_type(2)));
__device__ __forceinline__ unsigned cvtpk(float lo, float hi) { f32x2_t v = {lo, hi}; bf16x2_t b = __builtin_convertvector(v, bf16x2_t); return __builtin_bit_cast(unsigned, b); }
__device__ __forceinline__ float wave_sum(float v) {
#pragma unroll
    for (int o = 1; o < 64; o <<= 1) v += __shfl_xor(v, o);
    return v;
}
template <int CTRL> __device__ __forceinline__ float dpp_f(float v) { return __builtin_bit_cast(float, __builtin_amdgcn_update_dpp(0, __builtin_bit_cast(int, v), CTRL, 0xF, 0xF, true)); }
__device__ __forceinline__ float sum8(float v) { v += dpp_f<0xB1>(v); v += dpp_f<0x4E>(v); v += dpp_f<0x141>(v); return v; }
__device__ __forceinline__ float sum16(float v) { v = sum8(v); v += dpp_f<0x140>(v); return v; }
__device__ __forceinline__ float sigm(float x) { return __builtin_amdgcn_rcpf(1.0f + __expf(-x)); }

constexpr int P0_SCR_BYTES = 64 * 65 * 4;
__device__ __forceinline__ void p0_transpose_item(const float* W, int K, int N, const float* gain, bf16* WT, int k0, int n0, int dst_row0, LAS float* scr, int lane) {
    const int n4 = (lane & 15) * 4, kr = lane >> 4;
#pragma unroll 8
    for (int i = 0; i < 16; ++i) { const int kk = 4 * i + kr; const float g = gain ? gain[k0 + kk] : 1.0f;
        const f32x4 v = *(const GAS f32x4*)(W + (size_t)(k0 + kk) * N + n0 + n4);
        LAS float* s = scr + kk * 65 + n4; s[0] = v.x * g; s[1] = v.y * g; s[2] = v.z * g; s[3] = v.w * g; }
    LDS_WAIT(); asm volatile("" ::: "memory");
    const int c = lane & 7;
#pragma unroll
    for (int j = 0; j < 8; ++j) { const int n = (lane >> 3) + 8 * j; const LAS float* s = scr + (8 * c) * 65 + n;
        v4u o; o.x = pk2(s[0 * 65], s[1 * 65]); o.y = pk2(s[2 * 65], s[3 * 65]); o.z = pk2(s[4 * 65], s[5 * 65]); o.w = pk2(s[6 * 65], s[7 * 65]);
        *(GAS v4u*)(WT + (size_t)(dst_row0 + n) * K + k0 + 8 * c) = o; }
    LDS_WAIT(); asm volatile("" ::: "memory");
}
struct Args { const float* in[24]; float* out; unsigned char* ws; int ph_lo, ph_hi; };
constexpr int ITEMS_FF = (DM / 64) * (DFF / 64), ITEMS_IN = (DM / 64) * (NPROJ / 64), ITEMS_OUT = (DM / 64) * (DM / 64);
constexpr int ITEMS_LAYER = 6 * ITEMS_FF + ITEMS_IN + ITEMS_OUT;
constexpr int ITEMS_EARLY = 2 * ITEMS_FF;
__device__ __forceinline__ void p0_weights(const Frame& F, const Args& A, int it_lo, int it_hi, int gw, int NGW) {
    LAS float* scr = (LAS float*)(F.lds + RING_OFF + F.wave * P0_SCR_BYTES);
    for (int it = it_lo + gw; it < it_hi; it += NGW) {
        const int l = it / ITEMS_LAYER; int r = it % ITEMS_LAYER;
        bf16* wl = (bf16*)(F.ws + WS_W + (size_t)l * SZ_LAYER);
        const float* W; const float* gain = nullptr; bf16* WT; int K, N, mode = 0;
        if (r < ITEMS_FF)            { W = A.in[2] + (size_t)l * DM * DFF; gain = A.in[1] + l * DM; WT = (bf16*)((unsigned char*)wl + OFF_WGU1); K = DM; N = DFF; mode = 1; }
        else if ((r -= ITEMS_FF) < ITEMS_FF)  { W = A.in[3] + (size_t)l * DM * DFF; gain = A.in[1] + l * DM; WT = (bf16*)((unsigned char*)wl + OFF_WGU1); K = DM; N = DFF; mode = 2; }
        else if ((r -= ITEMS_FF) < ITEMS_FF)  { W = A.in[4] + (size_t)l * DFF * DM; WT = (bf16*)((unsigned char*)wl + OFF_WD1); K = DFF; N = DM; }
        else if ((r -= ITEMS_FF) < ITEMS_IN)  { W = A.in[6] + (size_t)l * DM * NPROJ; gain = A.in[5] + l * DM; WT = (bf16*)((unsigned char*)wl + OFF_WIN); K = DM; N = NPROJ; }
        else if ((r -= ITEMS_IN) < ITEMS_OUT) { W = A.in[18] + (size_t)l * DM * DM; WT = (bf16*)((unsigned char*)wl + OFF_WOUT); K = DM; N = DM; }
        else if ((r -= ITEMS_OUT) < ITEMS_FF) { W = A.in[20] + (size_t)l * DM * DFF; gain = A.in[19] + l * DM; WT = (bf16*)((unsigned char*)wl + OFF_WGU2); K = DM; N = DFF; mode = 1; }
        else if ((r -= ITEMS_FF) < ITEMS_FF)  { W = A.in[21] + (size_t)l * DM * DFF; gain = A.in[19] + l * DM; WT = (bf16*)((unsigned char*)wl + OFF_WGU2); K = DM; N = DFF; mode = 2; }
        else { r -= ITEMS_FF;                   W = A.in[22] + (size_t)l * DFF * DM; WT = (bf16*)((unsigned char*)wl + OFF_WD2); K = DFF; N = DM; }
        const int nblk = N / 64, kb = r / nblk, nb = r % nblk, k0 = 64 * kb, n0 = 64 * nb;
        const int dst = mode == 0 ? n0 : ((n0 >> 7) * 256 + (n0 & 127) + (mode == 2 ? 128 : 0));
        p0_transpose_item(W, K, N, gain, WT, k0, n0, dst, scr, F.lane);
    }
}
__device__ __forceinline__ void p0_prologue(const Frame& F, const Args& A) {
    const int gw = F.vcu * NWAVES + F.wave, NGW = F.G * NWAVES;
    p0_weights(F, A, 0, F.G == 256 ? ITEMS_EARLY : DEPTH * ITEMS_LAYER, gw, NGW);
    const int gt = gw * 64 + F.lane, NGT = NGW * 64;
    for (int it = gt; it < DEPTH * NLORA * (KLORA / 8); it += NGT) {
        const int l = it / (NLORA * (KLORA / 8)), r = it % (NLORA * (KLORA / 8)), n = r >> 5, k8 = (r & 31) * 8;
        const int blk = n >> 9, nn = n & 511;
        const int klo = blk == 0 ? 0 : (blk == 1 ? 64 : 128), khi = blk == 0 ? 64 : (blk == 1 ? 128 : 256);
        const float* src = blk == 0 ? A.in[9] + (size_t)l * 64 * 512 : (blk == 1 ? A.in[11] + (size_t)l * 64 * 512 : A.in[12] + (size_t)l * 128 * 512);
        float v[8];
#pragma unroll
        for (int j = 0; j < 8; ++j) { const int k = k8 + j; v[j] = (k >= klo && k < khi) ? src[(size_t)(k - klo) * 512 + nn] : 0.0f; }
        v4u o; o.x = pk2(v[0], v[1]); o.y = pk2(v[2], v[3]); o.z = pk2(v[4], v[5]); o.w = pk2(v[6], v[7]);
        *(GAS v4u*)((bf16*)(F.ws + WS_W + (size_t)l * SZ_LAYER + OFF_WLORA) + (size_t)n * KLORA + k8) = o;
    }
    for (int it = gt; it < SEQ * 32; it += NGT) {
        const int pos = it >> 5, i = it & 31;
        const float x = (float)i * (1.0f / 31.0f);
        const float inv_freq = 1.0f / powf(10000.0f, x);
        const float ang = (float)pos * inv_freq;
        float sn, cs; sincosf(ang, &sn, &cs);
        ((float*)(F.ws + WS_TRIG))[it] = cs; ((float*)(F.ws + WS_TRIG))[SEQ * 32 + it] = sn;
    }
    const float* x = A.in[0]; bf16* xb = (bf16*)(F.ws + WS_XB); float* ssq = (float*)(F.ws + WS_SSQ);
    for (int m = gw; m < M; m += 4 * NGW) {
        f32x4 v[4][4]; int mr[4]; bool has[4];
#pragma unroll
        for (int r = 0; r < 4; ++r) { mr[r] = m + r * NGW; has[r] = mr[r] < M; if (!has[r]) mr[r] = m;
            const GAS f32x4* xr = (const GAS f32x4*)(x + (size_t)mr[r] * DM) + F.lane;
#pragma unroll
            for (int j = 0; j < 4; ++j) v[r][j] = xr[64 * j]; }
#pragma unroll
        for (int r = 0; r < 4; ++r) {
            GAS unsigned long long* o8 = (GAS unsigned long long*)(xb + (size_t)mr[r] * DM) + F.lane;
            float sq = 0.f;
#pragma unroll
            for (int j = 0; j < 4; ++j) { sq += (v[r][j].x * v[r][j].x + v[r][j].y * v[r][j].y) + (v[r][j].z * v[r][j].z + v[r][j].w * v[r][j].w);
                if (has[r]) o8[64 * j] = (unsigned long long)pk2(v[r][j].x, v[r][j].y) | ((unsigned long long)pk2(v[r][j].z, v[r][j].w) << 32); }
            sq = wave_sum(sq);
            if (has[r] && F.lane < 16) ssq[(size_t)mr[r] * 16 + F.lane] = (F.lane == 0) ? sq : 0.0f;
        }
    }
}
__device__ __forceinline__ void lora_prep(const Frame& F, const float* mu) {
    const bf16* proj = (const bf16*)(F.ws + WS_H); bf16* alora = (bf16*)(F.ws + WS_ALORA);
    const int gt = (F.vcu * NWAVES + F.wave) * 64 + F.lane, NGT = F.G * NWAVES * 64;
    for (int it = gt; it < M * 32; it += NGT) {
        const int m = it >> 5, c8 = (it & 31) * 8;
        const v4u pc = *(const GAS v4u*)(proj + (size_t)m * NPROJ + 1536 + c8);
        v4u pp = (v4u){0u, 0u, 0u, 0u};
        if ((m & (SEQ - 1)) != 0) pp = *(const GAS v4u*)(proj + (size_t)(m - 1) * NPROJ + 1536 + c8);
        const f32x4 m0 = *(const f32x4*)(mu + 1536 + c8), m1 = *(const f32x4*)(mu + 1536 + c8 + 4);
        float v[8];
#pragma unroll
        for (int j = 0; j < 4; ++j) { const unsigned a = pc[j], b = pp[j]; const float ml = j < 2 ? m0[2 * j] : m1[2 * j - 4], mh = j < 2 ? m0[2 * j + 1] : m1[2 * j - 3];
            const float cl = bf_lo(a), ch = bf_hi(a), pl = bf_lo(b), ph = bf_hi(b);
            v[2 * j] = cl + ml * (pl - cl); v[2 * j + 1] = ch + mh * (ph - ch); }
        if (c8 < 64) {
#pragma unroll
            for (int j = 0; j < 8; ++j) v[j] = 1.0f - 2.0f * __builtin_amdgcn_rcpf(1.0f + __expf(2.0f * v[j]));
        } else if (c8 >= 128) {
#pragma unroll
            for (int j = 0; j < 8; ++j) v[j] = sigm(v[j]);
        }
        v4u o; o.x = cvtpk(v[0], v[1]); o.y = cvtpk(v[2], v[3]); o.z = cvtpk(v[4], v[5]); o.w = cvtpk(v[6], v[7]);
        *(GAS v4u*)(alora + (size_t)m * KLORA + c8) = o;
    }
    bf16* side = (bf16*)(F.ws + WS_SIDE);
    for (int it = gt; it < (M / 16) * 192; it += NGT) {
        const int cidx = it / 192, c8 = (it % 192) * 8;
        *(GAS v4u*)(side + (size_t)cidx * 1536 + c8) = *(const GAS v4u*)(proj + ((size_t)cidx * 16 + 15) * NPROJ + c8);
    }
}
__device__ __forceinline__ void lora_prep_piece(const Frame& F, const float* mu, int m, int c8) {
    const bf16* proj = (const bf16*)(F.ws + WS_H); bf16* alora = (bf16*)(F.ws + WS_ALORA);
    const v4u pc = *(const GAS v4u*)(proj + (size_t)m * NPROJ + 1536 + c8);
    v4u pp = (v4u){0u, 0u, 0u, 0u};
    if ((m & (SEQ - 1)) != 0) pp = *(const GAS v4u*)(proj + (size_t)(m - 1) * NPROJ + 1536 + c8);
    const f32x4 m0 = *(const f32x4*)(mu + 1536 + c8), m1 = *(const f32x4*)(mu + 1536 + c8 + 4);
    float v[8];
#pragma unroll
    for (int j = 0; j < 4; ++j) { const unsigned a = pc[j], b = pp[j]; const float ml = j < 2 ? m0[2 * j] : m1[2 * j - 4], mh = j < 2 ? m0[2 * j + 1] : m1[2 * j - 3];
        const float cl = bf_lo(a), ch = bf_hi(a), pl = bf_lo(b), ph = bf_hi(b);
        v[2 * j] = cl + ml * (pl - cl); v[2 * j + 1] = ch + mh * (ph - ch); }
    if (c8 < 64) {
#pragma unroll
        for (int j = 0; j < 8; ++j) v[j] = 1.0f - 2.0f * __builtin_amdgcn_rcpf(1.0f + __expf(2.0f * v[j]));
    } else if (c8 >= 128) {
#pragma unroll
        for (int j = 0; j < 8; ++j) v[j] = sigm(v[j]);
    }
    v4u o; o.x = cvtpk(v[0], v[1]); o.y = cvtpk(v[2], v[3]); o.z = cvtpk(v[4], v[5]); o.w = cvtpk(v[6], v[7]);
    *(GAS v4u*)(alora + (size_t)m * KLORA + c8) = o;
}
__device__ __forceinline__ void lora_prep_panel(const Frame& F, const float* mu, int pm) {
    for (int it = F.tid; it < 256 * 32; it += NWAVES * 64) { const int r = it >> 5, m = pm * 256 + r;
        if (r == 0 && (m & (SEQ - 1)) != 0) continue;
        lora_prep_piece(F, mu, m, (it & 31) * 8); }
}
__device__ __forceinline__ void lora_prep_edges(const Frame& F, const float* mu, int n0) {
    if ((n0 & 15) == 0 && n0 != 0) { const int b = F.tid >> 5, m = b * SEQ + n0 * 16; lora_prep_piece(F, mu, m, (F.tid & 31) * 8); }
    asm volatile("s_waitcnt vmcnt(0)" ::: "memory");
    __syncthreads();
}
__device__ __forceinline__ void lora_prep_edges_grp(const Frame& F, const float* mu, int g, int q) {
    if (F.tid < 128) { const int e = F.tid >> 5, b = 2 * g + (e & 1), n = 32 * q + 16 * (e >> 1);
        if (n != 0) lora_prep_piece(F, mu, b * SEQ + n * 16, (F.tid & 31) * 8); }
    asm volatile("s_waitcnt vmcnt(0)" ::: "memory");
    __syncthreads();
}
constexpr int M1_PW = 14592;
constexpr int M1_EL = 0;
constexpr int M1_AT = 0, M1_BT = 2304, M1_KT = 4608, M1_RT = 6912;
constexpr int M1_TMP = 0, M1_SM = 2304, M1_AHT = 2304 + 8 * 1024;
constexpr int M1W_LD = 72, M1G_LD = 136;
constexpr int M1W_W = NWAVES * M1_PW, M1W_A = M1W_W + 64 * M1W_LD * 2, M1W_G = M1W_A + 64 * M1W_LD * 2, M1W_END = M1W_G + 64 * M1G_LD * 2;
constexpr int M1W_PRM = M1W_END;
static_assert(M1_AHT + 4096 == M1_PW && M1W_PRM + 8 * 64 * 4 <= LDSCTL_OFF && (M1W_W % 16) == 0 && (M1W_PRM % 16) == 0, "M1 LDS");
__device__ __forceinline__ float bfu(unsigned short x) { return __builtin_bit_cast(float, (unsigned)x << 16); }
__device__ __forceinline__ unsigned short bf1(float x) { return (unsigned short)(cvtpk(x, x) & 0xffffu); }
typedef unsigned u32x2_t __attribute__((ext_vector_type(2)));
__device__ __forceinline__ f32x4 bf4(u32x2_t u) { return (f32x4){bf_lo(u[0]), bf_hi(u[0]), bf_lo(u[1]), bf_hi(u[1])}; }
#define LBAR() do { asm volatile("s_waitcnt lgkmcnt(0)" ::: "memory"); __builtin_amdgcn_s_barrier(); asm volatile("" ::: "memory"); } while (0)
#define M1_WAIT() asm volatile("s_waitcnt lgkmcnt(0)" ::: "memory")
__device__ __forceinline__ bf16* slot_mix(const Frame& F, size_t m, int h) { return (bf16*)(F.ws + WS_MIXED) + m * DM + h * 64; }
__device__ __forceinline__ bf16* slot_lw(const Frame& F, size_t m, int h) { return (bf16*)(F.lora) + m * NLORA + h * 64; }
__device__ __forceinline__ bf16* slot_la(const Frame& F, size_t m, int h) { return (bf16*)(F.lora) + m * NLORA + 512 + h * 64; }
__device__ __forceinline__ bf16* slot_pr(const Frame& F, size_t m, int h) { return (bf16*)(F.ws + WS_H) + m * NPROJ + h * 64; }
__device__ __forceinline__ bf16* slot_pk(const Frame& F, size_t m, int h) { return (bf16*)(F.ws + WS_H) + m * NPROJ + 512 + h * 64; }
__device__ __forceinline__ bf16* slot_pv(const Frame& F, size_t m, int h) { return (bf16*)(F.ws + WS_H) + m * NPROJ + 1024 + h * 64; }
typedef short bf16x4 __attribute__((ext_vector_type(4)));
#define M2_K16(p) (*(const LAS bf16x4*)(p))
#define M2_MFMA16(a, b, c) __builtin_amdgcn_mfma_f32_16x16x16bf16_1k(a, b, c, 0, 0, 0)
#define M2_TR16(p) __builtin_amdgcn_ds_read_tr16_b64_v4i16((LAS bf16x4*)(p))
__device__ __forceinline__ bf16x4 m2_acc_op(const f32x4& d) { u32x2_t w_; w_[0] = cvtpk(d[0], d[1]); w_[1] = cvtpk(d[2], d[3]); return __builtin_bit_cast(bf16x4, w_); }
struct M1Alf { bf16x8 f[8]; };
__device__ __forceinline__ void m1_alf_issue(const Frame& F, int u, int lane, M1Alf& A) {
    const int n = u & 127, b = u >> 10; const size_t mb = (size_t)b * SEQ + n * 16;
    const bf16* AL = (const bf16*)(F.ws + WS_ALORA) + (mb + (lane & 15)) * KLORA + 8 * (lane >> 4);
#pragma unroll
    for (int ks = 0; ks < 8; ++ks) asm volatile("global_load_dwordx4 %0, %1, off" : "+v"(A.f[ks]) : "v"(AL + 32 * ks) : "memory");
}
#define M1_ALF_WAIT(A) asm volatile("s_waitcnt vmcnt(0)" : "+v"((A).f[0]), "+v"((A).f[1]), "+v"((A).f[2]), "+v"((A).f[3]), "+v"((A).f[4]), "+v"((A).f[5]), "+v"((A).f[6]), "+v"((A).f[7]) :: "memory")
__device__ __forceinline__ void rwkv_m1_unit(const Frame& F, const LayerP& L, int u, int u_next, M1Alf& ALF, LAS unsigned char* wl) {
    const int n = u & 127, h = (u >> 7) & 7, b = u >> 10;
    int ln_ = F.lane; asm volatile("" : "+v"(ln_));
    const int lane = ln_, lr = lane & 15, lq = lane >> 4, te = lane >> 2, c0 = (lane & 3) * 16, ch = h * 64 + c0;
    const size_t mb = (size_t)b * SEQ + n * 16, m = mb + te;
    const bf16* P = (const bf16*)(F.ws + WS_H) + m * NPROJ;
    const bool hasp = (te > 0) || (n > 0);
    const bf16* Pp = (te > 0) ? (P - NPROJ) : ((const bf16*)(F.ws + WS_SIDE) + ((size_t)b * 128 + (n > 0 ? n - 1 : 0)) * 1536);
    v4u rc[2], kc[2], vc[2], rp[2], kp[2], vp[2], lw[2], la[2];
#pragma unroll
    for (int hh = 0; hh < 2; ++hh) { rc[hh] = *(const GAS v4u*)(P + ch + 8 * hh); kc[hh] = *(const GAS v4u*)(P + 512 + ch + 8 * hh); vc[hh] = *(const GAS v4u*)(P + 1024 + ch + 8 * hh);
        rp[hh] = (v4u){0u, 0u, 0u, 0u}; kp[hh] = rp[hh]; vp[hh] = rp[hh];
        if (hasp) { rp[hh] = *(const GAS v4u*)(Pp + ch + 8 * hh); kp[hh] = *(const GAS v4u*)(Pp + 512 + ch + 8 * hh); vp[hh] = *(const GAS v4u*)(Pp + 1024 + ch + 8 * hh); } }
    {   bf16x8 alf[8];
#pragma unroll
        for (int ks = 0; ks < 8; ++ks) alf[ks] = ALF.f[ks];
        LAS bf16* WW = (LAS bf16*)(F.lds + M1W_W); LAS bf16* WA = (LAS bf16*)(F.lds + M1W_A); LAS bf16* WG = (LAS bf16*)(F.lds + M1W_G);
        LAS bf16* LWs = (LAS bf16*)(wl + M1_AT); LAS bf16* LAs = (LAS bf16*)(wl + M1_BT);
        const f32x4 z4l = (f32x4){0.f, 0.f, 0.f, 0.f};
#pragma unroll
        for (int ct = 0; ct < 4; ++ct) {
            f32x4 dw = z4l, da = z4l, dg = z4l;
#pragma unroll
            for (int ks = 0; ks < 2; ++ks) {
                dw = __builtin_amdgcn_mfma_f32_16x16x32_bf16(*(const LAS bf16x8*)(WW + (16 * ct + lr) * M1W_LD + 32 * ks + 8 * lq), alf[ks], dw, 0, 0, 0);
                da = __builtin_amdgcn_mfma_f32_16x16x32_bf16(*(const LAS bf16x8*)(WA + (16 * ct + lr) * M1W_LD + 32 * ks + 8 * lq), alf[2 + ks], da, 0, 0, 0); }
#pragma unroll
            for (int ks = 0; ks < 4; ++ks)
                dg = __builtin_amdgcn_mfma_f32_16x16x32_bf16(*(const LAS bf16x8*)(WG + (16 * ct + lr) * M1G_LD + 32 * ks + 8 * lq), alf[4 + ks], dg, 0, 0, 0);
            u32x2_t wv; wv[0] = cvtpk(dw[0], dw[1]); wv[1] = cvtpk(dw[2], dw[3]); *(LAS u32x2_t*)(LWs + lr * 72 + 16 * ct + 4 * lq) = wv;
            wv[0] = cvtpk(da[0], da[1]); wv[1] = cvtpk(da[2], da[3]); *(LAS u32x2_t*)(LAs + lr * 72 + 16 * ct + 4 * lq) = wv;
            wv[0] = cvtpk(dg[0], dg[1]); wv[1] = cvtpk(dg[2], dg[3]); *(GAS u32x2_t*)((bf16*)(F.lora) + (mb + lr) * NLORA + 1024 + h * 64 + 16 * ct + 4 * lq) = wv; }
        m1_alf_issue(F, u_next, lane, ALF);
        M1_WAIT();
#pragma unroll
        for (int hh = 0; hh < 2; ++hh) { lw[hh] = *(const LAS v4u*)(LWs + te * 72 + c0 + 8 * hh); la[hh] = *(const LAS v4u*)(LAs + te * 72 + c0 + 8 * hh); }
        M1_WAIT();
    }
    float r[16], kh[16], v[16], al[16], e[16], kraw[16]; float ss = 0.f, bs = 0.f;
#pragma unroll
    for (int q = 0; q < 4; ++q) { const int cc = ch + 4 * q; const int hh = q >> 1, w2 = (q & 1) * 2;
        const LAS float* PR = (const LAS float*)(F.lds + M1W_PRM) + c0 + 4 * q;
        const f32x4 mur = *(const LAS f32x4*)(PR), muk = *(const LAS f32x4*)(PR + 64), muv = *(const LAS f32x4*)(PR + 128), w0p = *(const LAS f32x4*)(PR + 192), a0p = *(const LAS f32x4*)(PR + 256);
        const f32x4 kkp = *(const LAS f32x4*)(PR + 320), kap = *(const LAS f32x4*)(PR + 384), rkp = *(const LAS f32x4*)(PR + 448);
#pragma unroll
        for (int j = 0; j < 4; ++j) { const int i = 4 * q + j; const unsigned sh = (j & 1) ? 0xffff0000u : 0u; const int wd = w2 + (j >> 1);
#define M1_BF(x) ((j & 1) ? bf_hi((x)[hh][wd]) : bf_lo((x)[hh][wd]))
            const float rcv = M1_BF(rc), kcv = M1_BF(kc), vcv = M1_BF(vc), rpv = M1_BF(rp), kpv = M1_BF(kp), vpv = M1_BF(vp), lwv = M1_BF(lw), lav = M1_BF(la);
#undef M1_BF
            (void)sh;
            r[i] = rcv + mur[j] * (rpv - rcv); const float ks = kcv + muk[j] * (kpv - kcv); v[i] = vcv + muv[j] * (vpv - vcv);
            al[i] = sigm(a0p[j] + lav); e[i] = 0.6065306597126334f * sigm(w0p[j] + lwv);
            kraw[i] = ks * kkp[j]; ss += kraw[i] * kraw[i];
            kh[i] = ks * (1.0f + (al[i] - 1.0f) * kap[j]); bs += r[i] * kh[i] * rkp[j]; } }
    ss += dpp_f<0xB1>(ss); ss += dpp_f<0x4E>(ss); bs += dpp_f<0xB1>(bs); bs += dpp_f<0x4E>(bs);
    const float inv = 1.0f / sqrtf(fmaxf(ss, 1e-24f));
    if ((lane & 3) == 0) ((GAS float*)slot_pv(F, mb + 14, h))[te] = bs;
    LAS float* EL = (LAS float*)(wl + M1_EL);
#pragma unroll
    for (int q = 0; q < 4; ++q) *(LAS f32x4*)(EL + te * 64 + c0 + 4 * q) = (f32x4){e[4 * q], e[4 * q + 1], e[4 * q + 2], e[4 * q + 3]};
    M1_WAIT();
    { float acc = 0.f;
#pragma unroll
      for (int t = 0; t < 16; ++t) { acc += EL[t * 64 + lane]; EL[t * 64 + lane] = acc; }
      ((GAS float*)slot_pv(F, mb + 12 + (lane >> 5), h))[lane & 31] = __expf(-acc); }
    M1_WAIT();
    float Lt[16], LC[16];
#pragma unroll
    for (int q = 0; q < 4; ++q) { const f32x4 a4 = *(const LAS f32x4*)(EL + te * 64 + c0 + 4 * q), b4 = *(const LAS f32x4*)(EL + 15 * 64 + c0 + 4 * q);
#pragma unroll
        for (int j = 0; j < 4; ++j) { Lt[4 * q + j] = a4[j]; LC[4 * q + j] = b4[j]; } }
    M1_WAIT();
    unsigned pat[8], pbt[8], pkt[8], prt[8], pbh[8], pkh[8], pv[8];
#pragma unroll
    for (int i2 = 0; i2 < 8; ++i2) { float at2[2], bt2[2], kt2[2], rt2[2], bh2[2], kh2[2];
#pragma unroll
        for (int s = 0; s < 2; ++s) { const int i = 2 * i2 + s; const float x1 = __expf(Lt[i]), x1i = __builtin_amdgcn_rcpf(x1), xm1 = x1i * __expf(e[i]), xc = __expf(Lt[i] - LC[i]);
            const float kn = kraw[i] * inv, ba = kn * al[i];
            at2[s] = -kn * xm1; bt2[s] = ba * x1; kt2[s] = kh[i] * x1; rt2[s] = r[i] * x1i; bh2[s] = ba * xc; kh2[s] = kh[i] * xc; }
        pat[i2] = cvtpk(at2[0], at2[1]); pbt[i2] = cvtpk(bt2[0], bt2[1]); pkt[i2] = cvtpk(kt2[0], kt2[1]); prt[i2] = cvtpk(rt2[0], rt2[1]);
        pbh[i2] = cvtpk(bh2[0], bh2[1]); pkh[i2] = cvtpk(kh2[0], kh2[1]); pv[i2] = cvtpk(v[2 * i2], v[2 * i2 + 1]); }
    LAS bf16* AT = (LAS bf16*)(wl + M1_AT); LAS bf16* BT = (LAS bf16*)(wl + M1_BT); LAS bf16* KT = (LAS bf16*)(wl + M1_KT); LAS bf16* RT = (LAS bf16*)(wl + M1_RT);
#pragma unroll
    for (int hh = 0; hh < 2; ++hh) {
        *(LAS v4u*)(AT + te * 72 + c0 + 8 * hh) = (v4u){pat[4 * hh], pat[4 * hh + 1], pat[4 * hh + 2], pat[4 * hh + 3]};
        *(LAS v4u*)(BT + te * 72 + c0 + 8 * hh) = (v4u){pbt[4 * hh], pbt[4 * hh + 1], pbt[4 * hh + 2], pbt[4 * hh + 3]};
        *(LAS v4u*)(KT + te * 72 + c0 + 8 * hh) = (v4u){pkt[4 * hh], pkt[4 * hh + 1], pkt[4 * hh + 2], pkt[4 * hh + 3]};
        const v4u rr = (v4u){prt[4 * hh], prt[4 * hh + 1], prt[4 * hh + 2], prt[4 * hh + 3]};
        *(LAS v4u*)(RT + te * 72 + c0 + 8 * hh) = rr; *(GAS v4u*)(slot_lw(F, m, h) + c0 + 8 * hh) = rr; }
    M1_WAIT();
    const bf16x8 at0 = *(const LAS bf16x8*)(AT + lr * 72 + 8 * lq), at1 = *(const LAS bf16x8*)(AT + lr * 72 + 32 + 8 * lq);
    const bf16x8 b0 = *(const LAS bf16x8*)(BT + lr * 72 + 8 * lq), b1 = *(const LAS bf16x8*)(BT + lr * 72 + 32 + 8 * lq);
    const bf16x8 k0 = *(const LAS bf16x8*)(KT + lr * 72 + 8 * lq), k1 = *(const LAS bf16x8*)(KT + lr * 72 + 32 + 8 * lq);
    const bf16x8 r0 = *(const LAS bf16x8*)(RT + lr * 72 + 8 * lq), r1 = *(const LAS bf16x8*)(RT + lr * 72 + 32 + 8 * lq);
    M1_WAIT();
    const f32x4 z4 = (f32x4){0.f, 0.f, 0.f, 0.f};
    f32x4 dL = z4, dLt = z4, dKt = z4, dRb = z4, dRk = z4;
    dL = __builtin_amdgcn_mfma_f32_16x16x32_bf16(b0, at0, dL, 0, 0, 0); dL = __builtin_amdgcn_mfma_f32_16x16x32_bf16(b1, at1, dL, 0, 0, 0);
    dLt = __builtin_amdgcn_mfma_f32_16x16x32_bf16(at0, b0, dLt, 0, 0, 0); dLt = __builtin_amdgcn_mfma_f32_16x16x32_bf16(at1, b1, dLt, 0, 0, 0);
    dKt = __builtin_amdgcn_mfma_f32_16x16x32_bf16(at0, k0, dKt, 0, 0, 0); dKt = __builtin_amdgcn_mfma_f32_16x16x32_bf16(at1, k1, dKt, 0, 0, 0);
    dRb = __builtin_amdgcn_mfma_f32_16x16x32_bf16(b0, r0, dRb, 0, 0, 0); dRb = __builtin_amdgcn_mfma_f32_16x16x32_bf16(b1, r1, dRb, 0, 0, 0);
    dRk = __builtin_amdgcn_mfma_f32_16x16x32_bf16(k0, r0, dRk, 0, 0, 0); dRk = __builtin_amdgcn_mfma_f32_16x16x32_bf16(k1, r1, dRk, 0, 0, 0);
    f32x4 eye;
#pragma unroll
    for (int i = 0; i < 4; ++i) { const int rr = 4 * lq + i; eye[i] = (rr == lr) ? 1.0f : 0.0f;
        dL[i] = (rr < lr) ? dL[i] : 0.f; dLt[i] = (lr < rr) ? dLt[i] : 0.f; dKt[i] = (lr < rr) ? dKt[i] : 0.f; dRb[i] = (rr <= lr) ? dRb[i] : 0.f; dRk[i] = (rr <= lr) ? dRk[i] : 0.f; }
    {
        u32x2_t wv; wv[0] = cvtpk(dRb[0], dRb[1]); wv[1] = cvtpk(dRb[2], dRb[3]); *(GAS u32x2_t*)(slot_pv(F, mb + 4 + (lr >> 2), h) + (lr & 3) * 16 + 4 * lq) = wv;
        wv[0] = cvtpk(dRk[0], dRk[1]); wv[1] = cvtpk(dRk[2], dRk[3]); *(GAS u32x2_t*)(slot_pv(F, mb + 8 + (lr >> 2), h) + (lr & 3) * 16 + 4 * lq) = wv; }
#pragma unroll
    for (int hh = 0; hh < 2; ++hh) {
        *(GAS v4u*)(slot_pr(F, m, h) + c0 + 8 * hh) = (v4u){pbh[4 * hh], pbh[4 * hh + 1], pbh[4 * hh + 2], pbh[4 * hh + 3]};
        *(GAS v4u*)(slot_pk(F, m, h) + c0 + 8 * hh) = (v4u){pkh[4 * hh], pkh[4 * hh + 1], pkh[4 * hh + 2], pkh[4 * hh + 3]};
        *(GAS v4u*)(slot_la(F, m, h) + c0 + 8 * hh) = (v4u){pv[4 * hh], pv[4 * hh + 1], pv[4 * hh + 2], pv[4 * hh + 3]}; }
    {
        const bf16x4 fL = m2_acc_op(dL), fLt = m2_acc_op(dLt);
        const f32x4 z4b = (f32x4){0.f, 0.f, 0.f, 0.f};
        const f32x4 dL2 = M2_MFMA16(fL, fLt, z4b), dL2t = M2_MFMA16(fLt, fL, z4b);
        f32x4 dTt = dL + eye;
        const bf16x4 fL2t = m2_acc_op(dL2), fL2 = m2_acc_op(dL2t);
        dTt = M2_MFMA16(fL2t, m2_acc_op(dTt), dTt);
        const f32x4 dL4 = M2_MFMA16(fL2, fL2t, z4b), dL4t = M2_MFMA16(fL2t, fL2, z4b);
        const bf16x4 fL4t = m2_acc_op(dL4), fL4 = m2_acc_op(dL4t);
        dTt = M2_MFMA16(fL4t, m2_acc_op(dTt), dTt);
        const f32x4 dL8 = M2_MFMA16(fL4, fL4t, z4b);
        dTt = M2_MFMA16(m2_acc_op(dL8), m2_acc_op(dTt), dTt);
        const bf16x4 tq = m2_acc_op(dTt);
        const f32x4 nn = M2_MFMA16(m2_acc_op(dKt), tq, z4b);
        u32x2_t wv; wv[0] = cvtpk(nn[0], nn[1]); wv[1] = cvtpk(nn[2], nn[3]); *(GAS u32x2_t*)(slot_pv(F, mb + (lr >> 2), h) + (lr & 3) * 16 + 4 * lq) = wv;
#pragma unroll
        for (int tc = 0; tc < 4; ++tc) { const bf16x4 ah = __builtin_amdgcn_ds_read_tr16_b64_v4i16((LAS bf16x4*)(AT + (4 * lq + (lr >> 2)) * 72 + 16 * tc + 4 * (lr & 3)));
            const f32x4 pq = M2_MFMA16(ah, tq, z4b);
            wv[0] = cvtpk(pq[0], pq[1]); wv[1] = cvtpk(pq[2], pq[3]); *(GAS u32x2_t*)(slot_mix(F, mb + lr, h) + 16 * tc + 4 * lq) = wv; }
    }
    M1_WAIT();
    M1_ALF_WAIT(ALF);
}

__device__ __forceinline__ void rwkv_m1_phase(const Frame& F, const LayerP& L) {
    LAS unsigned char* wl = F.lds + RING_OFF + F.wave * M1_PW;
    const int NGW = F.G * NWAVES; int hcur = -1;
    const bool GL = (F.G == 256); const int grp = F.vcu >> 5, li = F.vcu & 31;
    if (GL) lora_prep_edges_grp(F, L.mu, grp, li & 3);
    M1Alf ALF;
#pragma unroll
    for (int ks = 0; ks < 8; ++ks) ALF.f[ks] = (bf16x8){0, 0, 0, 0, 0, 0, 0, 0};
    {   int ul_ = F.lane; asm volatile("" : "+v"(ul_));
        const int uf = (GL ? (((2 * grp) << 10) | ((li >> 2) << 7) | (32 * (li & 3))) : F.vcu * NWAVES) + F.wave;
        m1_alf_issue(F, uf < BATCH * 8 * 128 ? uf : 0, ul_, ALF); M1_ALF_WAIT(ALF); }
    for (int r = 0;; ++r) {
        const int u0 = GL ? (((2 * grp + (r & 1)) << 10) | ((li >> 2) << 7) | (32 * (li & 3) + 8 * (r >> 1))) : F.vcu * NWAVES + r * NGW;
        if (GL ? (r >= 8) : (u0 >= BATCH * 8 * 128)) break;
        const int h = (u0 >> 7) & 7;
        if (h != hcur) {
            if (hcur >= 0) __syncthreads();
            const bf16* W = L.wlora; const int t = F.tid, row = t >> 3, pc = (t & 7) * 8;
            *(LAS v4u*)(F.lds + M1W_W + (row * M1W_LD + pc) * 2) = *(const GAS v4u*)(W + (size_t)(h * 64 + row) * KLORA + pc);
            *(LAS v4u*)(F.lds + M1W_A + (row * M1W_LD + pc) * 2) = *(const GAS v4u*)(W + (size_t)(512 + h * 64 + row) * KLORA + 64 + pc);
#pragma unroll
            for (int j = 0; j < 2; ++j) *(LAS v4u*)(F.lds + M1W_G + (row * M1G_LD + 64 * j + pc) * 2) = *(const GAS v4u*)(W + (size_t)(1024 + h * 64 + row) * KLORA + 128 + 64 * j + pc);
            if (t < 128) { const int pr = t >> 4, c4 = (t & 15) * 4;
                const float* src = pr == 0 ? L.mu : (pr == 1 ? L.mu + 512 : (pr == 2 ? L.mu + 1024 : (pr == 3 ? L.w0 : (pr == 4 ? L.a0 : (pr == 5 ? L.k_k : (pr == 6 ? L.k_a : L.r_k))))));
                *(LAS f32x4*)((LAS float*)(F.lds + M1W_PRM) + pr * 64 + c4) = *(const f32x4*)(src + h * 64 + c4); }
            __syncthreads(); hcur = h; }
        const int u = u0 + F.wave;
        int un = GL ? ((((2 * grp + ((r + 1) & 1)) << 10) | ((li >> 2) << 7) | (32 * (li & 3) + 8 * ((r + 1) >> 1))) + F.wave) : u + NGW;
        if (GL ? (r + 1 >= 8) : (un >= BATCH * 8 * 128)) un = u;
        if (u < BATCH * 8 * 128) rwkv_m1_unit(F, L, u, un, ALF, wl);
    }
}
constexpr int S2_PM = 0, S2_NM = S2_PM + 2304, S2_RT = S2_NM + 1280, S2_MRB = S2_RT + 2304, S2_MRK = S2_MRB + 1280, S2_BH = S2_MRK + 1280, S2_KH = S2_BH + 2560, S2_VS = S2_KH + 2560,
              S2_GC = S2_VS + 2560, S2_RK = S2_GC + 256, S2_SET = S2_RK + 64;
constexpr int S2_SAT = 3 * S2_SET, S2_S = S2_SAT + 5120, S2_YB = S2_S + 2 * 9216, S2_PRM = S2_YB + 2 * 4352, S2_END = S2_PRM + 512;
static_assert(S2_END <= RING_BYTES && (S2_SET % 16) == 0 && (S2_S % 16) == 0 && (S2_YB % 16) == 0, "M2 LDS");
struct M2Raw { v4u a, b, c; };
struct M2Ptr { const bf16 *pa, *pb, *pc; };
__device__ __forceinline__ void m2_ptr0(const Frame& F, int b, int h, int i, M2Ptr& P) {
    const size_t mb = (size_t)b * SEQ; const int i7 = i & 127, row = i7 >> 3, chk = i7 & 7;
    P.pa = (i < 128 ? slot_mix(F, mb + row, h) : slot_lw(F, mb + row, h)) + chk * 8;
    P.pb = (i < 128 ? slot_la(F, mb + row, h) : slot_pr(F, mb + row, h)) + chk * 8;
    const int k1 = i - 128, k2 = i - 224, k3 = i - 240;
    const int tok = i < 128 ? row : (i < 224 ? (k1 >> 3) : (i < 240 ? 12 + (k2 >> 3) : 14));
    const int col = i < 128 ? 512 + chk * 8 : 1024 + (i < 224 ? (k1 & 7) : (i < 240 ? (k2 & 7) : (k3 & 3))) * 8;
    P.pc = (const bf16*)(F.ws + WS_H) + (mb + tok) * NPROJ + h * 64 + col;
}
__device__ __forceinline__ void m2_adv(M2Ptr& P, int i) { P.pa += (i < 128 ? 16 * DM : 16 * NLORA); P.pb += (i < 128 ? 16 * NLORA : 16 * NPROJ); P.pc += 16 * NPROJ; }
__device__ __forceinline__ void m2_load(const M2Ptr& P, M2Raw& R) {
    asm volatile("global_load_dwordx4 %0, %1, off" : "+v"(R.a) : "v"(P.pa) : "memory");
    asm volatile("global_load_dwordx4 %0, %1, off" : "+v"(R.b) : "v"(P.pb) : "memory");
    asm volatile("global_load_dwordx4 %0, %1, off" : "+v"(R.c) : "v"(P.pc) : "memory");
}
#define M2_WAIT_R(R, N) asm volatile("s_waitcnt vmcnt(" #N ")" : "+v"((R).a), "+v"((R).b), "+v"((R).c) :: "memory")
#define M2_WAIT_G(G, N) asm volatile("s_waitcnt vmcnt(" #N ")" : "+v"(G) :: "memory")
__device__ __forceinline__ void g_load(const bf16* p, u32x2_t& G) { asm volatile("global_load_dwordx2 %0, %1, off" : "+v"(G) : "v"(p) : "memory"); }
struct M2Off { int a, b, c; };
__device__ __forceinline__ void m2_off(int i, M2Off& O) {
    const int i7 = i & 127, row = i7 >> 3, chk = i7 & 7;
    O.a = (i < 128 ? S2_PM : S2_RT) + (row * 72 + chk * 8) * 2;
    O.b = (i < 128 ? S2_VS : S2_BH) + (row * 80 + chk * 8) * 2;
    int c = -1;
    if (i < 128) c = S2_KH + (row * 80 + chk * 8) * 2;
    else if (i < 224) { const int k = i - 128, mat = k >> 5, kk = k & 31, t = kk >> 1, hf = kk & 1;
        c = (mat == 0 ? S2_NM : (mat == 1 ? S2_MRB : S2_MRK)) + (t * 40 + hf * 8) * 2; }
    else if (i < 240) c = S2_GC + (i - 224) * 16;
    else if (i < 244) c = S2_RK + (i - 240) * 16;
    O.c = c;
}
__device__ __forceinline__ void m2_store(LAS unsigned char* set, const M2Off& O, const M2Raw& R) {
    *(LAS v4u*)(set + O.a) = R.a; *(LAS v4u*)(set + O.b) = R.b;
    if (O.c >= 0) *(LAS v4u*)(set + O.c) = R.c;
}
#define M2_LDR_ITER(RSET, GSET) \
    { \
        const int pt = tl_ & 255, te = pt >> 4, c4 = (pt & 15) * 4; \
        { \
            LAS unsigned char* SP = lds + ((n + 2) % 3) * S2_SET; \
            const LAS float* PRM = (const LAS float*)(lds + S2_PRM) + c4; \
            const u32x2_t vraw = *(const LAS u32x2_t*)((const LAS bf16*)(SP + S2_VS) + te * 80 + c4); \
            const f32x4 y = *(const LAS f32x4*)((LAS float*)(lds + S2_YB) + ((n + 1) & 1) * 1088 + te * 68 + c4); \
            const f32x4 lnw = *(const LAS f32x4*)(PRM), lnb = *(const LAS f32x4*)(PRM + 64); \
            const f32x4 vv = bf4(vraw); \
            const float bonus = ((const LAS float*)(SP + S2_RK))[te]; \
            __builtin_amdgcn_sched_barrier(0); \
            float s1 = (y[0] + y[1]) + (y[2] + y[3]), s2 = (y[0] * y[0] + y[1] * y[1]) + (y[2] * y[2] + y[3] * y[3]);        \
            s1 += dpp_f<0xB1>(s1); s2 += dpp_f<0xB1>(s2); s1 += dpp_f<0x4E>(s1); s2 += dpp_f<0x4E>(s2); s1 += dpp_f<0x141>(s1); s2 += dpp_f<0x141>(s2); s1 += dpp_f<0x140>(s1); s2 += dpp_f<0x140>(s2); \
            const float mean = s1 * (1.0f / 64.0f), var = fmaxf(s2 * (1.0f / 64.0f) - mean * mean, 0.0f); \
            const f32x4 d = y - mean; \
            const float rstd = __builtin_amdgcn_rsqf(var + LN_X_EPS); \
            M2_WAIT_G(GSET, 18); \
            const f32x4 o = (d * rstd * lnw + lnb + vv * bonus) * bf4(GSET); \
            u32x2_t wv; wv[0] = cvtpk(o[0], o[1]); wv[1] = cvtpk(o[2], o[3]); \
            const bool live = n >= 1 && n <= NCH;                                     \
            GAS u32x2_t* dst = live ? (GAS u32x2_t*)(op) : (GAS u32x2_t*)(dump); \
            *dst = wv; \
            if (live) op += 16 * DM; \
            g_load(gq, GSET); if (n + 4 < NCH) gq += 16 * NLORA; \
        } \
        M2_WAIT_R(RSET, 17); \
        if (n + 1 < NCH) m2_store(lds + ((n + 1) % 3) * S2_SET, OFF, RSET); \
        m2_load(P, RSET); if (n + 6 < NCH) m2_adv(P, pt); \
        LBAR(); \
    }
#define M2_ST_ITER() \
    { \
        const int lane = tl_ & 63, lr = lane & 15, lq = lane >> 4, q = w - 4; \
        if (n < NCH) { \
            LAS unsigned char* SC = lds + (n % 3) * S2_SET; \
            LAS bf16* PM = (LAS bf16*)(SC + S2_PM); LAS bf16* NM = (LAS bf16*)(SC + S2_NM); LAS bf16* VS = (LAS bf16*)(SC + S2_VS); LAS bf16* RT = (LAS bf16*)(SC + S2_RT); \
            LAS bf16* MRB = (LAS bf16*)(SC + S2_MRB); LAS bf16* MRK = (LAS bf16*)(SC + S2_MRK); LAS bf16* BH = (LAS bf16*)(SC + S2_BH); LAS bf16* KH = (LAS bf16*)(SC + S2_KH); \
            const int trow = (4 * lq + (lr >> 2)) * 80 + 4 * (lr & 3);                  \
            bf16x4 pf[4], rf[4], bhf[4], khf[4]; f32x4 gc[4]; \
            _Pragma("unroll") \
            for (int kt = 0; kt < 4; ++kt) { pf[kt] = M2_K16(PM + lr * 72 + 16 * kt + 4 * lq); rf[kt] = M2_K16(RT + lr * 72 + 16 * kt + 4 * lq); \
                bhf[kt] = M2_TR16(BH + trow + 16 * kt); khf[kt] = M2_TR16(KH + trow + 16 * kt); \
                gc[kt] = *(const LAS f32x4*)((LAS float*)(SC + S2_GC) + 16 * kt + 4 * lq); } \
            const bf16x4 nf = M2_K16(NM + lr * 40 + 4 * lq), mbf = M2_K16(MRB + lr * 40 + 4 * lq), mkf = M2_K16(MRK + lr * 40 + 4 * lq), vf = M2_TR16(VS + trow + 16 * q); \
            __builtin_amdgcn_sched_barrier(0); \
            bf16x4 so[4]; \
            _Pragma("unroll") \
            for (int kt = 0; kt < 4; ++kt) so[kt] = m2_acc_op(accS[kt]); \
            const f32x4 z4_ = (f32x4){0.f, 0.f, 0.f, 0.f}; \
            f32x4 sa = M2_MFMA16(nf, vf, z4_), sb = z4_, ya = M2_MFMA16(mkf, vf, z4_), yb = z4_; \
            sa = M2_MFMA16(pf[0], so[0], sa); sb = M2_MFMA16(pf[1], so[1], sb); sa = M2_MFMA16(pf[2], so[2], sa); sb = M2_MFMA16(pf[3], so[3], sb); \
            ya = M2_MFMA16(rf[0], so[0], ya); yb = M2_MFMA16(rf[1], so[1], yb); ya = M2_MFMA16(rf[2], so[2], ya); yb = M2_MFMA16(rf[3], so[3], yb); \
            sa = sa + sb; \
            const bf16x4 sao = m2_acc_op(sa); \
            ya = M2_MFMA16(mbf, sao, ya); \
            _Pragma("unroll") \
            for (int kt = 0; kt < 4; ++kt) { accS[kt] = accS[kt] * gc[kt]; accS[kt] = M2_MFMA16(bhf[kt], sao, accS[kt]); accS[kt] = M2_MFMA16(khf[kt], vf, accS[kt]); } \
            ya = ya + yb;                                                            \
            LAS float* YBs = (LAS float*)(lds + S2_YB) + (n & 1) * 1088 + 16 * q + lr; \
            _Pragma("unroll") \
            for (int i = 0; i < 4; ++i) YBs[(4 * lq + i) * 68] = ya[i]; \
        } \
        LBAR(); \
    }
__device__ __forceinline__ void rwkv_m2_unit(const Frame& F, const LayerP& L, int unit) {
    const int b = unit >> 3, h = unit & 7;
    LAS unsigned char* lds = F.lds + RING_OFF;
    const int tid = F.tid, w = F.wave;
    const bool ldr = w < 4;
    constexpr int NCH = SEQ / 16;
    int tl_ = tid; asm volatile("" : "+v"(tl_));
    for (int i = tid; i < S2_PRM / 4; i += NWAVES * 64) ((LAS unsigned*)lds)[i] = 0u;
    if (tid < 32) { const int row = tid >> 4, c = (tid & 15) * 4; *(LAS f32x4*)((LAS float*)(lds + S2_PRM) + row * 64 + c) = *(const f32x4*)((row == 0 ? L.ln_w : L.ln_b) + h * 64 + c); }
    __syncthreads();
    if (ldr) {
        M2Raw R0, R1, R2, R3; R0.a = (v4u){0u, 0u, 0u, 0u}; R0.b = R0.a; R0.c = R0.a; R1 = R0; R2 = R0; R3 = R0;
        u32x2_t G0 = (u32x2_t){0u, 0u}, G1 = G0, G2 = G0, G3 = G0;
        const int pt = tid, te = pt >> 4, c4 = (pt & 15) * 4, ch = h * 64 + c4;
        M2Ptr P; m2_ptr0(F, b, h, pt, P);
        M2Off OFF; m2_off(pt, OFF);
        { M2Raw T = R0; m2_load(P, T); m2_adv(P, pt); M2_WAIT_R(T, 0); m2_store(lds, OFF, T); }
        const bf16* gq = (const bf16*)(F.lora) + ((size_t)b * SEQ + te) * NLORA + 1024 + ch;
        bf16* op = (bf16*)(F.ws + WS_MIXED) + ((size_t)b * SEQ + te) * DM + ch;
        bf16* dump = (bf16*)(F.ws + WS_DUMP) + ((size_t)F.vcu * 256 + pt) * 4;
#define M2_FILL(RSET, GSET, GADV) { *(GAS u32x2_t*)dump = (u32x2_t){0u, 0u}; g_load(gq, GSET); if (GADV) gq += 16 * NLORA; m2_load(P, RSET); m2_adv(P, pt); }
        M2_FILL(R1, G3, false) M2_FILL(R2, G0, true) M2_FILL(R3, G1, true) M2_FILL(R0, G2, true)
#undef M2_FILL
        __syncthreads();
        for (int n0 = 0; n0 <= NCH; n0 += 4) {
            { const int n = n0;     M2_LDR_ITER(R1, G3) }
            { const int n = n0 + 1; M2_LDR_ITER(R2, G0) }
            { const int n = n0 + 2; M2_LDR_ITER(R3, G1) }
            { const int n = n0 + 3; M2_LDR_ITER(R0, G2) }
        }
        asm volatile("s_waitcnt vmcnt(0)" ::: "memory");
    } else {
        f32x4 accS[4];
#pragma unroll
        for (int q = 0; q < 4; ++q) accS[q] = (f32x4){0.f, 0.f, 0.f, 0.f};
        __syncthreads();
        for (int n0 = 0; n0 <= NCH; n0 += 4) {
            { const int n = n0;     M2_ST_ITER() }
            { const int n = n0 + 1; M2_ST_ITER() }
            { const int n = n0 + 2; M2_ST_ITER() }
            { const int n = n0 + 3; M2_ST_ITER() }
        }
    }
    __syncthreads();
}
constexpr int RT_LD = 72, RT_K2LD = 80, RT_VLD = 144, RT_OLD = 132;
constexpr int RT_QS = 0, RT_KS = RT_QS + 64 * RT_LD * 2, RT_K2 = RT_KS + 64 * RT_LD * 2, RT_SC = RT_K2 + 64 * RT_K2LD * 2, RT_VS = RT_SC + 64 * RT_LD * 2, RT_PT = RT_VS + 64 * RT_VLD * 2,
              RT_OB = RT_PT + 128 * RT_LD * 2, RT_END = RT_OB + 64 * RT_OLD * 4;
static_assert(RT_END <= RING_BYTES && (RT_K2 % 16) == 0 && (RT_VS % 16) == 0 && (RT_OB % 16) == 0, "retention LDS");
typedef unsigned ret_u2 __attribute__((ext_vector_type(2)));
typedef short ret_s4 __attribute__((ext_vector_type(4)));
struct RetA { ret_u2 q1, q2, k1, k2; v4u va, vb; f32x4 cs, sn; };
struct RetG { v4u ga, gb; };
#define RET_LD2(dst, ptr) asm volatile("global_load_dwordx2 %0, %1, off" : "+v"(dst) : "v"(ptr) : "memory")
#define RET_LD4(dst, ptr) asm volatile("global_load_dwordx4 %0, %1, off" : "+v"(dst) : "v"(ptr) : "memory")
__device__ __forceinline__ void ret_load_a(const bf16* P, const float* CS, const float* SN, int h, int dq, RetA& R) {
    const int d = dq * 4, e0 = dq * 16;
    RET_LD2(R.q1, P + h * 64 + d); RET_LD2(R.q2, P + h * 64 + 32 + d); RET_LD2(R.k1, P + 256 + h * 64 + d); RET_LD2(R.k2, P + 256 + h * 64 + 32 + d);
    RET_LD4(R.va, P + 512 + h * 128 + e0); RET_LD4(R.vb, P + 512 + h * 128 + e0 + 8); RET_LD4(R.cs, CS + d); RET_LD4(R.sn, SN + d);
}
__device__ __forceinline__ void ret_load_g(const bf16* P, int h, int dq, RetG& R) { const int e0 = dq * 16; RET_LD4(R.ga, P + 1024 + h * 128 + e0); RET_LD4(R.gb, P + 1024 + h * 128 + e0 + 8); }
#define RET_WAIT_A(R, N) asm volatile("s_waitcnt vmcnt(" #N ")" : "+v"((R).q1), "+v"((R).q2), "+v"((R).k1), "+v"((R).k2), "+v"((R).va), "+v"((R).vb), "+v"((R).cs), "+v"((R).sn) :: "memory")
#define RET_WAIT_G(R, N) asm volatile("s_waitcnt vmcnt(" #N ")" : "+v"((R).ga), "+v"((R).gb) :: "memory")
__device__ __forceinline__ bf16x8 ret_tr(const LAS bf16* img, int ld, int r0, int c0, int lr, int lq) {
    const LAS bf16* p = img + (r0 + 4 * lq + (lr >> 2)) * ld + c0 + 4 * (lr & 3);
    const ret_s4 a = __builtin_amdgcn_ds_read_tr16_b64_v4i16((LAS ret_s4*)p), b = __builtin_amdgcn_ds_read_tr16_b64_v4i16((LAS ret_s4*)(p + 16 * ld));
    return __builtin_shufflevector(a, b, 0, 1, 2, 3, 4, 5, 6, 7);
}
__device__ __forceinline__ bf16x8 ret_rowp(const LAS bf16* row, int k0, int lq) {
    const ret_s4 a = *(const LAS ret_s4*)(row + k0 + 4 * lq), b = *(const LAS ret_s4*)(row + k0 + 16 + 4 * lq);
    return __builtin_shufflevector(a, b, 0, 1, 2, 3, 4, 5, 6, 7);
}
#define RET_ITER(A, G) \
    { \
        int tl_ = tid; asm volatile("" : "+v"(tl_)); \
        const int lane = tl_ & 63, lr = lane & 15, lq = lane >> 4, i = tl_ >> 3, dq = tl_ & 7, d = dq * 4, e0 = dq * 16; \
        const int n2 = (n + 2 < SEQ / 64) ? n + 2 : SEQ / 64 - 1; \
        const bf16* P2 = prow + (size_t)n2 * 64 * NPROJ; \
        {     \
            RET_WAIT_A(A, 16); \
            const f32x4 cs = A.cs, sn = A.sn; \
            f32x4 x1, x2; \
            x1[0] = bf_lo(A.q1[0]); x1[1] = bf_hi(A.q1[0]); x1[2] = bf_lo(A.q1[1]); x1[3] = bf_hi(A.q1[1]); \
            x2[0] = bf_lo(A.q2[0]); x2[1] = bf_hi(A.q2[0]); x2[2] = bf_lo(A.q2[1]); x2[3] = bf_hi(A.q2[1]); \
            f32x4 o1 = x1 * cs - x2 * sn, o2 = x1 * sn + x2 * cs; \
            ret_u2 wv; wv[0] = cvtpk(o1[0], o1[1]); wv[1] = cvtpk(o1[2], o1[3]); *(LAS ret_u2*)(QS + i * RT_LD + d) = wv; \
            wv[0] = cvtpk(o2[0], o2[1]); wv[1] = cvtpk(o2[2], o2[3]); *(LAS ret_u2*)(QS + i * RT_LD + 32 + d) = wv; \
            x1[0] = bf_lo(A.k1[0]); x1[1] = bf_hi(A.k1[0]); x1[2] = bf_lo(A.k1[1]); x1[3] = bf_hi(A.k1[1]); \
            x2[0] = bf_lo(A.k2[0]); x2[1] = bf_hi(A.k2[0]); x2[2] = bf_lo(A.k2[1]); x2[3] = bf_hi(A.k2[1]); \
            o1 = (x1 * cs - x2 * sn) * 0.125f; o2 = (x1 * sn + x2 * cs) * 0.125f; \
            wv[0] = cvtpk(o1[0], o1[1]); wv[1] = cvtpk(o1[2], o1[3]); *(LAS ret_u2*)(KS + i * RT_LD + d) = wv; \
            wv[0] = cvtpk(o2[0], o2[1]); wv[1] = cvtpk(o2[2], o2[3]); *(LAS ret_u2*)(KS + i * RT_LD + 32 + d) = wv; \
            o1 = o1 * kwi; o2 = o2 * kwi; \
            wv[0] = cvtpk(o1[0], o1[1]); wv[1] = cvtpk(o1[2], o1[3]); *(LAS ret_u2*)(K2 + i * RT_K2LD + d) = wv; \
            wv[0] = cvtpk(o2[0], o2[1]); wv[1] = cvtpk(o2[2], o2[3]); *(LAS ret_u2*)(K2 + i * RT_K2LD + 32 + d) = wv; \
            *(LAS v4u*)(VS + i * RT_VLD + e0) = A.va; *(LAS v4u*)(VS + i * RT_VLD + e0 + 8) = A.vb; \
            ret_load_a(P2, COS + n2 * 64 * 32, SIN + n2 * 64 * 32, h, dq, A); \
        } \
        LBAR(); \
        if (!warm) { \
        {     \
            const int ti = w >> 1, ii = 16 * ti + lr; \
            const bf16x8 b0 = *(const LAS bf16x8*)(QS + ii * RT_LD + 8 * lq), b1 = *(const LAS bf16x8*)(QS + ii * RT_LD + 32 + 8 * lq); \
            _Pragma("unroll") \
            for (int q = 0; q < 2; ++q) { const int tj = (w & 1) * 2 + q; \
                const bf16x8 a0 = *(const LAS bf16x8*)(KS + (16 * tj + lr) * RT_LD + 8 * lq), a1 = *(const LAS bf16x8*)(KS + (16 * tj + lr) * RT_LD + 32 + 8 * lq); \
                f32x4 acc = (f32x4){0.f, 0.f, 0.f, 0.f}; \
                acc = __builtin_amdgcn_mfma_f32_16x16x32_bf16(a0, b0, acc, 0, 0, 0); acc = __builtin_amdgcn_mfma_f32_16x16x32_bf16(a1, b1, acc, 0, 0, 0); \
                _Pragma("unroll") \
                for (int rg = 0; rg < 4; ++rg) { const int j = 16 * tj + 4 * lq + rg; const int dd = ii > j ? ii - j : j - ii; acc[rg] *= __builtin_amdgcn_exp2f(lg * (float)dd); } \
                ret_u2 wv; wv[0] = cvtpk(acc[0], acc[1]); wv[1] = cvtpk(acc[2], acc[3]); *(LAS ret_u2*)(SC + ii * RT_LD + 16 * tj + 4 * lq) = wv; } \
        } \
        LBAR(); \
        } \
        if (!warm) \
        {     \
            const int ti = w >> 1, ii = 16 * ti + lr; \
            const LAS bf16* scr = SC + ii * RT_LD; \
            const bf16x8 sb0 = ret_rowp(scr, 0, lq), sb1 = ret_rowp(scr, 32, lq); \
            const bf16x8 qb0 = *(const LAS bf16x8*)(QS + ii * RT_LD + 8 * lq), qb1 = *(const LAS bf16x8*)(QS + ii * RT_LD + 32 + 8 * lq); \
            const bf16x8 ka0 = ret_tr(K2, RT_K2LD, 0, 16 * ti, lr, lq), ka1 = ret_tr(K2, RT_K2LD, 32, 16 * ti, lr, lq); \
            const float gi = __builtin_amdgcn_exp2f(lg * (float)(ii + 1)); \
            _Pragma("unroll") \
            for (int hq = 0; hq < 2; ++hq) { \
                bf16x8 va0[2], va1[2], pa0[2], pa1[2]; \
                _Pragma("unroll") \
                for (int q = 0; q < 2; ++q) { const int te = (w & 1) * 4 + 2 * hq + q; \
                    va0[q] = ret_tr(VS, RT_VLD, 0, 16 * te, lr, lq); va1[q] = ret_tr(VS, RT_VLD, 32, 16 * te, lr, lq); \
                    pa0[q] = *(const LAS bf16x8*)(PT + (16 * te + lr) * RT_LD + 8 * lq); pa1[q] = *(const LAS bf16x8*)(PT + (16 * te + lr) * RT_LD + 32 + 8 * lq); } \
                __builtin_amdgcn_sched_barrier(0); \
                _Pragma("unroll") \
                for (int q = 0; q < 2; ++q) { const int te = (w & 1) * 4 + 2 * hq + q, qq = 2 * hq + q; \
                    f32x4 ai = (f32x4){0.f, 0.f, 0.f, 0.f}, ax = ai; \
                    ai = __builtin_amdgcn_mfma_f32_16x16x32_bf16(va0[q], sb0, ai, 0, 0, 0); ax = __builtin_amdgcn_mfma_f32_16x16x32_bf16(pa0[q], qb0, ax, 0, 0, 0); \
                    ai = __builtin_amdgcn_mfma_f32_16x16x32_bf16(va1[q], sb1, ai, 0, 0, 0); ax = __builtin_amdgcn_mfma_f32_16x16x32_bf16(pa1[q], qb1, ax, 0, 0, 0); \
                    accP[qq] = accP[qq] * g64; \
                    accP[qq] = __builtin_amdgcn_mfma_f32_16x16x32_bf16(ka0, va0[q], accP[qq], 0, 0, 0); accP[qq] = __builtin_amdgcn_mfma_f32_16x16x32_bf16(ka1, va1[q], accP[qq], 0, 0, 0); \
                    *(LAS f32x4*)(OB + ii * RT_OLD + 16 * te + 4 * lq) = ai + ax * gi; } \
                __builtin_amdgcn_sched_barrier(0); \
            } \
        } \
        else {     \
            const int ti = w >> 1; \
            const bf16x8 ka0 = ret_tr(K2, RT_K2LD, 0, 16 * ti, lr, lq), ka1 = ret_tr(K2, RT_K2LD, 32, 16 * ti, lr, lq); \
            _Pragma("unroll") \
            for (int q = 0; q < 4; ++q) { const int te = (w & 1) * 4 + q; \
                const bf16x8 va0 = ret_tr(VS, RT_VLD, 0, 16 * te, lr, lq), va1 = ret_tr(VS, RT_VLD, 32, 16 * te, lr, lq); \
                accP[q] = accP[q] * g64; \
                accP[q] = __builtin_amdgcn_mfma_f32_16x16x32_bf16(ka0, va0, accP[q], 0, 0, 0); accP[q] = __builtin_amdgcn_mfma_f32_16x16x32_bf16(ka1, va1, accP[q], 0, 0, 0); } \
        } \
        LBAR(); \
        {     \
            _Pragma("unroll") \
            for (int q = 0; q < 4; ++q) { const int te = (w & 1) * 4 + q, td = w >> 1; ret_u2 wv; wv[0] = cvtpk(accP[q][0], accP[q][1]); wv[1] = cvtpk(accP[q][2], accP[q][3]); \
                *(LAS ret_u2*)(PT + (16 * te + lr) * RT_LD + 16 * td + 4 * lq) = wv; } \
            RET_WAIT_G(G, 20);                                                        \
            if (warm) { dumpp[0] = (v4u){0u, 0u, 0u, 0u}; dumpp[1] = (v4u){0u, 0u, 0u, 0u}; } else { \
            f32x4 o[4]; float ss = 0.f; \
            _Pragma("unroll") \
            for (int j = 0; j < 4; ++j) { o[j] = *(const LAS f32x4*)(OB + i * RT_OLD + e0 + 4 * j); ss += (o[j][0] * o[j][0] + o[j][1] * o[j][1]) + (o[j][2] * o[j][2] + o[j][3] * o[j][3]); } \
            ss = sum8(ss); \
            const float rstd = __builtin_amdgcn_rsqf(ss * (1.0f / 128.0f) + 1e-6f); \
            v4u oa, ob; \
            _Pragma("unroll") \
            for (int j = 0; j < 4; ++j) { \
                const float g0 = bf_lo(G.ga[j]), g1 = bf_hi(G.ga[j]), g2 = bf_lo(G.gb[j]), g3 = bf_hi(G.gb[j]); \
                const float x0 = o[j >> 1][(2 * j) & 3], x1 = o[j >> 1][(2 * j + 1) & 3], x2 = o[2 + (j >> 1)][(2 * j) & 3], x3 = o[2 + (j >> 1)][(2 * j + 1) & 3]; \
                oa[j] = cvtpk(x0 * rstd * g0 * sigm(g0), x1 * rstd * g1 * sigm(g1)); ob[j] = cvtpk(x2 * rstd * g2 * sigm(g2), x3 * rstd * g3 * sigm(g3)); } \
            bf16* O = orow + (size_t)n * 64 * DM; \
            *(GAS v4u*)O = oa; *(GAS v4u*)(O + 8) = ob; } \
            ret_load_g(P2, h, dq, G); \
        } \
          \
    }
__device__ __forceinline__ void ret_unit(const Frame& F, int unit) {
    const int b = unit >> 3, h = (unit >> 1) & 3, half = unit & 1;
    LAS unsigned char* lds = F.lds + RING_OFF;
    LAS bf16* QS = (LAS bf16*)(lds + RT_QS); LAS bf16* KS = (LAS bf16*)(lds + RT_KS); LAS bf16* K2 = (LAS bf16*)(lds + RT_K2); LAS bf16* SC = (LAS bf16*)(lds + RT_SC);
    LAS bf16* VS = (LAS bf16*)(lds + RT_VS); LAS bf16* PT = (LAS bf16*)(lds + RT_PT); LAS float* OB = (LAS float*)(lds + RT_OB);
    const int tid = F.tid, w = F.wave;
    const float gamma = 1.0f - exp2f(-5.0f - (float)h), lg = log2f(gamma), g64 = exp2f(64.0f * lg);
    for (int i = tid; i < 128 * RT_LD / 2; i += NWAVES * 64) ((LAS unsigned*)PT)[i] = 0u;
    f32x4 accP[4];
#pragma unroll
    for (int q = 0; q < 4; ++q) accP[q] = (f32x4){0.f, 0.f, 0.f, 0.f};
    const float* COS = (const float*)(F.ws + WS_TRIG) + (tid >> 3) * 32; const float* SIN = COS + SEQ * 32;
    const bf16* prow = (const bf16*)(F.ws + WS_H) + ((size_t)b * SEQ + (tid >> 3)) * NPROJ + RET_OFF;
    bf16* orow = (bf16*)(F.ws + WS_MIXED) + ((size_t)b * SEQ + (tid >> 3)) * DM + 512 + h * 128 + (tid & 7) * 16;
    const float kwi = exp2f(lg * (float)(63 - (tid >> 3)));
    GAS v4u* dumpp = (GAS v4u*)(F.ws + WS_DUMP + 1 * MiB) + ((size_t)F.vcu * 512 + tid) * 2;
    const int nend = half ? SEQ / 64 : SEQ / 128;
    RetA A0, A1; RetG G0, G1;
    A0.q1 = (ret_u2){0u, 0u}; A0.q2 = A0.q1; A0.k1 = A0.q1; A0.k2 = A0.q1; A0.va = (v4u){0u, 0u, 0u, 0u}; A0.vb = A0.va; A0.cs = (f32x4){0.f, 0.f, 0.f, 0.f}; A0.sn = A0.cs; A1 = A0;
    G0.ga = (v4u){0u, 0u, 0u, 0u}; G0.gb = G0.ga; G1 = G0;
    {
        const int dq = tid & 7;
        ret_load_a(prow, COS, SIN, h, dq, A0); dumpp[0] = (v4u){0u, 0u, 0u, 0u}; dumpp[1] = (v4u){0u, 0u, 0u, 0u}; ret_load_g(prow, h, dq, G0);
        const bf16* p1 = prow + (size_t)64 * NPROJ;
        ret_load_a(p1, COS + 64 * 32, SIN + 64 * 32, h, dq, A1); dumpp[0] = (v4u){0u, 0u, 0u, 0u}; dumpp[1] = (v4u){0u, 0u, 0u, 0u}; ret_load_g(p1, h, dq, G1);
    }
    __syncthreads();
    for (int n0 = 0; n0 < nend; n0 += 2) {
        const bool warm = half && n0 < SEQ / 128;
        { const int n = n0;     RET_ITER(A0, G0) }
        { const int n = n0 + 1; RET_ITER(A1, G1) }
    }
    asm volatile("s_waitcnt vmcnt(0)" ::: "memory");
    __syncthreads();
}
#ifndef MK_PER_PHASE
#define MK_PER_PHASE 0
#endif
constexpr int PH_PER_LAYER = 10, PH_FINAL = 1 + DEPTH * PH_PER_LAYER, N_PHASES = PH_FINAL + 1;
__global__ void __launch_bounds__(NWAVES * 64, 2) mk_fwd(Args args) {
    extern __shared__ __attribute__((aligned(16))) unsigned char lds[];
    Frame F;
    F.lds = (LAS unsigned char*)lds;
    F.MISC = (volatile LAS unsigned*)(F.lds + MISC_OFF);
    F.tid = threadIdx.x; F.lane = F.tid & 63; F.wave = __builtin_amdgcn_readfirstlane(F.tid >> 6);
    F.G = gridDim.x; { const int bx = blockIdx.x; F.vcu = (F.G % 8 == 0) ? (bx % 8) * (F.G / 8) + bx / 8 : bx; }
    F.ws = args.ws; F.lora = (unsigned char*)args.out;
    gu32* ctl = (gu32*)(F.ws + WS_CTL);
    for (int u = F.tid; u < (LDS_BYTES - LDSCTL_OFF) / 4; u += NWAVES * 64) ((LAS unsigned*)(F.lds + LDSCTL_OFF))[u] = 0u;
    __syncthreads();
#if MK_PER_PHASE
    const int lo = args.ph_lo, hi = args.ph_hi;
#else
    constexpr int lo = 0, hi = N_PHASES;
#endif
    XcdBarrier bar; bar.bar = (unsigned*)(ctl + CW_BAR); bar.x = 0; bar.st = nullptr;
    if (hi - lo > 1) bar = xcd_barrier_post((unsigned*)(ctl + CW_BAR), F.MISC + 8);
    const bool GL = (F.G == 256) && (hi - lo > 1);
    const unsigned grp = (unsigned)(F.vcu >> 5) & 7u;
    if (GL && threadIdx.x == 0) (void)__hip_atomic_fetch_or((unsigned*)(ctl + CW_BAR) + GB_MASK(grp), 1u << bar.x, RLX_AGENT);
#define IN(k) (lo <= (k) && (k) < hi)
#define PHASE_ENTER() do { int t_ = threadIdx.x; asm volatile("" : "+v"(t_)); F.tid = t_; F.lane = t_ & 63; } while (0)
#define SEAM(k) do { if (IN(k) && IN((k) + 1)) { XcdBarrier b_ = bar; asm volatile("" : "+s"(b_.bar), "+s"(b_.x)); xcd_barrier(b_); } } while (0)
#define GSEAM(k) do { if (IN(k) && IN((k) + 1)) { if (GL) { unsigned* gb_ = (unsigned*)(ctl + CW_BAR); unsigned gg_ = grp; asm volatile("" : "+s"(gb_), "+s"(gg_)); grp_barrier(gb_, GB_SUB(gg_), GB_GEN(gg_), 32u, F.MISC[10] != 0u); } \
        else { XcdBarrier b_ = bar; asm volatile("" : "+s"(b_.bar), "+s"(b_.x)); xcd_barrier(b_); } } } while (0)
#define QSEAM(k) do { if (IN(k) && IN((k) + 1)) { if (GL) { unsigned* gb_ = (unsigned*)(ctl + CW_BAR); unsigned qq_ = grp * 8u + ((unsigned)F.vcu & 7u); asm volatile("" : "+s"(gb_), "+s"(qq_)); grp_barrier(gb_, QB_SUB(qq_), QB_GEN(qq_), 4u, F.MISC[10] != 0u); } \
        else { XcdBarrier b_ = bar; asm volatile("" : "+s"(b_.bar), "+s"(b_.x)); xcd_barrier(b_); } } } while (0)
#define QSTAGGER() do { if (GL) for (unsigned i_ = 0; i_ < ((unsigned)F.vcu & 7u); ++i_) __builtin_amdgcn_s_sleep(QSLEEP); } while (0)
#define CTR_WAIT(word, below, acq) do { if (threadIdx.x == 0) { unsigned* gb_ = (unsigned*)(ctl + CW_BAR); asm volatile("" : "+s"(gb_)); XB_SPIN(xb_ld(&gb_[word]) < (below), gb_); \
        if (acq) { __builtin_amdgcn_fence(__ATOMIC_ACQUIRE, "agent"); asm volatile("s_waitcnt vmcnt(0)" ::: "memory"); } } __syncthreads(); } while (0)
#define CTR_POST(word) do { if (threadIdx.x == 0) { unsigned* gb_ = (unsigned*)(ctl + CW_BAR); asm volatile("" : "+s"(gb_)); __builtin_amdgcn_fence(__ATOMIC_RELEASE, "agent"); asm volatile("s_waitcnt vmcnt(0)" ::: "memory"); \
        (void)xb_add(&gb_[word], 1u); } } while (0)
    bf16* XB = (bf16*)(F.ws + WS_XB); bf16* HB = (bf16*)(F.ws + WS_H); bf16* PROJ = (bf16*)(F.ws + WS_H); bf16* MIXED = (bf16*)(F.ws + WS_MIXED); bf16* ALORA = (bf16*)(F.ws + WS_MIXED);
    float* SSQ = (float*)(F.ws + WS_SSQ);
    bf16* HBg = HB;
    if (IN(0)) { PHASE_ENTER(); p0_prologue(F, args); SEAM(0); }
    if (GL) {
        if (threadIdx.x == 0) { const unsigned mk = xb_ld((unsigned*)(ctl + CW_BAR) + GB_MASK(grp)); F.MISC[10] = (mk & (mk - 1u)) != 0u ? 1u : 0u; }
        {   constexpr int LATE = DEPTH * ITEMS_LAYER - ITEMS_EARLY; const int g = (int)grp;
            const int it0 = ITEMS_EARLY + (int)(((long)LATE * (g * (g - 1) / 2)) / 28), it1 = ITEMS_EARLY + (int)(((long)LATE * (g * (g + 1) / 2)) / 28);
            PHASE_ENTER(); p0_weights(F, args, it0, it1, (F.vcu & 31) * NWAVES + F.wave, 32 * NWAVES);
            asm volatile("s_waitcnt vmcnt(0)" ::: "memory"); __syncthreads(); CTR_POST(GB_WDONE); }
        QSTAGGER();
    }
    for (int l = 0; l < DEPTH; ++l) {
        const int pb = 1 + PH_PER_LAYER * l;
        const unsigned char* wl = F.ws + WS_W + (size_t)l * SZ_LAYER;
        float* ssq_in = SSQ + (size_t)(l & 1) * M * 16; float* ssq_a = SSQ + (size_t)((l + 1) & 1) * M * 16; float* ssq_b = ssq_in; float* ssq_c = ssq_a;
        LayerP L; L.mu = args.in[7] + l * RWKV_IN; L.w0 = args.in[8] + l * 512; L.a0 = args.in[10] + l * 512; L.k_k = args.in[13] + l * 512; L.k_a = args.in[14] + l * 512;
        L.r_k = args.in[15] + l * 512; L.ln_w = args.in[16] + l * 512; L.ln_b = args.in[17] + l * 512; L.wlora = (const bf16*)(wl + OFF_WLORA);
        if (IN(pb + 0)) {
            pg8::Gemm g{XB, (const bf16*)(wl + OFF_WGU1), M, NGU, DM, 0u}; pg8::StaticOrder S; S.init(M, NGU, F.G, opaque_bx());
            pg8::EpiSwiglu E{HBg, DFF, ssq_in, (LAS float*)(F.lds + EPI_TAB_OFF)};
            pg8::gemm_phase<pg8::EpiSwiglu, pg8::StaticOrder, true, true>(F.lds + RING_OFF, g, S, E);
            QSEAM(pb + 0);
        }
        if (IN(pb + 1)) {
            if (GL && l == 0) CTR_WAIT(GB_WDONE, (unsigned)F.G, true);
            pg8::Gemm g{HBg, (const bf16*)(wl + OFF_WD1), M, DM, DFF, pg8::HPAD_EL * 2u}; pg8::StaticOrder S; S.init(M, DM, F.G, opaque_bx());
            pg8::EpiResid E{XB, ssq_a, 0.5f};
            pg8::gemm_phase<pg8::EpiResid, pg8::StaticOrder, true, true>(F.lds + RING_OFF, g, S, E);
            QSEAM(pb + 1);
        }
        if (IN(pb + 2)) {
            pg8::Gemm g{XB, (const bf16*)(wl + OFF_WIN), M, NPROJ, DM, 0u}; pg8::WinOrder S; S.init(M, NPROJ, F.G, opaque_bx());
            pg8::EpiProj<true> E{PROJ, NPROJ, ssq_a, (LAS float*)(F.lds + EPI_TAB_OFF), S.fused ? (bf16*)(F.ws + WS_SIDE) : nullptr};
            pg8::gemm_phase<pg8::EpiProj<true>, pg8::WinOrder, true, true>(F.lds + RING_OFF, g, S, E);
            if (S.fused && S.c >= 128) { PHASE_ENTER(); lora_prep_panel(F, L.mu, S.pm6());
            }
            GSEAM(pb + 2);
        }
        if (IN(pb + 3) && F.G != 256) { PHASE_ENTER(); lora_prep(F, L.mu); GSEAM(pb + 3); }
        if (IN(pb + 5)) {
            PHASE_ENTER();
            rwkv_m1_phase(F, L);
            GSEAM(pb + 5);
        }
        if (IN(pb + 6)) {
            PHASE_ENTER();
            for (int u = F.vcu; u < 256; u += F.G) { int uu = u;
                if (GL) { const int li = u & 31, g16 = (u >> 5) * 16; uu = li < 16 ? g16 + li : 128 + g16 + (li - 16); }
                if (uu < 128) rwkv_m2_unit(F, L, uu); else ret_unit(F, uu - 128); }
            GSEAM(pb + 6);
            QSTAGGER();
            if (GL && l == DEPTH - 1) CTR_POST(GB_MDONE);
        }
        if (IN(pb + 7)) {
            pg8::Gemm g{MIXED, (const bf16*)(wl + OFF_WOUT), M, DM, DM, 0u}; pg8::StaticOrder S; S.init(M, DM, F.G, opaque_bx());
            pg8::EpiResid E{XB, ssq_b, 1.0f};
            pg8::gemm_phase<pg8::EpiResid, pg8::StaticOrder, true, true>(F.lds + RING_OFF, g, S, E);
            QSEAM(pb + 7);
        }
        if (IN(pb + 8)) {
            pg8::Gemm g{XB, (const bf16*)(wl + OFF_WGU2), M, NGU, DM, 0u}; pg8::StaticOrder S; S.init(M, NGU, F.G, opaque_bx());
            pg8::EpiSwiglu E{HBg, DFF, ssq_b, (LAS float*)(F.lds + EPI_TAB_OFF)};
            pg8::gemm_phase<pg8::EpiSwiglu, pg8::StaticOrder, true, true>(F.lds + RING_OFF, g, S, E);
            QSEAM(pb + 8);
        }
        if (IN(pb + 9)) {
            pg8::Gemm g{HBg, (const bf16*)(wl + OFF_WD2), M, DM, DFF, pg8::HPAD_EL * 2u}; pg8::StaticOrder S; S.init(M, DM, F.G, opaque_bx());
            pg8::EpiResid E{XB, ssq_c, 0.5f};
            pg8::gemm_phase<pg8::EpiResid, pg8::StaticOrder, true, true>(F.lds + RING_OFF, g, S, E);
            QSEAM(pb + 9);
        }
    }
    if (IN(PH_FINAL)) {
        PHASE_ENTER();
        const float* ssq = SSQ + (size_t)(DEPTH & 1) * M * 16; const float* gain = args.in[23];
        const unsigned tmo = __hip_atomic_load(ctl + CW_BAR + XB_TMO, RLX_AGENT);
        const int gw = F.vcu * NWAVES + F.wave, NGW = F.G * NWAVES;
        if (GL) CTR_WAIT(GB_MDONE, (unsigned)F.G, false);
        f32x4 gv[4];
#pragma unroll
        for (int j = 0; j < 4; ++j) gv[j] = *((const f32x4*)gain + 2 * F.lane + (j & 1) + 128 * (j >> 1));
        for (int k = 0;; k += 4) {
            int mr[4]; bool ok[4];
#pragma unroll
            for (int r = 0; r < 4; ++r) { mr[r] = GL ? ((int)grp * 16 + (F.vcu & 7) + 8 * ((k + r) >> 3)) * 256 + (((F.vcu & 31) >> 3) * NWAVES + F.wave) + 32 * ((k + r) & 7) : gw + (k + r) * NGW;     ok[r] = GL ? (k + r < 16) : (mr[r] < M); if (!ok[r]) mr[r] = 0; }
            if (!ok[0]) break;
            f32x4 sq[4][4]; v4u xv[4][2];
#pragma unroll
            for (int r = 0; r < 4; ++r) { const f32x4* sp = (const f32x4*)(ssq + (size_t)mr[r] * pg8::SSQ_P);
#pragma unroll
                for (int j = 0; j < 4; ++j) sq[r][j] = sp[j];
                const GAS v4u* xr = (const GAS v4u*)(XB + (size_t)mr[r] * DM) + F.lane; xv[r][0] = xr[0]; xv[r][1] = xr[64]; }
#pragma unroll
            for (int r = 0; r < 4; ++r) { if (!ok[r]) continue;
                const f32x4 s4 = (sq[r][0] + sq[r][1]) + (sq[r][2] + sq[r][3]); const float tt = (s4[0] + s4[1]) + (s4[2] + s4[3]);
                const float rs = (1.0f / sqrtf(tt * (1.0f / 1024.0f) + pg8::RMS_EPS)) * (tmo ? __builtin_nanf("") : 1.0f);
                GAS f32x4* orow = (GAS f32x4*)(args.out + (size_t)mr[r] * DM) + 2 * F.lane;
#pragma unroll
                for (int j = 0; j < 2; ++j) { const v4u v = xv[r][j];
                    const f32x4 a = {bf_lo(v.x), bf_hi(v.x), bf_lo(v.y), bf_hi(v.y)}, c = {bf_lo(v.z), bf_hi(v.z), bf_lo(v.w), bf_hi(v.w)};
                    orow[128 * j] = a * rs * gv[2 * j]; orow[128 * j + 1] = c * rs * gv[2 * j + 1]; } }
        }
    }
#undef IN
#undef SEAM
}

extern "C" void kernel_launch(void* const* d_in, const int* in_sizes, int n_in, void* d_out, int out_size, void* d_ws, size_t ws_size, hipStream_t stream) {
    static int grid = 0;
    if (grid == 0) {
        if (n_in != 24 || in_sizes[0] != M * DM || out_size != M * DM || ws_size < WS_END) { fprintf(stderr, "kernel_launch: unexpected shapes (n_in %d, in0 %d, out %d, ws %zu); nothing launched\n", n_in, n_in > 0 ? in_sizes[0] : -1, out_size, ws_size); grid = -1; return; }
        int dev = 0, cus = 0, per_cu = 0;
        if (hipGetDevice(&dev) != hipSuccess || hipDeviceGetAttribute(&cus, hipDeviceAttributeMultiprocessorCount, dev) != hipSuccess) { grid = -1; return; }
        if (hipFuncSetAttribute((const void*)mk_fwd, hipFuncAttributeMaxDynamicSharedMemorySize, LDS_BYTES) != hipSuccess) { fprintf(stderr, "kernel_launch: hipFuncSetAttribute failed\n"); grid = -1; return; }
        if (hipOccupancyMaxActiveBlocksPerMultiprocessor(&per_cu, (const void*)mk_fwd, NWAVES * 64, LDS_BYTES) != hipSuccess || per_cu < 1)
            fprintf(stderr, "kernel_launch: note: occupancy query reports %d workgroups per CU\n", per_cu);
        (void)hipGetLastError();
        grid = cus;
    }
    if (grid < 0) return;
    if (hipMemsetAsync((char*)d_ws + WS_CTL, 0, CTL_ZERO_BYTES, stream) != hipSuccess) return;
    Args a{};
    for (int i = 0; i < 24; ++i) a.in[i] = (const float*)d_in[i];
    a.out = (float*)d_out; a.ws = (unsigned char*)d_ws;
#if MK_PER_PHASE
    for (int p = 0; p < N_PHASES; ++p) { a.ph_lo = p; a.ph_hi = p + 1; hipLaunchKernelGGL(mk_fwd, dim3(grid), dim3(NWAVES * 64), LDS_BYTES, stream, a); }
#else
    a.ph_lo = 0; a.ph_hi = N_PHASES;
    hipLaunchKernelGGL(mk_fwd, dim3(grid), dim3(NWAVES * 64), LDS_BYTES, stream, a);
#endif
}
```

```cpp
#include <hip/hip_runtime.h>
#include <cstdio>
#include <cstdint>
#include <cmath>
namespace pg8 {
#define PG8_LAS __attribute__((address_space(3)))
typedef unsigned short bf16_t;
typedef short bf16x8 __attribute__((ext_vector_type(8)));
typedef float f32x4 __attribute__((ext_vector_type(4)));
typedef unsigned u32x4 __attribute__((ext_vector_type(4)));
constexpr int BM = 256, BK = 64, HALF = 128, HTB = HALF * BK * 2  , STAGE_BYTES = 8 * HTB, NXCD = 8, WGM = 8;

__host__ __device__ __forceinline__ int lds_byte(int r, int c) { const int st = (r >> 4) * 2 + (c >> 5), rr = r & 15, cc = c & 31, ob = rr * 64 + cc * 2; return st * 1024 + (ob ^ (((ob >> 9) & 1) << 5)); }
__host__ __device__ __forceinline__ void stage_rc(int b, int& R, int& C) { const int st = b / 1024, sb = b % 1024, swz = sb ^ (((sb >> 9) & 1) << 5); R = (st >> 1) * 16 + swz / 64; C = (st & 1) * 32 + (swz % 64) / 2; }
__host__ __device__ __forceinline__ int perm32(int rho) { const int n = rho >> 4, i = rho & 15; return 8 * (i >> 2) + 4 * n + (i & 3); }

struct Unit { int pm, pn; };
struct Gemm { const bf16_t* A; const bf16_t* Bt; int M, N, K; unsigned apad; };

struct StaticOrder {
    int nM, nN, nwg, G, c;
    __host__ __device__ void init(int M, int N, int G_, int c_) { nM = M / BM; nN = N / BM; nwg = nM * nN; G = G_; c = c_; }
    __host__ __device__ bool next(int i, Unit& u) const {
        const long L = (long)i * G + c; if (L >= nwg) return false;
        int wgid = (int)L; { const int q = nwg / NXCD, r = nwg % NXCD, xcd = wgid % NXCD, off = wgid / NXCD; wgid = (xcd < r ? xcd * (q + 1) : r * (q + 1) + (xcd - r) * q) + off; }
        const int nig = WGM * nN, gid = wgid / nig, fm = gid * WGM, gsz = (nM - fm) < WGM ? (nM - fm) : WGM;
        u.pm = fm + ((wgid % nig) % gsz); u.pn = (wgid % nig) / gsz; return true;
    }
    __device__ __forceinline__ void a_ready(const Unit&) const {}
    __device__ __forceinline__ void done(const Unit&) const {}
};
struct WinOrder {
    StaticOrder base; int c; bool fused;
    __host__ __device__ void init(int M, int N, int G_, int c_) { fused = (G_ == 256); c = c_; base.init(M, fused ? N - BM : N, G_, c_); }
    __host__ __device__ int pm6() const { return 16 * (c & 7) + ((c - 128) >> 3); }
    __host__ __device__ bool next(int i, Unit& u) const {
        if (!fused) return base.next(i, u);
        bool ok;
        if (c >= 128) { if (i == 0) { u.pm = pm6(); u.pn = 6; return true; } if (i > 5) return false; ok = base.next(i - 1, u); }
        else { if (i < 6) ok = base.next(i, u); else if (i == 6) { StaticOrder b2 = base; b2.c = c + 128; ok = b2.next(5, u); } else return false; }
        if (ok && u.pn >= 6) u.pn += 1;
        return ok;
    }
    __device__ __forceinline__ void a_ready(const Unit&) const {}
    __device__ __forceinline__ void done(const Unit&) const {}
};


__device__ __forceinline__ unsigned cvt_pk_bf16(float lo, float hi) { unsigned r; asm volatile("v_cvt_pk_bf16_f32 %0, %1, %2" : "=v"(r) : "v"(lo), "v"(hi)); return r; }
typedef unsigned u32x2 __attribute__((ext_vector_type(2)));
constexpr int SSQ_P = 16;
constexpr float RMS_EPS = 1e-6f;
__device__ __forceinline__ float fast_rcp(float x) { return __builtin_amdgcn_rcpf(x); }
__device__ __forceinline__ float sigmoid_f(float x) { return fast_rcp(1.0f + __expf(-x)); }
__device__ __forceinline__ float silu_f(float x) { return x * sigmoid_f(x); }
__device__ __forceinline__ float row_rstd(const float* ssq, int row) {
    const f32x4* p = (const f32x4*)(ssq + (size_t)row * SSQ_P);
    const f32x4 a = p[0], b = p[1], c = p[2], d = p[3];
    const f32x4 s = (a + b) + (c + d);
    const float t = (s[0] + s[1]) + (s[2] + s[3]);
    return 1.0f / sqrtf(t * (1.0f / 1024.0f) + RMS_EPS);
}
constexpr unsigned HPAD_EL = 256u * (3328u - 2816u);
struct EpiSwiglu {
    static constexpr bool PERM = true, AFTER_DRAIN = false;
    bf16_t* H; int ldh; const float* ssq; PG8_LAS float* tab;
    __device__ __forceinline__ void begin(int wid, int lane) const { if (lane == 0) ((PG8_LAS int*)(tab + 8 * 128))[wid] = -1; }
    __device__ __forceinline__ void operator()(const f32x4 (&acc)[2][2][4][2], const Unit& u, int wr, int wc, int fr, int fq) const {
        const int row0 = u.pm * BM + wr * 64 + fr, col0 = u.pn * HALF + wc * 32 + 8 * fq;
        PG8_LAS float* const tb = tab + (wr * 4 + wc) * 128; PG8_LAS int* const tg = (PG8_LAS int*)(tab + 8 * 128) + (wr * 4 + wc);
        if (__builtin_amdgcn_readfirstlane(*tg) != u.pm) { const int ln = fq * 16 + fr, rb = u.pm * BM + wr * 64 + ln;
            const float t0 = row_rstd(ssq, rb), t1 = row_rstd(ssq, rb + HALF); tb[ln] = t0; tb[64 + ln] = t1; if (ln == 0) *tg = u.pm; }
#pragma unroll
        for (int ai = 0; ai < 2; ++ai)
#pragma unroll
            for (int m = 0; m < 4; ++m) { const int row = row0 + ai * HALF + m * 16; const float rs = tb[ai * 64 + m * 16 + fr];
                typedef float f32x2v __attribute__((ext_vector_type(2)));
                const float c1 = rs * -1.4426950408889634f, c2 = rs * rs;
                f32x2v tp[4], hp[4];
#pragma unroll
                for (int n = 0; n < 2; ++n)
#pragma unroll
                    for (int i2 = 0; i2 < 2; ++i2) { const f32x2v g2 = {acc[ai][0][m][n][2 * i2], acc[ai][0][m][n][2 * i2 + 1]}, u2 = {acc[ai][1][m][n][2 * i2], acc[ai][1][m][n][2 * i2 + 1]};
                        tp[n * 2 + i2] = g2 * c1; hp[n * 2 + i2] = (g2 * u2) * c2; }
#pragma unroll
                for (int k = 0; k < 4; ++k) { tp[k].x = __builtin_amdgcn_exp2f(tp[k].x); tp[k].y = __builtin_amdgcn_exp2f(tp[k].y); }
#pragma unroll
                for (int k = 0; k < 4; ++k) tp[k] = tp[k] + 1.0f;
#pragma unroll
                for (int k = 0; k < 4; ++k) { tp[k].x = __builtin_amdgcn_rcpf(tp[k].x); tp[k].y = __builtin_amdgcn_rcpf(tp[k].y); }
                float hv[8];
#pragma unroll
                for (int k = 0; k < 4; ++k) { const f32x2v r2 = hp[k] * tp[k]; hv[2 * k] = r2.x; hv[2 * k + 1] = r2.y; }
                u32x4 w; w.x = cvt_pk_bf16(hv[0], hv[1]); w.y = cvt_pk_bf16(hv[2], hv[3]); w.z = cvt_pk_bf16(hv[4], hv[5]); w.w = cvt_pk_bf16(hv[6], hv[7]);
                *(u32x4*)(H + (size_t)row * ldh + (size_t)u.pm * HPAD_EL + col0) = w; }
    }
};
__device__ __forceinline__ float sum_fq(float x) {
    float a = x, b = x;
    asm volatile("s_nop 1\n\tv_permlane16_swap_b32 %0, %1" : "+v"(a), "+v"(b));
    a = a + b; b = a;
    asm volatile("s_nop 1\n\tv_permlane32_swap_b32 %0, %1" : "+v"(a), "+v"(b));
    return a + b;
}
struct EpiResid {
    static constexpr bool PERM = true, AFTER_DRAIN = false;
    bf16_t* xb; float* ssq; float scale;
    __device__ __forceinline__ void begin(int, int) const {}
    __device__ __forceinline__ void operator()(const f32x4 (&acc)[2][2][4][2], const Unit& u, int wr, int wc, int fr, int fq) const {
        const int row0 = u.pm * BM + wr * 64 + fr, col0 = u.pn * BM + wc * 32 + 8 * fq;
        u32x4 xo[4][2][2];
#define EPR_LOAD(g) do { _Pragma("unroll") for (int mm = 0; mm < 2; ++mm) _Pragma("unroll") for (int bj = 0; bj < 2; ++bj) \
            xo[g][mm][bj] = *(const u32x4*)(xb + (size_t)(row0 + ((g) >> 1) * HALF + (2 * ((g) & 1) + mm) * 16) * 1024 + col0 + bj * HALF); } while (0)
        EPR_LOAD(0); EPR_LOAD(1);
#pragma unroll
        for (int g = 0; g < 4; ++g) { const int ai = g >> 1;
            if (g == 0) EPR_LOAD(2); else if (g == 1) EPR_LOAD(3);
#pragma unroll
            for (int mm = 0; mm < 2; ++mm) { const int m = 2 * (g & 1) + mm; const int row = row0 + ai * HALF + m * 16; float ss = 0.f;
#pragma unroll
                for (int bj = 0; bj < 2; ++bj) { const u32x4 o = xo[g][mm][bj];
                    const f32x4 x0 = {__builtin_bit_cast(float, o.x << 16), __builtin_bit_cast(float, o.x & 0xffff0000u), __builtin_bit_cast(float, o.y << 16), __builtin_bit_cast(float, o.y & 0xffff0000u)};
                    const f32x4 x1 = {__builtin_bit_cast(float, o.z << 16), __builtin_bit_cast(float, o.z & 0xffff0000u), __builtin_bit_cast(float, o.w << 16), __builtin_bit_cast(float, o.w & 0xffff0000u)};
                    const f32x4 v0 = x0 + acc[ai][bj][m][0] * scale, v1 = x1 + acc[ai][bj][m][1] * scale;
                    u32x4 w; w.x = cvt_pk_bf16(v0[0], v0[1]); w.y = cvt_pk_bf16(v0[2], v0[3]); w.z = cvt_pk_bf16(v1[0], v1[1]); w.w = cvt_pk_bf16(v1[2], v1[3]);
                    *(u32x4*)(xb + (size_t)row * 1024 + col0 + bj * HALF) = w;
                    const float r0 = __builtin_bit_cast(float, w.x << 16), r1 = __builtin_bit_cast(float, w.x & 0xffff0000u), r2 = __builtin_bit_cast(float, w.y << 16), r3 = __builtin_bit_cast(float, w.y & 0xffff0000u);
                    const float r4 = __builtin_bit_cast(float, w.z << 16), r5 = __builtin_bit_cast(float, w.z & 0xffff0000u), r6 = __builtin_bit_cast(float, w.w << 16), r7 = __builtin_bit_cast(float, w.w & 0xffff0000u);
                    ss += ((r0 * r0 + r1 * r1) + (r2 * r2 + r3 * r3)) + ((r4 * r4 + r5 * r5) + (r6 * r6 + r7 * r7)); }
                ss = sum_fq(ss);
                if (fq == 0) ssq[(size_t)row * SSQ_P + u.pn * 4 + wc] = ss; }
        }
#undef EPR_LOAD
    }
};
template <bool SCALE> struct EpiProj {
    static constexpr bool PERM = true, AFTER_DRAIN = false;
    __device__ __forceinline__ void begin(int wid, int lane) const { if (lane == 0) ((PG8_LAS int*)(tab + 8 * 128))[wid] = -1; }
    bf16_t* O; int ldc; const float* ssq; PG8_LAS float* tab; bf16_t* side;
    __device__ __forceinline__ void operator()(const f32x4 (&acc)[2][2][4][2], const Unit& u, int wr, int wc, int fr, int fq) const {
        const int row0 = u.pm * BM + wr * 64 + fr, col0 = u.pn * BM + wc * 32 + 8 * fq;
        PG8_LAS float* const tb = tab + (wr * 4 + wc) * 128; PG8_LAS int* const tg = (PG8_LAS int*)(tab + 8 * 128) + (wr * 4 + wc);
        if (SCALE) { if (__builtin_amdgcn_readfirstlane(*tg) != u.pm) { const int ln = fq * 16 + fr, rb = u.pm * BM + wr * 64 + ln; const float t0 = row_rstd(ssq, rb), t1 = row_rstd(ssq, rb + HALF); tb[ln] = t0; tb[64 + ln] = t1; if (ln == 0) *tg = u.pm; } }
#pragma unroll
        for (int ai = 0; ai < 2; ++ai)
#pragma unroll
            for (int m = 0; m < 4; ++m) { const int row = row0 + ai * HALF + m * 16; const float rs = SCALE ? tb[ai * 64 + m * 16 + fr] : 1.0f;
#pragma unroll
                for (int bj = 0; bj < 2; ++bj) { const f32x4 v0 = acc[ai][bj][m][0] * rs, v1 = acc[ai][bj][m][1] * rs;
                    u32x4 w; w.x = cvt_pk_bf16(v0[0], v0[1]); w.y = cvt_pk_bf16(v0[2], v0[3]); w.z = cvt_pk_bf16(v1[0], v1[1]); w.w = cvt_pk_bf16(v1[2], v1[3]);
                    *(u32x4*)(O + (size_t)row * ldc + col0 + bj * HALF) = w;
                    if (side != nullptr && u.pn < 6 && fr == 15) *(u32x4*)(side + (size_t)(row >> 4) * 1536 + col0 + bj * HALF) = w; } }
    }
};

template <class Epi, class Sched, bool ALIGN_EPI = false, bool SP2 = false>
__device__ __forceinline__ void gemm_phase(PG8_LAS unsigned char* lds, const Gemm g, const Sched& S, const Epi& E) {
    int tid_ = threadIdx.x; asm volatile("" : "+v"(tid_));
    const int tid = tid_, wid = __builtin_amdgcn_readfirstlane(tid >> 6), lane = tid & 63, wr = wid >> 2, wc = wid & 3, fr = lane & 15, fq = lane >> 4;
    const int K = g.K, nt = K / BK;
    unsigned voffA[2], voffB[2];
#pragma unroll
    for (int i = 0; i < 2; ++i) { int R, C; stage_rc(tid * 16 + i * 8192, R, C); const int Rb = Epi::PERM ? ((R & ~31) + perm32(R & 31)) : R;
        voffA[i] = (unsigned)(R * K + C) * 2u; voffB[i] = (unsigned)(Rb * K + C) * 2u; }
    const unsigned kstep = (unsigned)(BK * 2);
    const unsigned hstep = (unsigned)HALF * (unsigned)K * 2u;
    const unsigned tstep = 2u * hstep;
    const unsigned tstepA = tstep + g.apad;
    const __amdgpu_buffer_rsrc_t rsA = __builtin_amdgcn_make_buffer_rsrc((void*)g.A, (short)0, (int)((size_t)g.M * K * 2 + (size_t)(g.M / BM) * g.apad), 0x00020000);
    const __amdgpu_buffer_rsrc_t rsB = __builtin_amdgcn_make_buffer_rsrc((void*)g.Bt, (short)0, (int)((size_t)g.N * K * 2), 0x00020000);
    const unsigned ldsw = (unsigned)wid * 1024u;
    const int aoff = lds_byte(wr * 64 + fr, fq * 8), boff = lds_byte(wc * 32 + fr, fq * 8);
#define PG8_SA(b, h) (((b) * 2 + (h)) * HTB)
#define PG8_SB(b, h) ((4 + (b) * 2 + (h)) * HTB)
#define PG8_STAGE_X(rs, bufoff, goff, voff) do { _Pragma("unroll") for (int _i = 0; _i < 2; ++_i) \
        __builtin_amdgcn_raw_ptr_buffer_load_lds(rs, (PG8_LAS unsigned*)(lds + (bufoff) + ldsw + _i * 8192), 16, (int)(voff)[_i], (int)(goff), 0, 0); } while (0)
#define PG8_STAGE_A(bufoff, goff, voff) PG8_STAGE_X(rsA, bufoff, goff, voff)
#define PG8_STAGE_B(bufoff, goff, voff) PG8_STAGE_X(rsB, bufoff, goff, voff)
#define PG8_LDA(dst, b, h) do { _Pragma("unroll") for (int m = 0; m < 4; ++m) _Pragma("unroll") for (int k = 0; k < 2; ++k) dst[m][k] = *(const PG8_LAS bf16x8*)(lds + PG8_SA(b, h) + aoff + m * 2048 + k * 1024); } while (0)
#define PG8_LDB(dst, b, h) do { _Pragma("unroll") for (int n = 0; n < 2; ++n) _Pragma("unroll") for (int k = 0; k < 2; ++k) dst[n][k] = *(const PG8_LAS bf16x8*)(lds + PG8_SB(b, h) + boff + n * 2048 + k * 1024); } while (0)
#define PG8_MMA(ai, bj, At, Bt) do { __builtin_amdgcn_s_setprio(1); _Pragma("unroll") for (int m = 0; m < 4; ++m) _Pragma("unroll") for (int n = 0; n < 2; ++n) _Pragma("unroll") for (int k = 0; k < 2; ++k) \
        acc[ai][bj][m][n] = __builtin_amdgcn_mfma_f32_16x16x32_bf16(Bt[n][k], At[m][k], acc[ai][bj][m][n], 0, 0, 0); __builtin_amdgcn_s_setprio(0); } while (0)
#define PG8_WAIT_V(n) asm volatile("s_waitcnt vmcnt(" #n ")" ::: "memory")
#define PG8_WAIT_L(n) asm volatile("s_waitcnt lgkmcnt(" #n ")" ::: "memory")
#define PG8_BAR __builtin_amdgcn_s_barrier()
#define PG8_SCHED __builtin_amdgcn_sched_barrier(0)
    E.begin(wid, lane);
    Unit cur, nxt; int ui = 0;
    if (!S.next(0, cur)) return;
    f32x4 acc[2][2][4][2];
#pragma unroll
    for (int a = 0; a < 2; ++a)
#pragma unroll
        for (int b = 0; b < 2; ++b)
#pragma unroll
            for (int m = 0; m < 4; ++m)
#pragma unroll
                for (int n = 0; n < 2; ++n) acc[a][b][m][n] = (f32x4){0.f, 0.f, 0.f, 0.f};
    bf16x8 At[4][2], B0[2][2], B1[2][2];
    unsigned cA = (unsigned)cur.pm * tstepA, cB = (unsigned)cur.pn * tstep;
    S.a_ready(cur);
    if constexpr (SP2) {
        PG8_STAGE_B(PG8_SB(0, 0), cB, voffB); PG8_STAGE_B(PG8_SB(0, 1), cB + hstep, voffB); PG8_STAGE_A(PG8_SA(0, 0), cA, voffA); PG8_STAGE_A(PG8_SA(0, 1), cA + hstep, voffA);
        if (wr == 1) PG8_BAR;
        PG8_WAIT_V(2); PG8_BAR;
        PG8_STAGE_B(PG8_SB(1, 0), cB + kstep, voffB); PG8_STAGE_A(PG8_SA(1, 0), cA + kstep, voffA); PG8_STAGE_B(PG8_SB(1, 1), cB + hstep + kstep, voffB);
        PG8_WAIT_V(6); PG8_BAR;
    } else {
        PG8_STAGE_B(PG8_SB(0, 0), cB, voffB); PG8_STAGE_A(PG8_SA(0, 0), cA, voffA); PG8_STAGE_B(PG8_SB(0, 1), cB + hstep, voffB); PG8_STAGE_A(PG8_SA(0, 1), cA + hstep, voffA);
        if (wr == 1) PG8_BAR;
        PG8_WAIT_V(4); PG8_BAR;
        PG8_STAGE_B(PG8_SB(1, 0), cB + kstep, voffB); PG8_STAGE_A(PG8_SA(1, 0), cA + kstep, voffA); PG8_STAGE_B(PG8_SB(1, 1), cB + hstep + kstep, voffB);
        PG8_WAIT_V(6); PG8_BAR;
    }
    for (;;) {
        const bool has_next = S.next(ui + 1, nxt);
        const unsigned nA = has_next ? (unsigned)nxt.pm * tstepA : cA, nB = has_next ? (unsigned)nxt.pn * tstep : cB;
        for (int t = 0; t < nt; t += 2) {
            const bool last = (t == nt - 2);
            const unsigned a1 = cA + (unsigned)(t + 1) * kstep;
            const unsigned a2 = last ? nA : cA + (unsigned)(t + 2) * kstep, b2 = last ? nB : cB + (unsigned)(t + 2) * kstep;
            const unsigned a3 = a2 + kstep, b3 = b2 + kstep;
            if (last && has_next) S.a_ready(nxt);
            if constexpr (SP2) {
            PG8_LDB(B0, 0, 0); PG8_LDB(B1, 0, 1); PG8_SCHED; PG8_LDA(At, 0, 0); PG8_STAGE_A(PG8_SA(1, 1), a1 + hstep, voffA);
            PG8_WAIT_V(8); PG8_WAIT_L(0); PG8_BAR; PG8_MMA(0, 0, At, B0); PG8_MMA(0, 1, At, B1); PG8_BAR; PG8_SCHED;
            PG8_LDA(At, 0, 1); PG8_STAGE_B(PG8_SB(0, 0), b2, voffB); PG8_STAGE_B(PG8_SB(0, 1), b2 + hstep, voffB); PG8_STAGE_A(PG8_SA(0, 0), a2, voffA);
            PG8_WAIT_V(8); PG8_WAIT_L(0); PG8_BAR; PG8_MMA(1, 0, At, B0); PG8_MMA(1, 1, At, B1); PG8_BAR; PG8_SCHED;
            PG8_LDB(B0, 1, 0); PG8_LDB(B1, 1, 1); PG8_SCHED; PG8_LDA(At, 1, 0); PG8_STAGE_A(PG8_SA(0, 1), a2 + hstep, voffA);
            PG8_WAIT_V(8); PG8_WAIT_L(0); PG8_BAR; PG8_MMA(0, 0, At, B0); PG8_MMA(0, 1, At, B1); PG8_BAR; PG8_SCHED;
            PG8_LDA(At, 1, 1); PG8_STAGE_B(PG8_SB(1, 0), b3, voffB); PG8_STAGE_B(PG8_SB(1, 1), b3 + hstep, voffB); PG8_STAGE_A(PG8_SA(1, 0), a3, voffA);
            PG8_WAIT_V(8); PG8_WAIT_L(0); PG8_BAR; PG8_MMA(1, 0, At, B0); PG8_MMA(1, 1, At, B1); PG8_BAR; PG8_SCHED;
            } else {
            PG8_LDB(B0, 0, 0); PG8_SCHED; PG8_LDA(At, 0, 0); PG8_STAGE_A(PG8_SA(1, 1), a1 + hstep, voffA);
            PG8_WAIT_L(8); PG8_BAR; PG8_WAIT_L(0); PG8_MMA(0, 0, At, B0); PG8_BAR; PG8_SCHED;
            PG8_LDB(B1, 0, 1); PG8_STAGE_B(PG8_SB(0, 0), b2, voffB);
            PG8_BAR; PG8_WAIT_L(0); PG8_MMA(0, 1, At, B1); PG8_BAR;
            PG8_LDA(At, 0, 1); PG8_STAGE_A(PG8_SA(0, 0), a2, voffA);
            PG8_BAR; PG8_WAIT_L(0); PG8_MMA(1, 0, At, B0); PG8_BAR; PG8_SCHED;
            PG8_STAGE_B(PG8_SB(0, 1), b2 + hstep, voffB);
            PG8_WAIT_V(6); PG8_BAR; PG8_MMA(1, 1, At, B1); PG8_BAR;
            PG8_LDB(B0, 1, 0); PG8_SCHED; PG8_LDA(At, 1, 0); PG8_STAGE_A(PG8_SA(0, 1), a2 + hstep, voffA);
            PG8_WAIT_L(8); PG8_BAR; PG8_WAIT_L(0); PG8_MMA(0, 0, At, B0); PG8_BAR; PG8_SCHED;
            PG8_LDB(B1, 1, 1); PG8_STAGE_B(PG8_SB(1, 0), b3, voffB);
            PG8_BAR; PG8_WAIT_L(0); PG8_MMA(0, 1, At, B1); PG8_BAR;
            PG8_LDA(At, 1, 1); PG8_STAGE_A(PG8_SA(1, 0), a3, voffA);
            PG8_BAR; PG8_WAIT_L(0); PG8_MMA(1, 0, At, B0); PG8_BAR; PG8_SCHED;
            PG8_STAGE_B(PG8_SB(1, 1), b3 + hstep, voffB);
            PG8_WAIT_V(6); PG8_BAR; PG8_MMA(1, 1, At, B1); PG8_BAR;
            }
        }
        if constexpr (ALIGN_EPI) { if (wr == 0) PG8_BAR; }
        if constexpr (!Epi::AFTER_DRAIN) { E(acc, cur, wr, wc, fr, fq); S.done(cur); }
        if (!has_next) break;
#pragma unroll
        for (int a = 0; a < 2; ++a)
#pragma unroll
            for (int b = 0; b < 2; ++b)
#pragma unroll
                for (int m = 0; m < 4; ++m)
#pragma unroll
                    for (int n = 0; n < 2; ++n) acc[a][b][m][n] = (f32x4){0.f, 0.f, 0.f, 0.f};
        cur = nxt; cA = nA; cB = nB; ++ui;
        if constexpr (ALIGN_EPI) { if (wr == 1) PG8_BAR; }
    }
    PG8_WAIT_V(0);
    if constexpr (!ALIGN_EPI) { if (wr == 0) PG8_BAR; }
    PG8_BAR;
    if constexpr (Epi::AFTER_DRAIN) { E.fused(acc, cur, wr, wc, fr, fq, lds, wid, lane); S.done(cur); }
#undef PG8_SA
#undef PG8_SB
#undef PG8_STAGE_X
#undef PG8_STAGE_A
#undef PG8_STAGE_B
#undef PG8_LDA
#undef PG8_LDB
#undef PG8_MMA
#undef PG8_WAIT_V
#undef PG8_WAIT_L
#undef PG8_BAR
#undef PG8_SCHED
}
}
#define GAS __attribute__((address_space(1)))
#define LAS __attribute__((address_space(3)))
typedef unsigned short bf16;
typedef unsigned v4u __attribute__((ext_vector_type(4)));
typedef float f32x4 __attribute__((ext_vector_type(4)));
typedef short bf16x8 __attribute__((ext_vector_type(8)));
typedef GAS unsigned gu32;
typedef GAS unsigned long long gu64;
#define RLX_AGENT __ATOMIC_RELAXED, __HIP_MEMORY_SCOPE_AGENT
#define LDS_WAIT() asm volatile("s_waitcnt lgkmcnt(0)" ::: "memory")
#define VM_WAIT() asm volatile("s_waitcnt vmcnt(0)" ::: "memory")
__device__ __forceinline__ unsigned long long rt() { return __builtin_amdgcn_s_memrealtime(); }
__device__ __forceinline__ unsigned f2bf(float f) { unsigned u = __builtin_bit_cast(unsigned, f); return (u + 0x7fffu + ((u >> 16) & 1u)) >> 16; }
__device__ __forceinline__ unsigned pk2(float lo, float hi) { return f2bf(lo) | (f2bf(hi) << 16); }

#define XB_TMO      128
#define XB_XCNT(j)  (256  + 64 * (j))
#define XB_XSUB(j)  (1280 + 64 * (j))
#define XB_XGEN(j)  (2304 + 64 * (j))
#define XB_TOP      3328
#define XB_TOPGEN   3392
#define XCD_BAR_WORDS 3456
#define GB_SUB(j)   (3456 + 64 * (j))
#define GB_GEN(j)   (3968 + 64 * (j))
#define GB_MASK(j)  (4480 + 64 * (j))
#define GB_WDONE    4992
#define GB_MDONE    5056
#define QB_SUB(j)   (5120 + 64 * (j))
#define QB_GEN(j)   (9216 + 64 * (j))
#define XB_SPIN_CAP (1u << 18)
#ifndef QSLEEP
#define QSLEEP 16
#endif

__device__ __forceinline__ unsigned xb_ld(unsigned* p)              { return __hip_atomic_load(p, __ATOMIC_RELAXED, __HIP_MEMORY_SCOPE_AGENT); }
__device__ __forceinline__ unsigned xb_add(unsigned* p, unsigned v) { return __hip_atomic_fetch_add(p, v, __ATOMIC_RELAXED, __HIP_MEMORY_SCOPE_AGENT); }
__device__ __forceinline__ unsigned xb_xcc_id() { return (unsigned)__builtin_amdgcn_s_getreg((3 << 11) | 20) & 0xFu; }
#define XB_SPIN(cond, bar) do { unsigned _sp = 0; while (cond) { __builtin_amdgcn_s_sleep(1); \
    if ((++_sp & 255u) == 0u) { if (xb_ld(&(bar)[XB_TMO])) break; if (_sp > XB_SPIN_CAP) { atomicAdd(&(bar)[XB_TMO], 1u); break; } } } } while (0)

struct XcdBarrier {
    unsigned* bar; unsigned x;
    volatile LAS unsigned* st;
};

__device__ __forceinline__ XcdBarrier xcd_barrier_post(unsigned* bar, volatile LAS unsigned* st) {
    XcdBarrier b; b.bar = bar; b.x = xb_xcc_id(); b.st = st;
    if (threadIdx.x == 0) (void)xb_add(&bar[XB_XCNT(b.x)], 1u);
    return b;
}
__device__ __forceinline__ void xcd_barrier_complete(unsigned* bar, unsigned x, unsigned& nloc, unsigned& nx) {
    const unsigned G = gridDim.x * gridDim.y * gridDim.z;
    unsigned sum, cnt, mine, sp = 0u;
    for (;;) {
        sum = 0u; cnt = 0u; mine = 0u;
#pragma unroll
        for (unsigned j = 0; j < 16; ++j) { const unsigned c = xb_ld(&bar[XB_XCNT(j)]); sum += c; cnt += (c > 0u) ? 1u : 0u; mine = (j == x) ? c : mine; }
        if (sum == G) break;
        __builtin_amdgcn_s_sleep(1);
        if ((++sp & 255u) == 0u) { if (xb_ld(&bar[XB_TMO])) break; if (sp > XB_SPIN_CAP) { atomicAdd(&bar[XB_TMO], 1u); break; } }
    }
    nloc = mine > 0u ? mine : 1u; nx = cnt > 0u ? cnt : 1u;
}

__device__ __forceinline__ void xcd_barrier(const XcdBarrier& b) {
    asm volatile("s_waitcnt vmcnt(0)" ::: "memory");
    __syncthreads();
    if (threadIdx.x == 0) {
        unsigned* bar = b.bar;
        __builtin_amdgcn_s_waitcnt(0);
        unsigned nloc = b.st[0], nx = b.st[1];
        if (nloc == 0u) { xcd_barrier_complete(bar, b.x, nloc, nx); b.st[0] = nloc; b.st[1] = nx; }
        const unsigned old = xb_add(&bar[XB_XSUB(b.x)], 1u);
        const unsigned gen = old / nloc;
        if (old + 1u == (gen + 1u) * nloc) {
            __builtin_amdgcn_fence(__ATOMIC_RELEASE, "agent");
            asm volatile("s_waitcnt vmcnt(0)" ::: "memory");
            const unsigned og = xb_add(&bar[XB_TOP], 1u);
            const unsigned tg = og / nx;
            if (og + 1u == (tg + 1u) * nx) xb_add(&bar[XB_TOPGEN], 1u);
            else XB_SPIN(xb_ld(&bar[XB_TOPGEN]) == tg, bar);
            __builtin_amdgcn_fence(__ATOMIC_ACQUIRE, "agent");
            xb_add(&bar[XB_XGEN(b.x)], 1u);
            asm volatile("s_waitcnt vmcnt(0)" ::: "memory");
        } else {
            XB_SPIN(xb_ld(&bar[XB_XGEN(b.x)]) == gen, bar);
            __builtin_amdgcn_fence(__ATOMIC_ACQUIRE, "agent");
            asm volatile("s_waitcnt vmcnt(0)" ::: "memory");
        }
    }
    __syncthreads();
}

__device__ __forceinline__ void grp_barrier(unsigned* bar, unsigned subw, unsigned genw, unsigned nloc, bool wb) {
    asm volatile("s_waitcnt vmcnt(0)" ::: "memory");
    __syncthreads();
    if (threadIdx.x == 0) {
        __builtin_amdgcn_s_waitcnt(0);
        if (wb) { __builtin_amdgcn_fence(__ATOMIC_RELEASE, "agent"); asm volatile("s_waitcnt vmcnt(0)" ::: "memory"); }
        const unsigned old = xb_add(&bar[subw], 1u);
        if (!wb) asm volatile("buffer_inv sc1" ::: "memory");
        const unsigned gen = old / nloc;
        if (old + 1u == (gen + 1u) * nloc) xb_add(&bar[genw], 1u);
        else XB_SPIN(xb_ld(&bar[genw]) == gen, bar);
        if (wb) __builtin_amdgcn_fence(__ATOMIC_ACQUIRE, "agent");
        asm volatile("s_waitcnt vmcnt(0)" ::: "memory");
    }
    __syncthreads();
}

constexpr int NWAVES = 8;
constexpr int BATCH = 16, SEQ = 2048, DM = 1024, DEPTH = 2, DFF = 2816, NGU = 2 * DFF, NPROJ = 3328, RWKV_IN = 1792, NLORA = 1536, KLORA = 256;
constexpr int M = BATCH * SEQ;
constexpr int RET_OFF = RWKV_IN;
constexpr float LN_X_EPS = 64e-5f;
constexpr size_t MiB = 1u << 20;
constexpr size_t WS_CTL = 0, CTL_ZERO_BYTES = 1 * MiB;
constexpr size_t SZ_WGU = (size_t)NGU * DM * 2, SZ_WD = (size_t)DM * DFF * 2, SZ_WIN = (size_t)NPROJ * DM * 2, SZ_WLORA = (size_t)NLORA * KLORA * 2, SZ_WOUT = (size_t)DM * DM * 2;
constexpr size_t OFF_WGU1 = 0, OFF_WD1 = OFF_WGU1 + SZ_WGU, OFF_WIN = OFF_WD1 + SZ_WD, OFF_WLORA = OFF_WIN + SZ_WIN, OFF_WOUT = OFF_WLORA + SZ_WLORA, OFF_WGU2 = OFF_WOUT + SZ_WOUT, OFF_WD2 = OFF_WGU2 + SZ_WGU, SZ_LAYER = OFF_WD2 + SZ_WD;
constexpr size_t WS_W = 1 * MiB;
constexpr size_t WS_TRIG = WS_W + DEPTH * SZ_LAYER;
constexpr size_t WS_SSQ = 86 * MiB;
constexpr size_t WS_XB = 90 * MiB;
constexpr size_t WS_SIDE = 186 * MiB;
constexpr size_t WS_DUMP = 192 * MiB;
constexpr size_t WS_ALORA = 154 * MiB;
constexpr size_t WS_MIXED = 218 * MiB;
constexpr size_t WS_H = 282 * MiB;
constexpr size_t WS_END = 490 * MiB;
static_assert(WS_TRIG + 2 * 2048 * 32 * 4 <= WS_SSQ && WS_SSQ + 2 * (size_t)M * 16 * 4 <= WS_XB && WS_XB + (size_t)M * DM * 2 <= WS_SIDE && (size_t)M * NLORA * 2 <= (size_t)M * DM * 4 && WS_H + (size_t)M * NPROJ * 2 <= WS_END, "d_ws map");
constexpr int CW_TMO = 0, CW_CODE = 1, CW_BAR = 4096;

constexpr int RING_OFF = 0, RING_BYTES = 131072;
constexpr int LDSCTL_OFF = 161792, MISC_OFF = LDSCTL_OFF + 320;
constexpr int EPI_TAB_OFF = 131072;
constexpr int LDS_BYTES = 163840;

__device__ __forceinline__ int opaque_bx() { int b = (int)blockIdx.x; asm volatile("" : "+s"(b)); return b; }
struct Frame {
    LAS unsigned char* lds;
    volatile LAS unsigned* MISC;
    int tid, lane, wave;
    int vcu, G;
    unsigned char* ws;
    unsigned char* lora;
};
struct LayerP {
    const float *mu, *w0, *a0, *k_k, *k_a, *r_k, *ln_w, *ln_b;
    const unsigned short* wlora;
};
__device__ __forceinline__ float bf_lo(unsigned u) { return __builtin_bit_cast(float, u << 16); }
__device__ __forceinline__ float bf_hi(unsigned u) { return __builtin_bit_cast(float, u & 0xffff0000u); }
typedef float f32x2_t __attribute__((ext_vector_type(2))); typedef __bf16 bf16x2_t __attribute__((ext_vector_type(2)));
__device__ __forceinline__ unsigned cvtpk(float lo, float hi) { f32x2_t v = {lo, hi}; bf16x2_t b = __builtin_convertvector(v, bf16x2_t); return __builtin_bit_cast(unsigned, b); }
__device__ __forceinline__ float wave_sum(float v) {
#pragma unroll
    for (int o = 1; o < 64; o <<= 1) v += __shfl_xor(v, o);
    return v;
}
template <int CTRL> __device__ __forceinline__ float dpp_f(float v) { return __builtin_bit_cast(float, __builtin_amdgcn_update_dpp(0, __builtin_bit_cast(int, v), CTRL, 0xF, 0xF, true)); }
__device__ __forceinline__ float sum8(float v) { v += dpp_f<0xB1>(v); v += dpp_f<0x4E>(v); v += dpp_f<0x141>(v); return v; }
__device__ __forceinline__ float sum16(float v) { v = sum8(v); v += dpp_f<0x140>(v); return v; }
__device__ __forceinline__ float sigm(float x) { return __builtin_amdgcn_rcpf(1.0f + __expf(-x)); }

constexpr int P0_SCR_BYTES = 64 * 65 * 4;
__device__ __forceinline__ void p0_transpose_item(const float* W, int K, int N, const float* gain, bf16* WT, int k0, int n0, int dst_row0, LAS float* scr, int lane) {
    const int n4 = (lane & 15) * 4, kr = lane >> 4;
#pragma unroll 8
    for (int i = 0; i < 16; ++i) { const int kk = 4 * i + kr; const float g = gain ? gain[k0 + kk] : 1.0f;
        const f32x4 v = *(const GAS f32x4*)(W + (size_t)(k0 + kk) * N + n0 + n4);
        LAS float* s = scr + kk * 65 + n4; s[0] = v.x * g; s[1] = v.y * g; s[2] = v.z * g; s[3] = v.w * g; }
    LDS_WAIT(); asm volatile("" ::: "memory");
    const int c = lane & 7;
#pragma unroll
    for (int j = 0; j < 8; ++j) { const int n = (lane >> 3) + 8 * j; const LAS float* s = scr + (8 * c) * 65 + n;
        v4u o; o.x = pk2(s[0 * 65], s[1 * 65]); o.y = pk2(s[2 * 65], s[3 * 65]); o.z = pk2(s[4 * 65], s[5 * 65]); o.w = pk2(s[6 * 65], s[7 * 65]);
        *(GAS v4u*)(WT + (size_t)(dst_row0 + n) * K + k0 + 8 * c) = o; }
    LDS_WAIT(); asm volatile("" ::: "memory");
}
struct Args { const float* in[24]; float* out; unsigned char* ws; int ph_lo, ph_hi; };
constexpr int ITEMS_FF = (DM / 64) * (DFF / 64), ITEMS_IN = (DM / 64) * (NPROJ / 64), ITEMS_OUT = (DM / 64) * (DM / 64);
constexpr int ITEMS_LAYER = 6 * ITEMS_FF + ITEMS_IN + ITEMS_OUT;
constexpr int ITEMS_EARLY = 2 * ITEMS_FF;
__device__ __forceinline__ void p0_weights(const Frame& F, const Args& A, int it_lo, int it_hi, int gw, int NGW) {
    LAS float* scr = (LAS float*)(F.lds + RING_OFF + F.wave * P0_SCR_BYTES);
    for (int it = it_lo + gw; it < it_hi; it += NGW) {
        const int l = it / ITEMS_LAYER; int r = it % ITEMS_LAYER;
        bf16* wl = (bf16*)(F.ws + WS_W + (size_t)l * SZ_LAYER);
        const float* W; const float* gain = nullptr; bf16* WT; int K, N, mode = 0;
        if (r < ITEMS_FF)            { W = A.in[2] + (size_t)l * DM * DFF; gain = A.in[1] + l * DM; WT = (bf16*)((unsigned char*)wl + OFF_WGU1); K = DM; N = DFF; mode = 1; }
        else if ((r -= ITEMS_FF) < ITEMS_FF)  { W = A.in[3] + (size_t)l * DM * DFF; gain = A.in[1] + l * DM; WT = (bf16*)((unsigned char*)wl + OFF_WGU1); K = DM; N = DFF; mode = 2; }
        else if ((r -= ITEMS_FF) < ITEMS_FF)  { W = A.in[4] + (size_t)l * DFF * DM; WT = (bf16*)((unsigned char*)wl + OFF_WD1); K = DFF; N = DM; }
        else if ((r -= ITEMS_FF) < ITEMS_IN)  { W = A.in[6] + (size_t)l * DM * NPROJ; gain = A.in[5] + l * DM; WT = (bf16*)((unsigned char*)wl + OFF_WIN); K = DM; N = NPROJ; }
        else if ((r -= ITEMS_IN) < ITEMS_OUT) { W = A.in[18] + (size_t)l * DM * DM; WT = (bf16*)((unsigned char*)wl + OFF_WOUT); K = DM; N = DM; }
        else if ((r -= ITEMS_OUT) < ITEMS_FF) { W = A.in[20] + (size_t)l * DM * DFF; gain = A.in[19] + l * DM; WT = (bf16*)((unsigned char*)wl + OFF_WGU2); K = DM; N = DFF; mode = 1; }
        else if ((r -= ITEMS_FF) < ITEMS_FF)  { W = A.in[21] + (size_t)l * DM * DFF; gain = A.in[19] + l * DM; WT = (bf16*)((unsigned char*)wl + OFF_WGU2); K = DM; N = DFF; mode = 2; }
        else { r -= ITEMS_FF;                   W = A.in[22] + (size_t)l * DFF * DM; WT = (bf16*)((unsigned char*)wl + OFF_WD2); K = DFF; N = DM; }
        const int nblk = N / 64, kb = r / nblk, nb = r % nblk, k0 = 64 * kb, n0 = 64 * nb;
        const int dst = mode == 0 ? n0 : ((n0 >> 7) * 256 + (n0 & 127) + (mode == 2 ? 128 : 0));
        p0_transpose_item(W, K, N, gain, WT, k0, n0, dst, scr, F.lane);
    }
}
__device__ __forceinline__ void p0_prologue(const Frame& F, const Args& A) {
    const int gw = F.vcu * NWAVES + F.wave, NGW = F.G * NWAVES;
    p0_weights(F, A, 0, F.G == 256 ? ITEMS_EARLY : DEPTH * ITEMS_LAYER, gw, NGW);
    const int gt = gw * 64 + F.lane, NGT = NGW * 64;
    for (int it = gt; it < DEPTH * NLORA * (KLORA / 8); it += NGT) {
        const int l = it / (NLORA * (KLORA / 8)), r = it % (NLORA * (KLORA / 8)), n = r >> 5, k8 = (r & 31) * 8;
        const int blk = n >> 9, nn = n & 511;
        const int klo = blk == 0 ? 0 : (blk == 1 ? 64 : 128), khi = blk == 0 ? 64 : (blk == 1 ? 128 : 256);
        const float* src = blk == 0 ? A.in[9] + (size_t)l * 64 * 512 : (blk == 1 ? A.in[11] + (size_t)l * 64 * 512 : A.in[12] + (size_t)l * 128 * 512);
        float v[8];
#pragma unroll
        for (int j = 0; j < 8; ++j) { const int k = k8 + j; v[j] = (k >= klo && k < khi) ? src[(size_t)(k - klo) * 512 + nn] : 0.0f; }
        v4u o; o.x = pk2(v[0], v[1]); o.y = pk2(v[2], v[3]); o.z = pk2(v[4], v[5]); o.w = pk2(v[6], v[7]);
        *(GAS v4u*)((bf16*)(F.ws + WS_W + (size_t)l * SZ_LAYER + OFF_WLORA) + (size_t)n * KLORA + k8) = o;
    }
    for (int it = gt; it < SEQ * 32; it += NGT) {
        const int pos = it >> 5, i = it & 31;
        const float x = (float)i * (1.0f / 31.0f);
        const float inv_freq = 1.0f / powf(10000.0f, x);
        const float ang = (float)pos * inv_freq;
        float sn, cs; sincosf(ang, &sn, &cs);
        ((float*)(F.ws + WS_TRIG))[it] = cs; ((float*)(F.ws + WS_TRIG))[SEQ * 32 + it] = sn;
    }
    const float* x = A.in[0]; bf16* xb = (bf16*)(F.ws + WS_XB); float* ssq = (float*)(F.ws + WS_SSQ);
    for (int m = gw; m < M; m += 4 * NGW) {
        f32x4 v[4][4]; int mr[4]; bool has[4];
#pragma unroll
        for (int r = 0; r < 4; ++r) { mr[r] = m + r * NGW; has[r] = mr[r] < M; if (!has[r]) mr[r] = m;
            const GAS f32x4* xr = (const GAS f32x4*)(x + (size_t)mr[r] * DM) + F.lane;
#pragma unroll
            for (int j = 0; j < 4; ++j) v[r][j] = xr[64 * j]; }
#pragma unroll
        for (int r = 0; r < 4; ++r) {
            GAS unsigned long long* o8 = (GAS unsigned long long*)(xb + (size_t)mr[r] * DM) + F.lane;
            float sq = 0.f;
#pragma unroll
            for (int j = 0; j < 4; ++j) { sq += (v[r][j].x * v[r][j].x + v[r][j].y * v[r][j].y) + (v[r][j].z * v[r][j].z + v[r][j].w * v[r][j].w);
                if (has[r]) o8[64 * j] = (unsigned long long)pk2(v[r][j].x, v[r][j].y) | ((unsigned long long)pk2(v[r][j].z, v[r][j].w) << 32); }
            sq = wave_sum(sq);
            if (has[r] && F.lane < 16) ssq[(size_t)mr[r] * 16 + F.lane] = (F.lane == 0) ? sq : 0.0f;
        }
    }
}
__device__ __forceinline__ void lora_prep(const Frame& F, const float* mu) {
    const bf16* proj = (const bf16*)(F.ws + WS_H); bf16* alora = (bf16*)(F.ws + WS_ALORA);
    const int gt = (F.vcu * NWAVES + F.wave) * 64 + F.lane, NGT = F.G * NWAVES * 64;
    for (int it = gt; it < M * 32; it += NGT) {
        const int m = it >> 5, c8 = (it & 31) * 8;
        const v4u pc = *(const GAS v4u*)(proj + (size_t)m * NPROJ + 1536 + c8);
        v4u pp = (v4u){0u, 0u, 0u, 0u};
        if ((m & (SEQ - 1)) != 0) pp = *(const GAS v4u*)(proj + (size_t)(m - 1) * NPROJ + 1536 + c8);
        const f32x4 m0 = *(const f32x4*)(mu + 1536 + c8), m1 = *(const f32x4*)(mu + 1536 + c8 + 4);
        float v[8];
#pragma unroll
        for (int j = 0; j < 4; ++j) { const unsigned a = pc[j], b = pp[j]; const float ml = j < 2 ? m0[2 * j] : m1[2 * j - 4], mh = j < 2 ? m0[2 * j + 1] : m1[2 * j - 3];
            const float cl = bf_lo(a), ch = bf_hi(a), pl = bf_lo(b), ph = bf_hi(b);
            v[2 * j] = cl + ml * (pl - cl); v[2 * j + 1] = ch + mh * (ph - ch); }
        if (c8 < 64) {
#pragma unroll
            for (int j = 0; j < 8; ++j) v[j] = 1.0f - 2.0f * __builtin_amdgcn_rcpf(1.0f + __expf(2.0f * v[j]));
        } else if (c8 >= 128) {
#pragma unroll
            for (int j = 0; j < 8; ++j) v[j] = sigm(v[j]);
        }
        v4u o; o.x = cvtpk(v[0], v[1]); o.y = cvtpk(v[2], v[3]); o.z = cvtpk(v[4], v[5]); o.w = cvtpk(v[6], v[7]);
        *(GAS v4u*)(alora + (size_t)m * KLORA + c8) = o;
    }
    bf16* side = (bf16*)(F.ws + WS_SIDE);
    for (int it = gt; it < (M / 16) * 192; it += NGT) {
        const int cidx = it / 192, c8 = (it % 192) * 8;
        *(GAS v4u*)(side + (size_t)cidx * 1536 + c8) = *(const GAS v4u*)(proj + ((size_t)cidx * 16 + 15) * NPROJ + c8);
    }
}
__device__ __forceinline__ void lora_prep_piece(const Frame& F, const float* mu, int m, int c8) {
    const bf16* proj = (const bf16*)(F.ws + WS_H); bf16* alora = (bf16*)(F.ws + WS_ALORA);
    const v4u pc = *(const GAS v4u*)(proj + (size_t)m * NPROJ + 1536 + c8);
    v4u pp = (v4u){0u, 0u, 0u, 0u};
    if ((m & (SEQ - 1)) != 0) pp = *(const GAS v4u*)(proj + (size_t)(m - 1) * NPROJ + 1536 + c8);
    const f32x4 m0 = *(const f32x4*)(mu + 1536 + c8), m1 = *(const f32x4*)(mu + 1536 + c8 + 4);
    float v[8];
#pragma unroll
    for (int j = 0; j < 4; ++j) { const unsigned a = pc[j], b = pp[j]; const float ml = j < 2 ? m0[2 * j] : m1[2 * j - 4], mh = j < 2 ? m0[2 * j + 1] : m1[2 * j - 3];
        const float cl = bf_lo(a), ch = bf_hi(a), pl = bf_lo(b), ph = bf_hi(b);
        v[2 * j] = cl + ml * (pl - cl); v[2 * j + 1] = ch + mh * (ph - ch); }
    if (c8 < 64) {
#pragma unroll
        for (int j = 0; j < 8; ++j) v[j] = 1.0f - 2.0f * __builtin_amdgcn_rcpf(1.0f + __expf(2.0f * v[j]));
    } else if (c8 >= 128) {
#pragma unroll
        for (int j = 0; j < 8; ++j) v[j] = sigm(v[j]);
    }
    v4u o; o.x = cvtpk(v[0], v[1]); o.y = cvtpk(v[2], v[3]); o.z = cvtpk(v[4], v[5]); o.w = cvtpk(v[6], v[7]);
    *(GAS v4u*)(alora + (size_t)m * KLORA + c8) = o;
}
__device__ __forceinline__ void lora_prep_panel(const Frame& F, const float* mu, int pm) {
    for (int it = F.tid; it < 256 * 32; it += NWAVES * 64) { const int r = it >> 5, m = pm * 256 + r;
        if (r == 0 && (m & (SEQ - 1)) != 0) continue;
        lora_prep_piece(F, mu, m, (it & 31) * 8); }
}
__device__ __forceinline__ void lora_prep_edges(const Frame& F, const float* mu, int n0) {
    if ((n0 & 15) == 0 && n0 != 0) { const int b = F.tid >> 5, m = b * SEQ + n0 * 16; lora_prep_piece(F, mu, m, (F.tid & 31) * 8); }
    asm volatile("s_waitcnt vmcnt(0)" ::: "memory");
    __syncthreads();
}
__device__ __forceinline__ void lora_prep_edges_grp(const Frame& F, const float* mu, int g, int q) {
    if (F.tid < 128) { const int e = F.tid >> 5, b = 2 * g + (e & 1), n = 32 * q + 16 * (e >> 1);
        if (n != 0) lora_prep_piece(F, mu, b * SEQ + n * 16, (F.tid & 31) * 8); }
    asm volatile("s_waitcnt vmcnt(0)" ::: "memory");
    __syncthreads();
}
constexpr int M1_PW = 14592;
constexpr int M1_EL = 0;
constexpr int M1_AT = 0, M1_BT = 2304, M1_KT = 4608, M1_RT = 6912;
constexpr int M1_TMP = 0, M1_SM = 2304, M1_AHT = 2304 + 8 * 1024;
constexpr int M1W_LD = 72, M1G_LD = 136;
constexpr int M1W_W = NWAVES * M1_PW, M1W_A = M1W_W + 64 * M1W_LD * 2, M1W_G = M1W_A + 64 * M1W_LD * 2, M1W_END = M1W_G + 64 * M1G_LD * 2;
constexpr int M1W_PRM = M1W_END;
static_assert(M1_AHT + 4096 == M1_PW && M1W_PRM + 8 * 64 * 4 <= LDSCTL_OFF && (M1W_W % 16) == 0 && (M1W_PRM % 16) == 0, "M1 LDS");
__device__ __forceinline__ float bfu(unsigned short x) { return __builtin_bit_cast(float, (unsigned)x << 16); }
__device__ __forceinline__ unsigned short bf1(float x) { return (unsigned short)(cvtpk(x, x) & 0xffffu); }
typedef unsigned u32x2_t __attribute__((ext_vector_type(2)));
__device__ __forceinline__ f32x4 bf4(u32x2_t u) { return (f32x4){bf_lo(u[0]), bf_hi(u[0]), bf_lo(u[1]), bf_hi(u[1])}; }
#define LBAR() do { asm volatile("s_waitcnt lgkmcnt(0)" ::: "memory"); __builtin_amdgcn_s_barrier(); asm volatile("" ::: "memory"); } while (0)
#define M1_WAIT() asm volatile("s_waitcnt lgkmcnt(0)" ::: "memory")
__device__ __forceinline__ bf16* slot_mix(const Frame& F, size_t m, int h) { return (bf16*)(F.ws + WS_MIXED) + m * DM + h * 64; }
__device__ __forceinline__ bf16* slot_lw(const Frame& F, size_t m, int h) { return (bf16*)(F.lora) + m * NLORA + h * 64; }
__device__ __forceinline__ bf16* slot_la(const Frame& F, size_t m, int h) { return (bf16*)(F.lora) + m * NLORA + 512 + h * 64; }
__device__ __forceinline__ bf16* slot_pr(const Frame& F, size_t m, int h) { return (bf16*)(F.ws + WS_H) + m * NPROJ + h * 64; }
__device__ __forceinline__ bf16* slot_pk(const Frame& F, size_t m, int h) { return (bf16*)(F.ws + WS_H) + m * NPROJ + 512 + h * 64; }
__device__ __forceinline__ bf16* slot_pv(const Frame& F, size_t m, int h) { return (bf16*)(F.ws + WS_H) + m * NPROJ + 1024 + h * 64; }
typedef short bf16x4 __attribute__((ext_vector_type(4)));
#define M2_K16(p) (*(const LAS bf16x4*)(p))
#define M2_MFMA16(a, b, c) __builtin_amdgcn_mfma_f32_16x16x16bf16_1k(a, b, c, 0, 0, 0)
#define M2_TR16(p) __builtin_amdgcn_ds_read_tr16_b64_v4i16((LAS bf16x4*)(p))
__device__ __forceinline__ bf16x4 m2_acc_op(const f32x4& d) { u32x2_t w_; w_[0] = cvtpk(d[0], d[1]); w_[1] = cvtpk(d[2], d[3]); return __builtin_bit_cast(bf16x4, w_); }
struct M1Alf { bf16x8 f[8]; };
__device__ __forceinline__ void m1_alf_issue(const Frame& F, int u, int lane, M1Alf& A) {
    const int n = u & 127, b = u >> 10; const size_t mb = (size_t)b * SEQ + n * 16;
    const bf16* AL = (const bf16*)(F.ws + WS_ALORA) + (mb + (lane & 15)) * KLORA + 8 * (lane >> 4);
#pragma unroll
    for (int ks = 0; ks < 8; ++ks) asm volatile("global_load_dwordx4 %0, %1, off" : "+v"(A.f[ks]) : "v"(AL + 32 * ks) : "memory");
}
#define M1_ALF_WAIT(A) asm volatile("s_waitcnt vmcnt(0)" : "+v"((A).f[0]), "+v"((A).f[1]), "+v"((A).f[2]), "+v"((A).f[3]), "+v"((A).f[4]), "+v"((A).f[5]), "+v"((A).f[6]), "+v"((A).f[7]) :: "memory")
__device__ __forceinline__ void rwkv_m1_unit(const Frame& F, const LayerP& L, int u, int u_next, M1Alf& ALF, LAS unsigned char* wl) {
    const int n = u & 127, h = (u >> 7) & 7, b = u >> 10;
    int ln_ = F.lane; asm volatile("" : "+v"(ln_));
    const int lane = ln_, lr = lane & 15, lq = lane >> 4, te = lane >> 2, c0 = (lane & 3) * 16, ch = h * 64 + c0;
    const size_t mb = (size_t)b * SEQ + n * 16, m = mb + te;
    const bf16* P = (const bf16*)(F.ws + WS_H) + m * NPROJ;
    const bool hasp = (te > 0) || (n > 0);
    const bf16* Pp = (te > 0) ? (P - NPROJ) : ((const bf16*)(F.ws + WS_SIDE) + ((size_t)b * 128 + (n > 0 ? n - 1 : 0)) * 1536);
    v4u rc[2], kc[2], vc[2], rp[2], kp[2], vp[2], lw[2], la[2];
#pragma unroll
    for (int hh = 0; hh < 2; ++hh) { rc[hh] = *(const GAS v4u*)(P + ch + 8 * hh); kc[hh] = *(const GAS v4u*)(P + 512 + ch + 8 * hh); vc[hh] = *(const GAS v4u*)(P + 1024 + ch + 8 * hh);
        rp[hh] = (v4u){0u, 0u, 0u, 0u}; kp[hh] = rp[hh]; vp[hh] = rp[hh];
        if (hasp) { rp[hh] = *(const GAS v4u*)(Pp + ch + 8 * hh); kp[hh] = *(const GAS v4u*)(Pp + 512 + ch + 8 * hh); vp[hh] = *(const GAS v4u*)(Pp + 1024 + ch + 8 * hh); } }
    {   bf16x8 alf[8];
#pragma unroll
        for (int ks = 0; ks < 8; ++ks) alf[ks] = ALF.f[ks];
        LAS bf16* WW = (LAS bf16*)(F.lds + M1W_W); LAS bf16* WA = (LAS bf16*)(F.lds + M1W_A); LAS bf16* WG = (LAS bf16*)(F.lds + M1W_G);
        LAS bf16* LWs = (LAS bf16*)(wl + M1_AT); LAS bf16* LAs = (LAS bf16*)(wl + M1_BT);
        const f32x4 z4l = (f32x4){0.f, 0.f, 0.f, 0.f};
#pragma unroll
        for (int ct = 0; ct < 4; ++ct) {
            f32x4 dw = z4l, da = z4l, dg = z4l;
#pragma unroll
            for (int ks = 0; ks < 2; ++ks) {
                dw = __builtin_amdgcn_mfma_f32_16x16x32_bf16(*(const LAS bf16x8*)(WW + (16 * ct + lr) * M1W_LD + 32 * ks + 8 * lq), alf[ks], dw, 0, 0, 0);
                da = __builtin_amdgcn_mfma_f32_16x16x32_bf16(*(const LAS bf16x8*)(WA + (16 * ct + lr) * M1W_LD + 32 * ks + 8 * lq), alf[2 + ks], da, 0, 0, 0); }
#pragma unroll
            for (int ks = 0; ks < 4; ++ks)
                dg = __builtin_amdgcn_mfma_f32_16x16x32_bf16(*(const LAS bf16x8*)(WG + (16 * ct + lr) * M1G_LD + 32 * ks + 8 * lq), alf[4 + ks], dg, 0, 0, 0);
            u32x2_t wv; wv[0] = cvtpk(dw[0], dw[1]); wv[1] = cvtpk(dw[2], dw[3]); *(LAS u32x2_t*)(LWs + lr * 72 + 16 * ct + 4 * lq) = wv;
            wv[0] = cvtpk(da[0], da[1]); wv[1] = cvtpk(da[2], da[3]); *(LAS u32x2_t*)(LAs + lr * 72 + 16 * ct + 4 * lq) = wv;
            wv[0] = cvtpk(dg[0], dg[1]); wv[1] = cvtpk(dg[2], dg[3]); *(GAS u32x2_t*)((bf16*)(F.lora) + (mb + lr) * NLORA + 1024 + h * 64 + 16 * ct + 4 * lq) = wv; }
        m1_alf_issue(F, u_next, lane, ALF);
        M1_WAIT();
#pragma unroll
        for (int hh = 0; hh < 2; ++hh) { lw[hh] = *(const LAS v4u*)(LWs + te * 72 + c0 + 8 * hh); la[hh] = *(const LAS v4u*)(LAs + te * 72 + c0 + 8 * hh); }
        M1_WAIT();
    }
    float r[16], kh[16], v[16], al[16], e[16], kraw[16]; float ss = 0.f, bs = 0.f;
#pragma unroll
    for (int q = 0; q < 4; ++q) { const int cc = ch + 4 * q; const int hh = q >> 1, w2 = (q & 1) * 2;
        const LAS float* PR = (const LAS float*)(F.lds + M1W_PRM) + c0 + 4 * q;
        const f32x4 mur = *(const LAS f32x4*)(PR), muk = *(const LAS f32x4*)(PR + 64), muv = *(const LAS f32x4*)(PR + 128), w0p = *(const LAS f32x4*)(PR + 192), a0p = *(const LAS f32x4*)(PR + 256);
        const f32x4 kkp = *(const LAS f32x4*)(PR + 320), kap = *(const LAS f32x4*)(PR + 384), rkp = *(const LAS f32x4*)(PR + 448);
#pragma unroll
        for (int j = 0; j < 4; ++j) { const int i = 4 * q + j; const unsigned sh = (j & 1) ? 0xffff0000u : 0u; const int wd = w2 + (j >> 1);
#define M1_BF(x) ((j & 1) ? bf_hi((x)[hh][wd]) : bf_lo((x)[hh][wd]))
            const float rcv = M1_BF(rc), kcv = M1_BF(kc), vcv = M1_BF(vc), rpv = M1_BF(rp), kpv = M1_BF(kp), vpv = M1_BF(vp), lwv = M1_BF(lw), lav = M1_BF(la);
#undef M1_BF
            (void)sh;
            r[i] = rcv + mur[j] * (rpv - rcv); const float ks = kcv + muk[j] * (kpv - kcv); v[i] = vcv + muv[j] * (vpv - vcv);
            al[i] = sigm(a0p[j] + lav); e[i] = 0.6065306597126334f * sigm(w0p[j] + lwv);
            kraw[i] = ks * kkp[j]; ss += kraw[i] * kraw[i];
            kh[i] = ks * (1.0f + (al[i] - 1.0f) * kap[j]); bs += r[i] * kh[i] * rkp[j]; } }
    ss += dpp_f<0xB1>(ss); ss += dpp_f<0x4E>(ss); bs += dpp_f<0xB1>(bs); bs += dpp_f<0x4E>(bs);
    const float inv = 1.0f / sqrtf(fmaxf(ss, 1e-24f));
    if ((lane & 3) == 0) ((GAS float*)slot_pv(F, mb + 14, h))[te] = bs;
    LAS float* EL = (LAS float*)(wl + M1_EL);
#pragma unroll
    for (int q = 0; q < 4; ++q) *(LAS f32x4*)(EL + te * 64 + c0 + 4 * q) = (f32x4){e[4 * q], e[4 * q + 1], e[4 * q + 2], e[4 * q + 3]};
    M1_WAIT();
    { float acc = 0.f;
#pragma unroll
      for (int t = 0; t < 16; ++t) { acc += EL[t * 64 + lane]; EL[t * 64 + lane] = acc; }
      ((GAS float*)slot_pv(F, mb + 12 + (lane >> 5), h))[lane & 31] = __expf(-acc); }
    M1_WAIT();
    float Lt[16], LC[16];
#pragma unroll
    for (int q = 0; q < 4; ++q) { const f32x4 a4 = *(const LAS f32x4*)(EL + te * 64 + c0 + 4 * q), b4 = *(const LAS f32x4*)(EL + 15 * 64 + c0 + 4 * q);
#pragma unroll
        for (int j = 0; j < 4; ++j) { Lt[4 * q + j] = a4[j]; LC[4 * q + j] = b4[j]; } }
    M1_WAIT();
    unsigned pat[8], pbt[8], pkt[8], prt[8], pbh[8], pkh[8], pv[8];
#pragma unroll
    for (int i2 = 0; i2 < 8; ++i2) { float at2[2], bt2[2], kt2[2], rt2[2], bh2[2], kh2[2];
#pragma unroll
        for (int s = 0; s < 2; ++s) { const int i = 2 * i2 + s; const float x1 = __expf(Lt[i]), x1i = __builtin_amdgcn_rcpf(x1), xm1 = x1i * __expf(e[i]), xc = __expf(Lt[i] - LC[i]);
            const float kn = kraw[i] * inv, ba = kn * al[i];
            at2[s] = -kn * xm1; bt2[s] = ba * x1; kt2[s] = kh[i] * x1; rt2[s] = r[i] * x1i; bh2[s] = ba * xc; kh2[s] = kh[i] * xc; }
        pat[i2] = cvtpk(at2[0], at2[1]); pbt[i2] = cvtpk(bt2[0], bt2[1]); pkt[i2] = cvtpk(kt2[0], kt2[1]); prt[i2] = cvtpk(rt2[0], rt2[1]);
        pbh[i2] = cvtpk(bh2[0], bh2[1]); pkh[i2] = cvtpk(kh2[0], kh2[1]); pv[i2] = cvtpk(v[2 * i2], v[2 * i2 + 1]); }
    LAS bf16* AT = (LAS bf16*)(wl + M1_AT); LAS bf16* BT = (LAS bf16*)(wl + M1_BT); LAS bf16* KT = (LAS bf16*)(wl + M1_KT); LAS bf16* RT = (LAS bf16*)(wl + M1_RT);
#pragma unroll
    for (int hh = 0; hh < 2; ++hh) {
        *(LAS v4u*)(AT + te * 72 + c0 + 8 * hh) = (v4u){pat[4 * hh], pat[4 * hh + 1], pat[4 * hh + 2], pat[4 * hh + 3]};
        *(LAS v4u*)(BT + te * 72 + c0 + 8 * hh) = (v4u){pbt[4 * hh], pbt[4 * hh + 1], pbt[4 * hh + 2], pbt[4 * hh + 3]};
        *(LAS v4u*)(KT + te * 72 + c0 + 8 * hh) = (v4u){pkt[4 * hh], pkt[4 * hh + 1], pkt[4 * hh + 2], pkt[4 * hh + 3]};
        const v4u rr = (v4u){prt[4 * hh], prt[4 * hh + 1], prt[4 * hh + 2], prt[4 * hh + 3]};
        *(LAS v4u*)(RT + te * 72 + c0 + 8 * hh) = rr; *(GAS v4u*)(slot_lw(F, m, h) + c0 + 8 * hh) = rr; }
    M1_WAIT();
    const bf16x8 at0 = *(const LAS bf16x8*)(AT + lr * 72 + 8 * lq), at1 = *(const LAS bf16x8*)(AT + lr * 72 + 32 + 8 * lq);
    const bf16x8 b0 = *(const LAS bf16x8*)(BT + lr * 72 + 8 * lq), b1 = *(const LAS bf16x8*)(BT + lr * 72 + 32 + 8 * lq);
    const bf16x8 k0 = *(const LAS bf16x8*)(KT + lr * 72 + 8 * lq), k1 = *(const LAS bf16x8*)(KT + lr * 72 + 32 + 8 * lq);
    const bf16x8 r0 = *(const LAS bf16x8*)(RT + lr * 72 + 8 * lq), r1 = *(const LAS bf16x8*)(RT + lr * 72 + 32 + 8 * lq);
    M1_WAIT();
    const f32x4 z4 = (f32x4){0.f, 0.f, 0.f, 0.f};
    f32x4 dL = z4, dLt = z4, dKt = z4, dRb = z4, dRk = z4;
    dL = __builtin_amdgcn_mfma_f32_16x16x32_bf16(b0, at0, dL, 0, 0, 0); dL = __builtin_amdgcn_mfma_f32_16x16x32_bf16(b1, at1, dL, 0, 0, 0);
    dLt = __builtin_amdgcn_mfma_f32_16x16x32_bf16(at0, b0, dLt, 0, 0, 0); dLt = __builtin_amdgcn_mfma_f32_16x16x32_bf16(at1, b1, dLt, 0, 0, 0);
    dKt = __builtin_amdgcn_mfma_f32_16x16x32_bf16(at0, k0, dKt, 0, 0, 0); dKt = __builtin_amdgcn_mfma_f32_16x16x32_bf16(at1, k1, dKt, 0, 0, 0);
    dRb = __builtin_amdgcn_mfma_f32_16x16x32_bf16(b0, r0, dRb, 0, 0, 0); dRb = __builtin_amdgcn_mfma_f32_16x16x32_bf16(b1, r1, dRb, 0, 0, 0);
    dRk = __builtin_amdgcn_mfma_f32_16x16x32_bf16(k0, r0, dRk, 0, 0, 0); dRk = __builtin_amdgcn_mfma_f32_16x16x32_bf16(k1, r1, dRk, 0, 0, 0);
    f32x4 eye;
#pragma unroll
    for (int i = 0; i < 4; ++i) { const int rr = 4 * lq + i; eye[i] = (rr == lr) ? 1.0f : 0.0f;
        dL[i] = (rr < lr) ? dL[i] : 0.f; dLt[i] = (lr < rr) ? dLt[i] : 0.f; dKt[i] = (lr < rr) ? dKt[i] : 0.f; dRb[i] = (rr <= lr) ? dRb[i] : 0.f; dRk[i] = (rr <= lr) ? dRk[i] : 0.f; }
    {
        u32x2_t wv; wv[0] = cvtpk(dRb[0], dRb[1]); wv[1] = cvtpk(dRb[2], dRb[3]); *(GAS u32x2_t*)(slot_pv(F, mb + 4 + (lr >> 2), h) + (lr & 3) * 16 + 4 * lq) = wv;
        wv[0] = cvtpk(dRk[0], dRk[1]); wv[1] = cvtpk(dRk[2], dRk[3]); *(GAS u32x2_t*)(slot_pv(F, mb + 8 + (lr >> 2), h) + (lr & 3) * 16 + 4 * lq) = wv; }
#pragma unroll
    for (int hh = 0; hh < 2; ++hh) {
        *(GAS v4u*)(slot_pr(F, m, h) + c0 + 8 * hh) = (v4u){pbh[4 * hh], pbh[4 * hh + 1], pbh[4 * hh + 2], pbh[4 * hh + 3]};
        *(GAS v4u*)(slot_pk(F, m, h) + c0 + 8 * hh) = (v4u){pkh[4 * hh], pkh[4 * hh + 1], pkh[4 * hh + 2], pkh[4 * hh + 3]};
        *(GAS v4u*)(slot_la(F, m, h) + c0 + 8 * hh) = (v4u){pv[4 * hh], pv[4 * hh + 1], pv[4 * hh + 2], pv[4 * hh + 3]}; }
    {
        const bf16x4 fL = m2_acc_op(dL), fLt = m2_acc_op(dLt);
        const f32x4 z4b = (f32x4){0.f, 0.f, 0.f, 0.f};
        const f32x4 dL2 = M2_MFMA16(fL, fLt, z4b), dL2t = M2_MFMA16(fLt, fL, z4b);
        f32x4 dTt = dL + eye;
        const bf16x4 fL2t = m2_acc_op(dL2), fL2 = m2_acc_op(dL2t);
        dTt = M2_MFMA16(fL2t, m2_acc_op(dTt), dTt);
        const f32x4 dL4 = M2_MFMA16(fL2, fL2t, z4b), dL4t = M2_MFMA16(fL2t, fL2, z4b);
        const bf16x4 fL4t = m2_acc_op(dL4), fL4 = m2_acc_op(dL4t);
        dTt = M2_MFMA16(fL4t, m2_acc_op(dTt), dTt);
        const f32x4 dL8 = M2_MFMA16(fL4, fL4t, z4b);
        dTt = M2_MFMA16(m2_acc_op(dL8), m2_acc_op(dTt), dTt);
        const bf16x4 tq = m2_acc_op(dTt);
        const f32x4 nn = M2_MFMA16(m2_acc_op(dKt), tq, z4b);
        u32x2_t wv; wv[0] = cvtpk(nn[0], nn[1]); wv[1] = cvtpk(nn[2], nn[3]); *(GAS u32x2_t*)(slot_pv(F, mb + (lr >> 2), h) + (lr & 3) * 16 + 4 * lq) = wv;
#pragma unroll
        for (int tc = 0; tc < 4; ++tc) { const bf16x4 ah = __builtin_amdgcn_ds_read_tr16_b64_v4i16((LAS bf16x4*)(AT + (4 * lq + (lr >> 2)) * 72 + 16 * tc + 4 * (lr & 3)));
            const f32x4 pq = M2_MFMA16(ah, tq, z4b);
            wv[0] = cvtpk(pq[0], pq[1]); wv[1] = cvtpk(pq[2], pq[3]); *(GAS u32x2_t*)(slot_mix(F, mb + lr, h) + 16 * tc + 4 * lq) = wv; }
    }
    M1_WAIT();
    M1_ALF_WAIT(ALF);
}

__device__ __forceinline__ void rwkv_m1_phase(const Frame& F, const LayerP& L) {
    LAS unsigned char* wl = F.lds + RING_OFF + F.wave * M1_PW;
    const int NGW = F.G * NWAVES; int hcur = -1;
    const bool GL = (F.G == 256); const int grp = F.vcu >> 5, li = F.vcu & 31;
    if (GL) lora_prep_edges_grp(F, L.mu, grp, li & 3);
    M1Alf ALF;
#pragma unroll
    for (int ks = 0; ks < 8; ++ks) ALF.f[ks] = (bf16x8){0, 0, 0, 0, 0, 0, 0, 0};
    {   int ul_ = F.lane; asm volatile("" : "+v"(ul_));
        const int uf = (GL ? (((2 * grp) << 10) | ((li >> 2) << 7) | (32 * (li & 3))) : F.vcu * NWAVES) + F.wave;
        m1_alf_issue(F, uf < BATCH * 8 * 128 ? uf : 0, ul_, ALF); M1_ALF_WAIT(ALF); }
    for (int r = 0;; ++r) {
        const int u0 = GL ? (((2 * grp + (r & 1)) << 10) | ((li >> 2) << 7) | (32 * (li & 3) + 8 * (r >> 1))) : F.vcu * NWAVES + r * NGW;
        if (GL ? (r >= 8) : (u0 >= BATCH * 8 * 128)) break;
        const int h = (u0 >> 7) & 7;
        if (h != hcur) {
            if (hcur >= 0) __syncthreads();
            const bf16* W = L.wlora; const int t = F.tid, row = t >> 3, pc = (t & 7) * 8;
            *(LAS v4u*)(F.lds + M1W_W + (row * M1W_LD + pc) * 2) = *(const GAS v4u*)(W + (size_t)(h * 64 + row) * KLORA + pc);
            *(LAS v4u*)(F.lds + M1W_A + (row * M1W_LD + pc) * 2) = *(const GAS v4u*)(W + (size_t)(512 + h * 64 + row) * KLORA + 64 + pc);
#pragma unroll
            for (int j = 0; j < 2; ++j) *(LAS v4u*)(F.lds + M1W_G + (row * M1G_LD + 64 * j + pc) * 2) = *(const GAS v4u*)(W + (size_t)(1024 + h * 64 + row) * KLORA + 128 + 64 * j + pc);
            if (t < 128) { const int pr = t >> 4, c4 = (t & 15) * 4;
                const float* src = pr == 0 ? L.mu : (pr == 1 ? L.mu + 512 : (pr == 2 ? L.mu + 1024 : (pr == 3 ? L.w0 : (pr == 4 ? L.a0 : (pr == 5 ? L.k_k : (pr == 6 ? L.k_a : L.r_k))))));
                *(LAS f32x4*)((LAS float*)(F.lds + M1W_PRM) + pr * 64 + c4) = *(const f32x4*)(src + h * 64 + c4); }
            __syncthreads(); hcur = h; }
        const int u = u0 + F.wave;
        int un = GL ? ((((2 * grp + ((r + 1) & 1)) << 10) | ((li >> 2) << 7) | (32 * (li & 3) + 8 * ((r + 1) >> 1))) + F.wave) : u + NGW;
        if (GL ? (r + 1 >= 8) : (un >= BATCH * 8 * 128)) un = u;
        if (u < BATCH * 8 * 128) rwkv_m1_unit(F, L, u, un, ALF, wl);
    }
}
constexpr int S2_PM = 0, S2_NM = S2_PM + 2304, S2_RT = S2_NM + 1280, S2_MRB = S2_RT + 2304, S2_MRK = S2_MRB + 1280, S2_BH = S2_MRK + 1280, S2_KH = S2_BH + 2560, S2_VS = S2_KH + 2560,
              S2_GC = S2_VS + 2560, S2_RK = S2_GC + 256, S2_SET = S2_RK + 64;
constexpr int S2_SAT = 3 * S2_SET, S2_S = S2_SAT + 5120, S2_YB = S2_S + 2 * 9216, S2_PRM = S2_YB + 2 * 4352, S2_END = S2_PRM + 512;
static_assert(S2_END <= RING_BYTES && (S2_SET % 16) == 0 && (S2_S % 16) == 0 && (S2_YB % 16) == 0, "M2 LDS");
struct M2Raw { v4u a, b, c; };
struct M2Ptr { const bf16 *pa, *pb, *pc; };
__device__ __forceinline__ void m2_ptr0(const Frame& F, int b, int h, int i, M2Ptr& P) {
    const size_t mb = (size_t)b * SEQ; const int i7 = i & 127, row = i7 >> 3, chk = i7 & 7;
    P.pa = (i < 128 ? slot_mix(F, mb + row, h) : slot_lw(F, mb + row, h)) + chk * 8;
    P.pb = (i < 128 ? slot_la(F, mb + row, h) : slot_pr(F, mb + row, h)) + chk * 8;
    const int k1 = i - 128, k2 = i - 224, k3 = i - 240;
    const int tok = i < 128 ? row : (i < 224 ? (k1 >> 3) : (i < 240 ? 12 + (k2 >> 3) : 14));
    const int col = i < 128 ? 512 + chk * 8 : 1024 + (i < 224 ? (k1 & 7) : (i < 240 ? (k2 & 7) : (k3 & 3))) * 8;
    P.pc = (const bf16*)(F.ws + WS_H) + (mb + tok) * NPROJ + h * 64 + col;
}
__device__ __forceinline__ void m2_adv(M2Ptr& P, int i) { P.pa += (i < 128 ? 16 * DM : 16 * NLORA); P.pb += (i < 128 ? 16 * NLORA : 16 * NPROJ); P.pc += 16 * NPROJ; }
__device__ __forceinline__ void m2_load(const M2Ptr& P, M2Raw& R) {
    asm volatile("global_load_dwordx4 %0, %1, off" : "+v"(R.a) : "v"(P.pa) : "memory");
    asm volatile("global_load_dwordx4 %0, %1, off" : "+v"(R.b) : "v"(P.pb) : "memory");
    asm volatile("global_load_dwordx4 %0, %1, off" : "+v"(R.c) : "v"(P.pc) : "memory");
}
#define M2_WAIT_R(R, N) asm volatile("s_waitcnt vmcnt(" #N ")" : "+v"((R).a), "+v"((R).b), "+v"((R).c) :: "memory")
#define M2_WAIT_G(G, N) asm volatile("s_waitcnt vmcnt(" #N ")" : "+v"(G) :: "memory")
__device__ __forceinline__ void g_load(const bf16* p, u32x2_t& G) { asm volatile("global_load_dwordx2 %0, %1, off" : "+v"(G) : "v"(p) : "memory"); }
struct M2Off { int a, b, c; };
__device__ __forceinline__ void m2_off(int i, M2Off& O) {
    const int i7 = i & 127, row = i7 >> 3, chk = i7 & 7;
    O.a = (i < 128 ? S2_PM : S2_RT) + (row * 72 + chk * 8) * 2;
    O.b = (i < 128 ? S2_VS : S2_BH) + (row * 80 + chk * 8) * 2;
    int c = -1;
    if (i < 128) c = S2_KH + (row * 80 + chk * 8) * 2;
    else if (i < 224) { const int k = i - 128, mat = k >> 5, kk = k & 31, t = kk >> 1, hf = kk & 1;
        c = (mat == 0 ? S2_NM : (mat == 1 ? S2_MRB : S2_MRK)) + (t * 40 + hf * 8) * 2; }
    else if (i < 240) c = S2_GC + (i - 224) * 16;
    else if (i < 244) c = S2_RK + (i - 240) * 16;
    O.c = c;
}
__device__ __forceinline__ void m2_store(LAS unsigned char* set, const M2Off& O, const M2Raw& R) {
    *(LAS v4u*)(set + O.a) = R.a; *(LAS v4u*)(set + O.b) = R.b;
    if (O.c >= 0) *(LAS v4u*)(set + O.c) = R.c;
}
#define M2_LDR_ITER(RSET, GSET) \
    { \
        const int pt = tl_ & 255, te = pt >> 4, c4 = (pt & 15) * 4; \
        { \
            LAS unsigned char* SP = lds + ((n + 2) % 3) * S2_SET; \
            const LAS float* PRM = (const LAS float*)(lds + S2_PRM) + c4; \
            const u32x2_t vraw = *(const LAS u32x2_t*)((const LAS bf16*)(SP + S2_VS) + te * 80 + c4); \
            const f32x4 y = *(const LAS f32x4*)((LAS float*)(lds + S2_YB) + ((n + 1) & 1) * 1088 + te * 68 + c4); \
            const f32x4 lnw = *(const LAS f32x4*)(PRM), lnb = *(const LAS f32x4*)(PRM + 64); \
            const f32x4 vv = bf4(vraw); \
            const float bonus = ((const LAS float*)(SP + S2_RK))[te]; \
            __builtin_amdgcn_sched_barrier(0); \
            float s1 = (y[0] + y[1]) + (y[2] + y[3]), s2 = (y[0] * y[0] + y[1] * y[1]) + (y[2] * y[2] + y[3] * y[3]);        \
            s1 += dpp_f<0xB1>(s1); s2 += dpp_f<0xB1>(s2); s1 += dpp_f<0x4E>(s1); s2 += dpp_f<0x4E>(s2); s1 += dpp_f<0x141>(s1); s2 += dpp_f<0x141>(s2); s1 += dpp_f<0x140>(s1); s2 += dpp_f<0x140>(s2); \
            const float mean = s1 * (1.0f / 64.0f), var = fmaxf(s2 * (1.0f / 64.0f) - mean * mean, 0.0f); \
            const f32x4 d = y - mean; \
            const float rstd = __builtin_amdgcn_rsqf(var + LN_X_EPS); \
            M2_WAIT_G(GSET, 18); \
            const f32x4 o = (d * rstd * lnw + lnb + vv * bonus) * bf4(GSET); \
            u32x2_t wv; wv[0] = cvtpk(o[0], o[1]); wv[1] = cvtpk(o[2], o[3]); \
            const bool live = n >= 1 && n <= NCH;                                     \
            GAS u32x2_t* dst = live ? (GAS u32x2_t*)(op) : (GAS u32x2_t*)(dump); \
            *dst = wv; \
            if (live) op += 16 * DM; \
            g_load(gq, GSET); if (n + 4 < NCH) gq += 16 * NLORA; \
        } \
        M2_WAIT_R(RSET, 17); \
        if (n + 1 < NCH) m2_store(lds + ((n + 1) % 3) * S2_SET, OFF, RSET); \
        m2_load(P, RSET); if (n + 6 < NCH) m2_adv(P, pt); \
        LBAR(); \
    }
#define M2_ST_ITER() \
    { \
        const int lane = tl_ & 63, lr = lane & 15, lq = lane >> 4, q = w - 4; \
        if (n < NCH) { \
            LAS unsigned char* SC = lds + (n % 3) * S2_SET; \
            LAS bf16* PM = (LAS bf16*)(SC + S2_PM); LAS bf16* NM = (LAS bf16*)(SC + S2_NM); LAS bf16* VS = (LAS bf16*)(SC + S2_VS); LAS bf16* RT = (LAS bf16*)(SC + S2_RT); \
            LAS bf16* MRB = (LAS bf16*)(SC + S2_MRB); LAS bf16* MRK = (LAS bf16*)(SC + S2_MRK); LAS bf16* BH = (LAS bf16*)(SC + S2_BH); LAS bf16* KH = (LAS bf16*)(SC + S2_KH); \
            const int trow = (4 * lq + (lr >> 2)) * 80 + 4 * (lr & 3);                  \
            bf16x4 pf[4], rf[4], bhf[4], khf[4]; f32x4 gc[4]; \
            _Pragma("unroll") \
            for (int kt = 0; kt < 4; ++kt) { pf[kt] = M2_K16(PM + lr * 72 + 16 * kt + 4 * lq); rf[kt] = M2_K16(RT + lr * 72 + 16 * kt + 4 * lq); \
                bhf[kt] = M2_TR16(BH + trow + 16 * kt); khf[kt] = M2_TR16(KH + trow + 16 * kt); \
                gc[kt] = *(const LAS f32x4*)((LAS float*)(SC + S2_GC) + 16 * kt + 4 * lq); } \
            const bf16x4 nf = M2_K16(NM + lr * 40 + 4 * lq), mbf = M2_K16(MRB + lr * 40 + 4 * lq), mkf = M2_K16(MRK + lr * 40 + 4 * lq), vf = M2_TR16(VS + trow + 16 * q); \
            __builtin_amdgcn_sched_barrier(0); \
            bf16x4 so[4]; \
            _Pragma("unroll") \
            for (int kt = 0; kt < 4; ++kt) so[kt] = m2_acc_op(accS[kt]); \
            const f32x4 z4_ = (f32x4){0.f, 0.f, 0.f, 0.f}; \
            f32x4 sa = M2_MFMA16(nf, vf, z4_), sb = z4_, ya = M2_MFMA16(mkf, vf, z4_), yb = z4_; \
            sa = M2_MFMA16(pf[0], so[0], sa); sb = M2_MFMA16(pf[1], so[1], sb); sa = M2_MFMA16(pf[2], so[2], sa); sb = M2_MFMA16(pf[3], so[3], sb); \
            ya = M2_MFMA16(rf[0], so[0], ya); yb = M2_MFMA16(rf[1], so[1], yb); ya = M2_MFMA16(rf[2], so[2], ya); yb = M2_MFMA16(rf[3], so[3], yb); \
            sa = sa + sb; \
            const bf16x4 sao = m2_acc_op(sa); \
            ya = M2_MFMA16(mbf, sao, ya); \
            _Pragma("unroll") \
            for (int kt = 0; kt < 4; ++kt) { accS[kt] = accS[kt] * gc[kt]; accS[kt] = M2_MFMA16(bhf[kt], sao, accS[kt]); accS[kt] = M2_MFMA16(khf[kt], vf, accS[kt]); } \
            ya = ya + yb;                                                            \
            LAS float* YBs = (LAS float*)(lds + S2_YB) + (n & 1) * 1088 + 16 * q + lr; \
            _Pragma("unroll") \
            for (int i = 0; i < 4; ++i) YBs[(4 * lq + i) * 68] = ya[i]; \
        } \
        LBAR(); \
    }
__device__ __forceinline__ void rwkv_m2_unit(const Frame& F, const LayerP& L, int unit) {
    const int b = unit >> 3, h = unit & 7;
    LAS unsigned char* lds = F.lds + RING_OFF;
    const int tid = F.tid, w = F.wave;
    const bool ldr = w < 4;
    constexpr int NCH = SEQ / 16;
    int tl_ = tid; asm volatile("" : "+v"(tl_));
    for (int i = tid; i < S2_PRM / 4; i += NWAVES * 64) ((LAS unsigned*)lds)[i] = 0u;
    if (tid < 32) { const int row = tid >> 4, c = (tid & 15) * 4; *(LAS f32x4*)((LAS float*)(lds + S2_PRM) + row * 64 + c) = *(const f32x4*)((row == 0 ? L.ln_w : L.ln_b) + h * 64 + c); }
    __syncthreads();
    if (ldr) {
        M2Raw R0, R1, R2, R3; R0.a = (v4u){0u, 0u, 0u, 0u}; R0.b = R0.a; R0.c = R0.a; R1 = R0; R2 = R0; R3 = R0;
        u32x2_t G0 = (u32x2_t){0u, 0u}, G1 = G0, G2 = G0, G3 = G0;
        const int pt = tid, te = pt >> 4, c4 = (pt & 15) * 4, ch = h * 64 + c4;
        M2Ptr P; m2_ptr0(F, b, h, pt, P);
        M2Off OFF; m2_off(pt, OFF);
        { M2Raw T = R0; m2_load(P, T); m2_adv(P, pt); M2_WAIT_R(T, 0); m2_store(lds, OFF, T); }
        const bf16* gq = (const bf16*)(F.lora) + ((size_t)b * SEQ + te) * NLORA + 1024 + ch;
        bf16* op = (bf16*)(F.ws + WS_MIXED) + ((size_t)b * SEQ + te) * DM + ch;
        bf16* dump = (bf16*)(F.ws + WS_DUMP) + ((size_t)F.vcu * 256 + pt) * 4;
#define M2_FILL(RSET, GSET, GADV) { *(GAS u32x2_t*)dump = (u32x2_t){0u, 0u}; g_load(gq, GSET); if (GADV) gq += 16 * NLORA; m2_load(P, RSET); m2_adv(P, pt); }
        M2_FILL(R1, G3, false) M2_FILL(R2, G0, true) M2_FILL(R3, G1, true) M2_FILL(R0, G2, true)
#undef M2_FILL
        __syncthreads();
        for (int n0 = 0; n0 <= NCH; n0 += 4) {
            { const int n = n0;     M2_LDR_ITER(R1, G3) }
            { const int n = n0 + 1; M2_LDR_ITER(R2, G0) }
            { const int n = n0 + 2; M2_LDR_ITER(R3, G1) }
            { const int n = n0 + 3; M2_LDR_ITER(R0, G2) }
        }
        asm volatile("s_waitcnt vmcnt(0)" ::: "memory");
    } else {
        f32x4 accS[4];
#pragma unroll
        for (int q = 0; q < 4; ++q) accS[q] = (f32x4){0.f, 0.f, 0.f, 0.f};
        __syncthreads();
        for (int n0 = 0; n0 <= NCH; n0 += 4) {
            { const int n = n0;     M2_ST_ITER() }
            { const int n = n0 + 1; M2_ST_ITER() }
            { const int n = n0 + 2; M2_ST_ITER() }
            { const int n = n0 + 3; M2_ST_ITER() }
        }
    }
    __syncthreads();
}
constexpr int RT_LD = 72, RT_K2LD = 80, RT_VLD = 144, RT_OLD = 132;
constexpr int RT_QS = 0, RT_KS = RT_QS + 64 * RT_LD * 2, RT_K2 = RT_KS + 64 * RT_LD * 2, RT_SC = RT_K2 + 64 * RT_K2LD * 2, RT_VS = RT_SC + 64 * RT_LD * 2, RT_PT = RT_VS + 64 * RT_VLD * 2,
              RT_OB = RT_PT + 128 * RT_LD * 2, RT_END = RT_OB + 64 * RT_OLD * 4;
static_assert(RT_END <= RING_BYTES && (RT_K2 % 16) == 0 && (RT_VS % 16) == 0 && (RT_OB % 16) == 0, "retention LDS");
typedef unsigned ret_u2 __attribute__((ext_vector_type(2)));
typedef short ret_s4 __attribute__((ext_vector_type(4)));
struct RetA { ret_u2 q1, q2, k1, k2; v4u va, vb; f32x4 cs, sn; };
struct RetG { v4u ga, gb; };
#define RET_LD2(dst, ptr) asm volatile("global_load_dwordx2 %0, %1, off" : "+v"(dst) : "v"(ptr) : "memory")
#define RET_LD4(dst, ptr) asm volatile("global_load_dwordx4 %0, %1, off" : "+v"(dst) : "v"(ptr) : "memory")
__device__ __forceinline__ void ret_load_a(const bf16* P, const float* CS, const float* SN, int h, int dq, RetA& R) {
    const int d = dq * 4, e0 = dq * 16;
    RET_LD2(R.q1, P + h * 64 + d); RET_LD2(R.q2, P + h * 64 + 32 + d); RET_LD2(R.k1, P + 256 + h * 64 + d); RET_LD2(R.k2, P + 256 + h * 64 + 32 + d);
    RET_LD4(R.va, P + 512 + h * 128 + e0); RET_LD4(R.vb, P + 512 + h * 128 + e0 + 8); RET_LD4(R.cs, CS + d); RET_LD4(R.sn, SN + d);
}
__device__ __forceinline__ void ret_load_g(const bf16* P, int h, int dq, RetG& R) { const int e0 = dq * 16; RET_LD4(R.ga, P + 1024 + h * 128 + e0); RET_LD4(R.gb, P + 1024 + h * 128 + e0 + 8); }
#define RET_WAIT_A(R, N) asm volatile("s_waitcnt vmcnt(" #N ")" : "+v"((R).q1), "+v"((R).q2), "+v"((R).k1), "+v"((R).k2), "+v"((R).va), "+v"((R).vb), "+v"((R).cs), "+v"((R).sn) :: "memory")
#define RET_WAIT_G(R, N) asm volatile("s_waitcnt vmcnt(" #N ")" : "+v"((R).ga), "+v"((R).gb) :: "memory")
__device__ __forceinline__ bf16x8 ret_tr(const LAS bf16* img, int ld, int r0, int c0, int lr, int lq) {
    const LAS bf16* p = img + (r0 + 4 * lq + (lr >> 2)) * ld + c0 + 4 * (lr & 3);
    const ret_s4 a = __builtin_amdgcn_ds_read_tr16_b64_v4i16((LAS ret_s4*)p), b = __builtin_amdgcn_ds_read_tr16_b64_v4i16((LAS ret_s4*)(p + 16 * ld));
    return __builtin_shufflevector(a, b, 0, 1, 2, 3, 4, 5, 6, 7);
}
__device__ __forceinline__ bf16x8 ret_rowp(const LAS bf16* row, int k0, int lq) {
    const ret_s4 a = *(const LAS ret_s4*)(row + k0 + 4 * lq), b = *(const LAS ret_s4*)(row + k0 + 16 + 4 * lq);
    return __builtin_shufflevector(a, b, 0, 1, 2, 3, 4, 5, 6, 7);
}
#define RET_ITER(A, G) \
    { \
        int tl_ = tid; asm volatile("" : "+v"(tl_)); \
        const int lane = tl_ & 63, lr = lane & 15, lq = lane >> 4, i = tl_ >> 3, dq = tl_ & 7, d = dq * 4, e0 = dq * 16; \
        const int n2 = (n + 2 < SEQ / 64) ? n + 2 : SEQ / 64 - 1; \
        const bf16* P2 = prow + (size_t)n2 * 64 * NPROJ; \
        {     \
            RET_WAIT_A(A, 16); \
            const f32x4 cs = A.cs, sn = A.sn; \
            f32x4 x1, x2; \
            x1[0] = bf_lo(A.q1[0]); x1[1] = bf_hi(A.q1[0]); x1[2] = bf_lo(A.q1[1]); x1[3] = bf_hi(A.q1[1]); \
            x2[0] = bf_lo(A.q2[0]); x2[1] = bf_hi(A.q2[0]); x2[2] = bf_lo(A.q2[1]); x2[3] = bf_hi(A.q2[1]); \
            f32x4 o1 = x1 * cs - x2 * sn, o2 = x1 * sn + x2 * cs; \
            ret_u2 wv; wv[0] = cvtpk(o1[0], o1[1]); wv[1] = cvtpk(o1[2], o1[3]); *(LAS ret_u2*)(QS + i * RT_LD + d) = wv; \
            wv[0] = cvtpk(o2[0], o2[1]); wv[1] = cvtpk(o2[2], o2[3]); *(LAS ret_u2*)(QS + i * RT_LD + 32 + d) = wv; \
            x1[0] = bf_lo(A.k1[0]); x1[1] = bf_hi(A.k1[0]); x1[2] = bf_lo(A.k1[1]); x1[3] = bf_hi(A.k1[1]); \
            x2[0] = bf_lo(A.k2[0]); x2[1] = bf_hi(A.k2[0]); x2[2] = bf_lo(A.k2[1]); x2[3] = bf_hi(A.k2[1]); \
            o1 = (x1 * cs - x2 * sn) * 0.125f; o2 = (x1 * sn + x2 * cs) * 0.125f; \
            wv[0] = cvtpk(o1[0], o1[1]); wv[1] = cvtpk(o1[2], o1[3]); *(LAS ret_u2*)(KS + i * RT_LD + d) = wv; \
            wv[0] = cvtpk(o2[0], o2[1]); wv[1] = cvtpk(o2[2], o2[3]); *(LAS ret_u2*)(KS + i * RT_LD + 32 + d) = wv; \
            o1 = o1 * kwi; o2 = o2 * kwi; \
            wv[0] = cvtpk(o1[0], o1[1]); wv[1] = cvtpk(o1[2], o1[3]); *(LAS ret_u2*)(K2 + i * RT_K2LD + d) = wv; \
            wv[0] = cvtpk(o2[0], o2[1]); wv[1] = cvtpk(o2[2], o2[3]); *(LAS ret_u2*)(K2 + i * RT_K2LD + 32 + d) = wv; \
            *(LAS v4u*)(VS + i * RT_VLD + e0) = A.va; *(LAS v4u*)(VS + i * RT_VLD + e0 + 8) = A.vb; \
            ret_load_a(P2, COS + n2 * 64 * 32, SIN + n2 * 64 * 32, h, dq, A); \
        } \
        LBAR(); \
        if (!warm) { \
        {     \
            const int ti = w >> 1, ii = 16 * ti + lr; \
            const bf16x8 b0 = *(const LAS bf16x8*)(QS + ii * RT_LD + 8 * lq), b1 = *(const LAS bf16x8*)(QS + ii * RT_LD + 32 + 8 * lq); \
            _Pragma("unroll") \
            for (int q = 0; q < 2; ++q) { const int tj = (w & 1) * 2 + q; \
                const bf16x8 a0 = *(const LAS bf16x8*)(KS + (16 * tj + lr) * RT_LD + 8 * lq), a1 = *(const LAS bf16x8*)(KS + (16 * tj + lr) * RT_LD + 32 + 8 * lq); \
                f32x4 acc = (f32x4){0.f, 0.f, 0.f, 0.f}; \
                acc = __builtin_amdgcn_mfma_f32_16x16x32_bf16(a0, b0, acc, 0, 0, 0); acc = __builtin_amdgcn_mfma_f32_16x16x32_bf16(a1, b1, acc, 0, 0, 0); \
                _Pragma("unroll") \
                for (int rg = 0; rg < 4; ++rg) { const int j = 16 * tj + 4 * lq + rg; const int dd = ii > j ? ii - j : j - ii; acc[rg] *= __builtin_amdgcn_exp2f(lg * (float)dd); } \
                ret_u2 wv; wv[0] = cvtpk(acc[0], acc[1]); wv[1] = cvtpk(acc[2], acc[3]); *(LAS ret_u2*)(SC + ii * RT_LD + 16 * tj + 4 * lq) = wv; } \
        } \
        LBAR(); \
        } \
        if (!warm) \
        {     \
            const int ti = w >> 1, ii = 16 * ti + lr; \
            const LAS bf16* scr = SC + ii * RT_LD; \
            const bf16x8 sb0 = ret_rowp(scr, 0, lq), sb1 = ret_rowp(scr, 32, lq); \
            const bf16x8 qb0 = *(const LAS bf16x8*)(QS + ii * RT_LD + 8 * lq), qb1 = *(const LAS bf16x8*)(QS + ii * RT_LD + 32 + 8 * lq); \
            const bf16x8 ka0 = ret_tr(K2, RT_K2LD, 0, 16 * ti, lr, lq), ka1 = ret_tr(K2, RT_K2LD, 32, 16 * ti, lr, lq); \
            const float gi = __builtin_amdgcn_exp2f(lg * (float)(ii + 1)); \
            _Pragma("unroll") \
            for (int hq = 0; hq < 2; ++hq) { \
                bf16x8 va0[2], va1[2], pa0[2], pa1[2]; \
                _Pragma("unroll") \
                for (int q = 0; q < 2; ++q) { const int te = (w & 1) * 4 + 2 * hq + q; \
                    va0[q] = ret_tr(VS, RT_VLD, 0, 16 * te, lr, lq); va1[q] = ret_tr(VS, RT_VLD, 32, 16 * te, lr, lq); \
                    pa0[q] = *(const LAS bf16x8*)(PT + (16 * te + lr) * RT_LD + 8 * lq); pa1[q] = *(const LAS bf16x8*)(PT + (16 * te + lr) * RT_LD + 32 + 8 * lq); } \
                __builtin_amdgcn_sched_barrier(0); \
                _Pragma("unroll") \
                for (int q = 0; q < 2; ++q) { const int te = (w & 1) * 4 + 2 * hq + q, qq = 2 * hq + q; \
                    f32x4 ai = (f32x4){0.f, 0.f, 0.f, 0.f}, ax = ai; \
                    ai = __builtin_amdgcn_mfma_f32_16x16x32_bf16(va0[q], sb0, ai, 0, 0, 0); ax = __builtin_amdgcn_mfma_f32_16x16x32_bf16(pa0[q], qb0, ax, 0, 0, 0); \
                    ai = __builtin_amdgcn_mfma_f32_16x16x32_bf16(va1[q], sb1, ai, 0, 0, 0); ax = __builtin_amdgcn_mfma_f32_16x16x32_bf16(pa1[q], qb1, ax, 0, 0, 0); \
                    accP[qq] = accP[qq] * g64; \
                    accP[qq] = __builtin_amdgcn_mfma_f32_16x16x32_bf16(ka0, va0[q], accP[qq], 0, 0, 0); accP[qq] = __builtin_amdgcn_mfma_f32_16x16x32_bf16(ka1, va1[q], accP[qq], 0, 0, 0); \
                    *(LAS f32x4*)(OB + ii * RT_OLD + 16 * te + 4 * lq) = ai + ax * gi; } \
                __builtin_amdgcn_sched_barrier(0); \
            } \
        } \
        else {     \
            const int ti = w >> 1; \
            const bf16x8 ka0 = ret_tr(K2, RT_K2LD, 0, 16 * ti, lr, lq), ka1 = ret_tr(K2, RT_K2LD, 32, 16 * ti, lr, lq); \
            _Pragma("unroll") \
            for (int q = 0; q < 4; ++q) { const int te = (w & 1) * 4 + q; \
                const bf16x8 va0 = ret_tr(VS, RT_VLD, 0, 16 * te, lr, lq), va1 = ret_tr(VS, RT_VLD, 32, 16 * te, lr, lq); \
                accP[q] = accP[q] * g64; \
                accP[q] = __builtin_amdgcn_mfma_f32_16x16x32_bf16(ka0, va0, accP[q], 0, 0, 0); accP[q] = __builtin_amdgcn_mfma_f32_16x16x32_bf16(ka1, va1, accP[q], 0, 0, 0); } \
        } \
        LBAR(); \
        {     \
            _Pragma("unroll") \
            for (int q = 0; q < 4; ++q) { const int te = (w & 1) * 4 + q, td = w >> 1; ret_u2 wv; wv[0] = cvtpk(accP[q][0], accP[q][1]); wv[1] = cvtpk(accP[q][2], accP[q][3]); \
                *(LAS ret_u2*)(PT + (16 * te + lr) * RT_LD + 16 * td + 4 * lq) = wv; } \
            RET_WAIT_G(G, 20);                                                        \
            if (warm) { dumpp[0] = (v4u){0u, 0u, 0u, 0u}; dumpp[1] = (v4u){0u, 0u, 0u, 0u}; } else { \
            f32x4 o[4]; float ss = 0.f; \
            _Pragma("unroll") \
            for (int j = 0; j < 4; ++j) { o[j] = *(const LAS f32x4*)(OB + i * RT_OLD + e0 + 4 * j); ss += (o[j][0] * o[j][0] + o[j][1] * o[j][1]) + (o[j][2] * o[j][2] + o[j][3] * o[j][3]); } \
            ss = sum8(ss); \
            const float rstd = __builtin_amdgcn_rsqf(ss * (1.0f / 128.0f) + 1e-6f); \
            v4u oa, ob; \
            _Pragma("unroll") \
            for (int j = 0; j < 4; ++j) { \
                const float g0 = bf_lo(G.ga[j]), g1 = bf_hi(G.ga[j]), g2 = bf_lo(G.gb[j]), g3 = bf_hi(G.gb[j]); \
                const float x0 = o[j >> 1][(2 * j) & 3], x1 = o[j >> 1][(2 * j + 1) & 3], x2 = o[2 + (j >> 1)][(2 * j) & 3], x3 = o[2 + (j >> 1)][(2 * j + 1) & 3]; \
                oa[j] = cvtpk(x0 * rstd * g0 * sigm(g0), x1 * rstd * g1 * sigm(g1)); ob[j] = cvtpk(x2 * rstd * g2 * sigm(g2), x3 * rstd * g3 * sigm(g3)); } \
            bf16* O = orow + (size_t)n * 64 * DM; \
            *(GAS v4u*)O = oa; *(GAS v4u*)(O + 8) = ob; } \
            ret_load_g(P2, h, dq, G); \
        } \
          \
    }
__device__ __forceinline__ void ret_unit(const Frame& F, int unit) {
    const int b = unit >> 3, h = (unit >> 1) & 3, half = unit & 1;
    LAS unsigned char* lds = F.lds + RING_OFF;
    LAS bf16* QS = (LAS bf16*)(lds + RT_QS); LAS bf16* KS = (LAS bf16*)(lds + RT_KS); LAS bf16* K2 = (LAS bf16*)(lds + RT_K2); LAS bf16* SC = (LAS bf16*)(lds + RT_SC);
    LAS bf16* VS = (LAS bf16*)(lds + RT_VS); LAS bf16* PT = (LAS bf16*)(lds + RT_PT); LAS float* OB = (LAS float*)(lds + RT_OB);
    const int tid = F.tid, w = F.wave;
    const float gamma = 1.0f - exp2f(-5.0f - (float)h), lg = log2f(gamma), g64 = exp2f(64.0f * lg);
    for (int i = tid; i < 128 * RT_LD / 2; i += NWAVES * 64) ((LAS unsigned*)PT)[i] = 0u;
    f32x4 accP[4];
#pragma unroll
    for (int q = 0; q < 4; ++q) accP[q] = (f32x4){0.f, 0.f, 0.f, 0.f};
    const float* COS = (const float*)(F.ws + WS_TRIG) + (tid >> 3) * 32; const float* SIN = COS + SEQ * 32;
    const bf16* prow = (const bf16*)(F.ws + WS_H) + ((size_t)b * SEQ + (tid >> 3)) * NPROJ + RET_OFF;
    bf16* orow = (bf16*)(F.ws + WS_MIXED) + ((size_t)b * SEQ + (tid >> 3)) * DM + 512 + h * 128 + (tid & 7) * 16;
    const float kwi = exp2f(lg * (float)(63 - (tid >> 3)));
    GAS v4u* dumpp = (GAS v4u*)(F.ws + WS_DUMP + 1 * MiB) + ((size_t)F.vcu * 512 + tid) * 2;
    const int nend = half ? SEQ / 64 : SEQ / 128;
    RetA A0, A1; RetG G0, G1;
    A0.q1 = (ret_u2){0u, 0u}; A0.q2 = A0.q1; A0.k1 = A0.q1; A0.k2 = A0.q1; A0.va = (v4u){0u, 0u, 0u, 0u}; A0.vb = A0.va; A0.cs = (f32x4){0.f, 0.f, 0.f, 0.f}; A0.sn = A0.cs; A1 = A0;
    G0.ga = (v4u){0u, 0u, 0u, 0u}; G0.gb = G0.ga; G1 = G0;
    {
        const int dq = tid & 7;
        ret_load_a(prow, COS, SIN, h, dq, A0); dumpp[0] = (v4u){0u, 0u, 0u, 0u}; dumpp[1] = (v4u){0u, 0u, 0u, 0u}; ret_load_g(prow, h, dq, G0);
        const bf16* p1 = prow + (size_t)64 * NPROJ;
        ret_load_a(p1, COS + 64 * 32, SIN + 64 * 32, h, dq, A1); dumpp[0] = (v4u){0u, 0u, 0u, 0u}; dumpp[1] = (v4u){0u, 0u, 0u, 0u}; ret_load_g(p1, h, dq, G1);
    }
    __syncthreads();
    for (int n0 = 0; n0 < nend; n0 += 2) {
        const bool warm = half && n0 < SEQ / 128;
        { const int n = n0;     RET_ITER(A0, G0) }
        { const int n = n0 + 1; RET_ITER(A1, G1) }
    }
    asm volatile("s_waitcnt vmcnt(0)" ::: "memory");
    __syncthreads();
}
#ifndef MK_PER_PHASE
#define MK_PER_PHASE 0
#endif
constexpr int PH_PER_LAYER = 10, PH_FINAL = 1 + DEPTH * PH_PER_LAYER, N_PHASES = PH_FINAL + 1;
__global__ void __launch_bounds__(NWAVES * 64, 2) mk_fwd(Args args) {
    extern __shared__ __attribute__((aligned(16))) unsigned char lds[];
    Frame F;
    F.lds = (LAS unsigned char*)lds;
    F.MISC = (volatile LAS unsigned*)(F.lds + MISC_OFF);
    F.tid = threadIdx.x; F.lane = F.tid & 63; F.wave = __builtin_amdgcn_readfirstlane(F.tid >> 6);
    F.G = gridDim.x; { const int bx = blockIdx.x; F.vcu = (F.G % 8 == 0) ? (bx % 8) * (F.G / 8) + bx / 8 : bx; }
    F.ws = args.ws; F.lora = (unsigned char*)args.out;
    gu32* ctl = (gu32*)(F.ws + WS_CTL);
    for (int u = F.tid; u < (LDS_BYTES - LDSCTL_OFF) / 4; u += NWAVES * 64) ((LAS unsigned*)(F.lds + LDSCTL_OFF))[u] = 0u;
    __syncthreads();
#if MK_PER_PHASE
    const int lo = args.ph_lo, hi = args.ph_hi;
#else
    constexpr int lo = 0, hi = N_PHASES;
#endif
    XcdBarrier bar; bar.bar = (unsigned*)(ctl + CW_BAR); bar.x = 0; bar.st = nullptr;
    if (hi - lo > 1) bar = xcd_barrier_post((unsigned*)(ctl + CW_BAR), F.MISC + 8);
    const bool GL = (F.G == 256) && (hi - lo > 1);
    const unsigned grp = (unsigned)(F.vcu >> 5) & 7u;
    if (GL && threadIdx.x == 0) (void)__hip_atomic_fetch_or((unsigned*)(ctl + CW_BAR) + GB_MASK(grp), 1u << bar.x, RLX_AGENT);
#define IN(k) (lo <= (k) && (k) < hi)
#define PHASE_ENTER() do { int t_ = threadIdx.x; asm volatile("" : "+v"(t_)); F.tid = t_; F.lane = t_ & 63; } while (0)
#define SEAM(k) do { if (IN(k) && IN((k) + 1)) { XcdBarrier b_ = bar; asm volatile("" : "+s"(b_.bar), "+s"(b_.x)); xcd_barrier(b_); } } while (0)
#define GSEAM(k) do { if (IN(k) && IN((k) + 1)) { if (GL) { unsigned* gb_ = (unsigned*)(ctl + CW_BAR); unsigned gg_ = grp; asm volatile("" : "+s"(gb_), "+s"(gg_)); grp_barrier(gb_, GB_SUB(gg_), GB_GEN(gg_), 32u, F.MISC[10] != 0u); } \
        else { XcdBarrier b_ = bar; asm volatile("" : "+s"(b_.bar), "+s"(b_.x)); xcd_barrier(b_); } } } while (0)
#define QSEAM(k) do { if (IN(k) && IN((k) + 1)) { if (GL) { unsigned* gb_ = (unsigned*)(ctl + CW_BAR); unsigned qq_ = grp * 8u + ((unsigned)F.vcu & 7u); asm volatile("" : "+s"(gb_), "+s"(qq_)); grp_barrier(gb_, QB_SUB(qq_), QB_GEN(qq_), 4u, F.MISC[10] != 0u); } \
        else { XcdBarrier b_ = bar; asm volatile("" : "+s"(b_.bar), "+s"(b_.x)); xcd_barrier(b_); } } } while (0)
#define QSTAGGER() do { if (GL) for (unsigned i_ = 0; i_ < ((unsigned)F.vcu & 7u); ++i_) __builtin_amdgcn_s_sleep(QSLEEP); } while (0)
#define CTR_WAIT(word, below, acq) do { if (threadIdx.x == 0) { unsigned* gb_ = (unsigned*)(ctl + CW_BAR); asm volatile("" : "+s"(gb_)); XB_SPIN(xb_ld(&gb_[word]) < (below), gb_); \
        if (acq) { __builtin_amdgcn_fence(__ATOMIC_ACQUIRE, "agent"); asm volatile("s_waitcnt vmcnt(0)" ::: "memory"); } } __syncthreads(); } while (0)
#define CTR_POST(word) do { if (threadIdx.x == 0) { unsigned* gb_ = (unsigned*)(ctl + CW_BAR); asm volatile("" : "+s"(gb_)); __builtin_amdgcn_fence(__ATOMIC_RELEASE, "agent"); asm volatile("s_waitcnt vmcnt(0)" ::: "memory"); \
        (void)xb_add(&gb_[word], 1u); } } while (0)
    bf16* XB = (bf16*)(F.ws + WS_XB); bf16* HB = (bf16*)(F.ws + WS_H); bf16* PROJ = (bf16*)(F.ws + WS_H); bf16* MIXED = (bf16*)(F.ws + WS_MIXED); bf16* ALORA = (bf16*)(F.ws + WS_MIXED);
    float* SSQ = (float*)(F.ws + WS_SSQ);
    bf16* HBg = HB;
    if (IN(0)) { PHASE_ENTER(); p0_prologue(F, args); SEAM(0); }
    if (GL) {
        if (threadIdx.x == 0) { const unsigned mk = xb_ld((unsigned*)(ctl + CW_BAR) + GB_MASK(grp)); F.MISC[10] = (mk & (mk - 1u)) != 0u ? 1u : 0u; }
        {   constexpr int LATE = DEPTH * ITEMS_LAYER - ITEMS_EARLY; const int g = (int)grp;
            const int it0 = ITEMS_EARLY + (int)(((long)LATE * (g * (g - 1) / 2)) / 28), it1 = ITEMS_EARLY + (int)(((long)LATE * (g * (g + 1) / 2)) / 28);
            PHASE_ENTER(); p0_weights(F, args, it0, it1, (F.vcu & 31) * NWAVES + F.wave, 32 * NWAVES);
            asm volatile("s_waitcnt vmcnt(0)" ::: "memory"); __syncthreads(); CTR_POST(GB_WDONE); }
        QSTAGGER();
    }
    for (int l = 0; l < DEPTH; ++l) {
        const int pb = 1 + PH_PER_LAYER * l;
        const unsigned char* wl = F.ws + WS_W + (size_t)l * SZ_LAYER;
        float* ssq_in = SSQ + (size_t)(l & 1) * M * 16; float* ssq_a = SSQ + (size_t)((l + 1) & 1) * M * 16; float* ssq_b = ssq_in; float* ssq_c = ssq_a;
        LayerP L; L.mu = args.in[7] + l * RWKV_IN; L.w0 = args.in[8] + l * 512; L.a0 = args.in[10] + l * 512; L.k_k = args.in[13] + l * 512; L.k_a = args.in[14] + l * 512;
        L.r_k = args.in[15] + l * 512; L.ln_w = args.in[16] + l * 512; L.ln_b = args.in[17] + l * 512; L.wlora = (const bf16*)(wl + OFF_WLORA);
        if (IN(pb + 0)) {
            pg8::Gemm g{XB, (const bf16*)(wl + OFF_WGU1), M, NGU, DM, 0u}; pg8::StaticOrder S; S.init(M, NGU, F.G, opaque_bx());
            pg8::EpiSwiglu E{HBg, DFF, ssq_in, (LAS float*)(F.lds + EPI_TAB_OFF)};
            pg8::gemm_phase<pg8::EpiSwiglu, pg8::StaticOrder, true, true>(F.lds + RING_OFF, g, S, E);
            QSEAM(pb + 0);
        }
        if (IN(pb + 1)) {
            if (GL && l == 0) CTR_WAIT(GB_WDONE, (unsigned)F.G, true);
            pg8::Gemm g{HBg, (const bf16*)(wl + OFF_WD1), M, DM, DFF, pg8::HPAD_EL * 2u}; pg8::StaticOrder S; S.init(M, DM, F.G, opaque_bx());
            pg8::EpiResid E{XB, ssq_a, 0.5f};
            pg8::gemm_phase<pg8::EpiResid, pg8::StaticOrder, true, true>(F.lds + RING_OFF, g, S, E);
            QSEAM(pb + 1);
        }
        if (IN(pb + 2)) {
            pg8::Gemm g{XB, (const bf16*)(wl + OFF_WIN), M, NPROJ, DM, 0u}; pg8::WinOrder S; S.init(M, NPROJ, F.G, opaque_bx());
            pg8::EpiProj<true> E{PROJ, NPROJ, ssq_a, (LAS float*)(F.lds + EPI_TAB_OFF), S.fused ? (bf16*)(F.ws + WS_SIDE) : nullptr};
            pg8::gemm_phase<pg8::EpiProj<true>, pg8::WinOrder, true, true>(F.lds + RING_OFF, g, S, E);
            if (S.fused && S.c >= 128) { PHASE_ENTER(); lora_prep_panel(F, L.mu, S.pm6());
            }
            GSEAM(pb + 2);
        }
        if (IN(pb + 3) && F.G != 256) { PHASE_ENTER(); lora_prep(F, L.mu); GSEAM(pb + 3); }
        if (IN(pb + 5)) {
            PHASE_ENTER();
            rwkv_m1_phase(F, L);
            GSEAM(pb + 5);
        }
        if (IN(pb + 6)) {
            PHASE_ENTER();
            for (int u = F.vcu; u < 256; u += F.G) { int uu = u;
                if (GL) { const int li = u & 31, g16 = (u >> 5) * 16; uu = li < 16 ? g16 + li : 128 + g16 + (li - 16); }
                if (uu < 128) rwkv_m2_unit(F, L, uu); else ret_unit(F, uu - 128); }
            GSEAM(pb + 6);
            QSTAGGER();
            if (GL && l == DEPTH - 1) CTR_POST(GB_MDONE);
        }
        if (IN(pb + 7)) {
            pg8::Gemm g{MIXED, (const bf16*)(wl + OFF_WOUT), M, DM, DM, 0u}; pg8::StaticOrder S; S.init(M, DM, F.G, opaque_bx());
            pg8::EpiResid E{XB, ssq_b, 1.0f};
            pg8::gemm_phase<pg8::EpiResid, pg8::StaticOrder, true, true>(F.lds + RING_OFF, g, S, E);
            QSEAM(pb + 7);
        }
        if (IN(pb + 8)) {
            pg8::Gemm g{XB, (const bf16*)(wl + OFF_WGU2), M, NGU, DM, 0u}; pg8::StaticOrder S; S.init(M, NGU, F.G, opaque_bx());
            pg8::EpiSwiglu E{HBg, DFF, ssq_b, (LAS float*)(F.lds + EPI_TAB_OFF)};
            pg8::gemm_phase<pg8::EpiSwiglu, pg8::StaticOrder, true, true>(F.lds + RING_OFF, g, S, E);
            QSEAM(pb + 8);
        }
        if (IN(pb + 9)) {
            pg8::Gemm g{HBg, (const bf16*)(wl + OFF_WD2), M, DM, DFF, pg8::HPAD_EL * 2u}; pg8::StaticOrder S; S.init(M, DM, F.G, opaque_bx());
            pg8::EpiResid E{XB, ssq_c, 0.5f};
            pg8::gemm_phase<pg8::EpiResid, pg8::StaticOrder, true, true>(F.lds + RING_OFF, g, S, E);
            QSEAM(pb + 9);
        }
    }
    if (IN(PH_FINAL)) {
        PHASE_ENTER();
        const float* ssq = SSQ + (size_t)(DEPTH & 1) * M * 16; const float* gain = args.in[23];
        const unsigned tmo = __hip_atomic_load(ctl + CW_BAR + XB_TMO, RLX_AGENT);
        const int gw = F.vcu * NWAVES + F.wave, NGW = F.G * NWAVES;
        if (GL) CTR_WAIT(GB_MDONE, (unsigned)F.G, false);
        f32x4 gv[4];
#pragma unroll
        for (int j = 0; j < 4; ++j) gv[j] = *((const f32x4*)gain + 2 * F.lane + (j & 1) + 128 * (j >> 1));
        for (int k = 0;; k += 4) {
            int mr[4]; bool ok[4];
#pragma unroll
            for (int r = 0; r < 4; ++r) { mr[r] = GL ? ((int)grp * 16 + (F.vcu & 7) + 8 * ((k + r) >> 3)) * 256 + (((F.vcu & 31) >> 3) * NWAVES + F.wave) + 32 * ((k + r) & 7) : gw + (k + r) * NGW;     ok[r] = GL ? (k + r < 16) : (mr[r] < M); if (!ok[r]) mr[r] = 0; }
            if (!ok[0]) break;
            f32x4 sq[4][4]; v4u xv[4][2];
#pragma unroll
            for (int r = 0; r < 4; ++r) { const f32x4* sp = (const f32x4*)(ssq + (size_t)mr[r] * pg8::SSQ_P);
#pragma unroll
                for (int j = 0; j < 4; ++j) sq[r][j] = sp[j];
                const GAS v4u* xr = (const GAS v4u*)(XB + (size_t)mr[r] * DM) + F.lane; xv[r][0] = xr[0]; xv[r][1] = xr[64]; }
#pragma unroll
            for (int r = 0; r < 4; ++r) { if (!ok[r]) continue;
                const f32x4 s4 = (sq[r][0] + sq[r][1]) + (sq[r][2] + sq[r][3]); const float tt = (s4[0] + s4[1]) + (s4[2] + s4[3]);
                const float rs = (1.0f / sqrtf(tt * (1.0f / 1024.0f) + pg8::RMS_EPS)) * (tmo ? __builtin_nanf("") : 1.0f);
                GAS f32x4* orow = (GAS f32x4*)(args.out + (size_t)mr[r] * DM) + 2 * F.lane;
#pragma unroll
                for (int j = 0; j < 2; ++j) { const v4u v = xv[r][j];
                    const f32x4 a = {bf_lo(v.x), bf_hi(v.x), bf_lo(v.y), bf_hi(v.y)}, c = {bf_lo(v.z), bf_hi(v.z), bf_lo(v.w), bf_hi(v.w)};
                    orow[128 * j] = a * rs * gv[2 * j]; orow[128 * j + 1] = c * rs * gv[2 * j + 1]; } }
        }
    }
#undef IN
#undef SEAM
}

extern "C" void kernel_launch(void* const* d_in, const int* in_sizes, int n_in, void* d_out, int out_size, void* d_ws, size_t ws_size, hipStream_t stream) {
    static int grid = 0;
    if (grid == 0) {
        if (n_in != 24 || in_sizes[0] != M * DM || out_size != M * DM || ws_size < WS_END) { fprintf(stderr, "kernel_launch: unexpected shapes (n_in %d, in0 %d, out %d, ws %zu); nothing launched\n", n_in, n_in > 0 ? in_sizes[0] : -1, out_size, ws_size); grid = -1; return; }
        int dev = 0, cus = 0, per_cu = 0;
        if (hipGetDevice(&dev) != hipSuccess || hipDeviceGetAttribute(&cus, hipDeviceAttributeMultiprocessorCount, dev) != hipSuccess) { grid = -1; return; }
        if (hipFuncSetAttribute((const void*)mk_fwd, hipFuncAttributeMaxDynamicSharedMemorySize, LDS_BYTES) != hipSuccess) { fprintf(stderr, "kernel_launch: hipFuncSetAttribute failed\n"); grid = -1; return; }
        if (hipOccupancyMaxActiveBlocksPerMultiprocessor(&per_cu, (const void*)mk_fwd, NWAVES * 64, LDS_BYTES) != hipSuccess || per_cu < 1)
            fprintf(stderr, "kernel_launch: note: occupancy query reports %d workgroups per CU\n", per_cu);
        (void)hipGetLastError();
        grid = cus;
    }
    if (grid < 0) return;
    if (hipMemsetAsync((char*)d_ws + WS_CTL, 0, CTL_ZERO_BYTES, stream) != hipSuccess) return;
    Args a{};
    for (int i = 0; i < 24; ++i) a.in[i] = (const float*)d_in[i];
    a.out = (float*)d_out; a.ws = (unsigned char*)d_ws;
#if MK_PER_PHASE
    for (int p = 0; p < N_PHASES; ++p) { a.ph_lo = p; a.ph_hi = p + 1; hipLaunchKernelGGL(mk_fwd, dim3(grid), dim3(NWAVES * 64), LDS_BYTES, stream, a); }
#else
    a.ph_lo = 0; a.ph_hi = N_PHASES;
    hipLaunchKernelGGL(mk_fwd, dim3(grid), dim3(NWAVES * 64), LDS_BYTES, stream, a);
#endif
}
```

```cpp
#include <hip/hip_runtime.h>
#include <cstdio>
#include <cstdint>
#include <cmath>
namespace pg8 {
#define PG8_LAS __attribute__((address_space(3)))
typedef unsigned short bf16_t;
typedef short bf16x8 __attribute__((ext_vector_type(8)));
typedef float f32x4 __attribute__((ext_vector_type(4)));
typedef unsigned u32x4 __attribute__((ext_vector_type(4)));
constexpr int BM = 256, BK = 64, HALF = 128, HTB = HALF * BK * 2  , STAGE_BYTES = 8 * HTB, NXCD = 8, WGM = 8;

__host__ __device__ __forceinline__ int lds_byte(int r, int c) { const int st = (r >> 4) * 2 + (c >> 5), rr = r & 15, cc = c & 31, ob = rr * 64 + cc * 2; return st * 1024 + (ob ^ (((ob >> 9) & 1) << 5)); }
__host__ __device__ __forceinline__ void stage_rc(int b, int& R, int& C) { const int st = b / 1024, sb = b % 1024, swz = sb ^ (((sb >> 9) & 1) << 5); R = (st >> 1) * 16 + swz / 64; C = (st & 1) * 32 + (swz % 64) / 2; }
__host__ __device__ __forceinline__ int perm32(int rho) { const int n = rho >> 4, i = rho & 15; return 8 * (i >> 2) + 4 * n + (i & 3); }

struct Unit { int pm, pn; };
struct Gemm { const bf16_t* A; const bf16_t* Bt; int M, N, K; unsigned apad; };

struct StaticOrder {
    int nM, nN, nwg, G, c;
    __host__ __device__ void init(int M, int N, int G_, int c_) { nM = M / BM; nN = N / BM; nwg = nM * nN; G = G_; c = c_; }
    __host__ __device__ bool next(int i, Unit& u) const {
        const long L = (long)i * G + c; if (L >= nwg) return false;
        int wgid = (int)L; { const int q = nwg / NXCD, r = nwg % NXCD, xcd = wgid % NXCD, off = wgid / NXCD; wgid = (xcd < r ? xcd * (q + 1) : r * (q + 1) + (xcd - r) * q) + off; }
        const int nig = WGM * nN, gid = wgid / nig, fm = gid * WGM, gsz = (nM - fm) < WGM ? (nM - fm) : WGM;
        u.pm = fm + ((wgid % nig) % gsz); u.pn = (wgid % nig) / gsz; return true;
    }
    __device__ __forceinline__ void a_ready(const Unit&) const {}
    __device__ __forceinline__ void done(const Unit&) const {}
};
struct WinOrder {
    StaticOrder base; int c; bool fused;
    __host__ __device__ void init(int M, int N, int G_, int c_) { fused = (G_ == 256); c = c_; base.init(M, fused ? N - BM : N, G_, c_); }
    __host__ __device__ int pm6() const { return 16 * (c & 7) + ((c - 128) >> 3); }
    __host__ __device__ bool next(int i, Unit& u) const {
        if (!fused) return base.next(i, u);
        bool ok;
        if (c >= 128) { if (i == 0) { u.pm = pm6(); u.pn = 6; return true; } if (i > 5) return false; ok = base.next(i - 1, u); }
        else { if (i < 6) ok = base.next(i, u); else if (i == 6) { StaticOrder b2 = base; b2.c = c + 128; ok = b2.next(5, u); } else return false; }
        if (ok && u.pn >= 6) u.pn += 1;
        return ok;
    }
    __device__ __forceinline__ void a_ready(const Unit&) const {}
    __device__ __forceinline__ void done(const Unit&) const {}
};


__device__ __forceinline__ unsigned cvt_pk_bf16(float lo, float hi) { unsigned r; asm volatile("v_cvt_pk_bf16_f32 %0, %1, %2" : "=v"(r) : "v"(lo), "v"(hi)); return r; }
typedef unsigned u32x2 __attribute__((ext_vector_type(2)));
constexpr int SSQ_P = 16;
constexpr float RMS_EPS = 1e-6f;
__device__ __forceinline__ float fast_rcp(float x) { return __builtin_amdgcn_rcpf(x); }
__device__ __forceinline__ float sigmoid_f(float x) { return fast_rcp(1.0f + __expf(-x)); }
__device__ __forceinline__ float silu_f(float x) { return x * sigmoid_f(x); }
__device__ __forceinline__ float row_rstd(const float* ssq, int row) {
    const f32x4* p = (const f32x4*)(ssq + (size_t)row * SSQ_P);
    const f32x4 a = p[0], b = p[1], c = p[2], d = p[3];
    const f32x4 s = (a + b) + (c + d);
    const float t = (s[0] + s[1]) + (s[2] + s[3]);
    return 1.0f / sqrtf(t * (1.0f / 1024.0f) + RMS_EPS);
}
constexpr unsigned HPAD_EL = 256u * (3328u - 2816u);
struct EpiSwiglu {
    static constexpr bool PERM = true, AFTER_DRAIN = false;
    bf16_t* H; int ldh; const float* ssq; PG8_LAS float* tab;
    __device__ __forceinline__ void begin(int wid, int lane) const { if (lane == 0) ((PG8_LAS int*)(tab + 8 * 128))[wid] = -1; }
    __device__ __forceinline__ void operator()(const f32x4 (&acc)[2][2][4][2], const Unit& u, int wr, int wc, int fr, int fq) const {
        const int row0 = u.pm * BM + wr * 64 + fr, col0 = u.pn * HALF + wc * 32 + 8 * fq;
        PG8_LAS float* const tb = tab + (wr * 4 + wc) * 128; PG8_LAS int* const tg = (PG8_LAS int*)(tab + 8 * 128) + (wr * 4 + wc);
        if (__builtin_amdgcn_readfirstlane(*tg) != u.pm) { const int ln = fq * 16 + fr, rb = u.pm * BM + wr * 64 + ln;
            const float t0 = row_rstd(ssq, rb), t1 = row_rstd(ssq, rb + HALF); tb[ln] = t0; tb[64 + ln] = t1; if (ln == 0) *tg = u.pm; }
#pragma unroll
        for (int ai = 0; ai < 2; ++ai)
#pragma unroll
            for (int m = 0; m < 4; ++m) { const int row = row0 + ai * HALF + m * 16; const float rs = tb[ai * 64 + m * 16 + fr];
                typedef float f32x2v __attribute__((ext_vector_type(2)));
                const float c1 = rs * -1.4426950408889634f, c2 = rs * rs;
                f32x2v tp[4], hp[4];
#pragma unroll
                for (int n = 0; n < 2; ++n)
#pragma unroll
                    for (int i2 = 0; i2 < 2; ++i2) { const f32x2v g2 = {acc[ai][0][m][n][2 * i2], acc[ai][0][m][n][2 * i2 + 1]}, u2 = {acc[ai][1][m][n][2 * i2], acc[ai][1][m][n][2 * i2 + 1]};
                        tp[n * 2 + i2] = g2 * c1; hp[n * 2 + i2] = (g2 * u2) * c2; }
#pragma unroll
                for (int k = 0; k < 4; ++k) { tp[k].x = __builtin_amdgcn_exp2f(tp[k].x); tp[k].y = __builtin_amdgcn_exp2f(tp[k].y); }
#pragma unroll
                for (int k = 0; k < 4; ++k) tp[k] = tp[k] + 1.0f;
#pragma unroll
                for (int k = 0; k < 4; ++k) { tp[k].x = __builtin_amdgcn_rcpf(tp[k].x); tp[k].y = __builtin_amdgcn_rcpf(tp[k].y); }
                float hv[8];
#pragma unroll
                for (int k = 0; k < 4; ++k) { const f32x2v r2 = hp[k] * tp[k]; hv[2 * k] = r2.x; hv[2 * k + 1] = r2.y; }
                u32x4 w; w.x = cvt_pk_bf16(hv[0], hv[1]); w.y = cvt_pk_bf16(hv[2], hv[3]); w.z = cvt_pk_bf16(hv[4], hv[5]); w.w = cvt_pk_bf16(hv[6], hv[7]);
                *(u32x4*)(H + (size_t)row * ldh + (size_t)u.pm * HPAD_EL + col0) = w; }
    }
};
__device__ __forceinline__ float sum_fq(float x) {
    float a = x, b = x;
    asm volatile("s_nop 1\n\tv_permlane16_swap_b32 %0, %1" : "+v"(a), "+v"(b));
    a = a + b; b = a;
    asm volatile("s_nop 1\n\tv_permlane32_swap_b32 %0, %1" : "+v"(a), "+v"(b));
    return a + b;
}
struct EpiResid {
    static constexpr bool PERM = true, AFTER_DRAIN = false;
    bf16_t* xb; float* ssq; float scale;
    __device__ __forceinline__ void begin(int, int) const {}
    __device__ __forceinline__ void operator()(const f32x4 (&acc)[2][2][4][2], const Unit& u, int wr, int wc, int fr, int fq) const {
        const int row0 = u.pm * BM + wr * 64 + fr, col0 = u.pn * BM + wc * 32 + 8 * fq;
        u32x4 xo[4][2][2];
#define EPR_LOAD(g) do { _Pragma("unroll") for (int mm = 0; mm < 2; ++mm) _Pragma("unroll") for (int bj = 0; bj < 2; ++bj) \
            xo[g][mm][bj] = *(const u32x4*)(xb + (size_t)(row0 + ((g) >> 1) * HALF + (2 * ((g) & 1) + mm) * 16) * 1024 + col0 + bj * HALF); } while (0)
        EPR_LOAD(0); EPR_LOAD(1);
#pragma unroll
        for (int g = 0; g < 4; ++g) { const int ai = g >> 1;
            if (g == 0) EPR_LOAD(2); else if (g == 1) EPR_LOAD(3);
#pragma unroll
            for (int mm = 0; mm < 2; ++mm) { const int m = 2 * (g & 1) + mm; const int row = row0 + ai * HALF + m * 16; float ss = 0.f;
#pragma unroll
                for (int bj = 0; bj < 2; ++bj) { const u32x4 o = xo[g][mm][bj];
                    const f32x4 x0 = {__builtin_bit_cast(float, o.x << 16), __builtin_bit_cast(float, o.x & 0xffff0000u), __builtin_bit_cast(float, o.y << 16), __builtin_bit_cast(float, o.y & 0xffff0000u)};
                    const f32x4 x1 = {__builtin_bit_cast(float, o.z << 16), __builtin_bit_cast(float, o.z & 0xffff0000u), __builtin_bit_cast(float, o.w << 16), __builtin_bit_cast(float, o.w & 0xffff0000u)};
                    const f32x4 v0 = x0 + acc[ai][bj][m][0] * scale, v1 = x1 + acc[ai][bj][m][1] * scale;
                    u32x4 w; w.x = cvt_pk_bf16(v0[0], v0[1]); w.y = cvt_pk_bf16(v0[2], v0[3]); w.z = cvt_pk_bf16(v1[0], v1[1]); w.w = cvt_pk_bf16(v1[2], v1[3]);
                    *(u32x4*)(xb + (size_t)row * 1024 + col0 + bj * HALF) = w;
                    const float r0 = __builtin_bit_cast(float, w.x << 16), r1 = __builtin_bit_cast(float, w.x & 0xffff0000u), r2 = __builtin_bit_cast(float, w.y << 16), r3 = __builtin_bit_cast(float, w.y & 0xffff0000u);
                    const float r4 = __builtin_bit_cast(float, w.z << 16), r5 = __builtin_bit_cast(float, w.z & 0xffff0000u), r6 = __builtin_bit_cast(float, w.w << 16), r7 = __builtin_bit_cast(float, w.w & 0xffff0000u);
                    ss += ((r0 * r0 + r1 * r1) + (r2 * r2 + r3 * r3)) + ((r4 * r4 + r5 * r5) + (r6 * r6 + r7 * r7)); }
                ss = sum_fq(ss);
                if (fq == 0) ssq[(size_t)row * SSQ_P + u.pn * 4 + wc] = ss; }
        }
#undef EPR_LOAD
    }
};
template <bool SCALE> struct EpiProj {
    static constexpr bool PERM = true, AFTER_DRAIN = false;
    __device__ __forceinline__ void begin(int wid, int lane) const { if (lane == 0) ((PG8_LAS int*)(tab + 8 * 128))[wid] = -1; }
    bf16_t* O; int ldc; const float* ssq; PG8_LAS float* tab; bf16_t* side;
    __device__ __forceinline__ void operator()(const f32x4 (&acc)[2][2][4][2], const Unit& u, int wr, int wc, int fr, int fq) const {
        const int row0 = u.pm * BM + wr * 64 + fr, col0 = u.pn * BM + wc * 32 + 8 * fq;
        PG8_LAS float* const tb = tab + (wr * 4 + wc) * 128; PG8_LAS int* const tg = (PG8_LAS int*)(tab + 8 * 128) + (wr * 4 + wc);
        if (SCALE) { if (__builtin_amdgcn_readfirstlane(*tg) != u.pm) { const int ln = fq * 16 + fr, rb = u.pm * BM + wr * 64 + ln; const float t0 = row_rstd(ssq, rb), t1 = row_rstd(ssq, rb + HALF); tb[ln] = t0; tb[64 + ln] = t1; if (ln == 0) *tg = u.pm; } }
#pragma unroll
        for (int ai = 0; ai < 2; ++ai)
#pragma unroll
            for (int m = 0; m < 4; ++m) { const int row = row0 + ai * HALF + m * 16; const float rs = SCALE ? tb[ai * 64 + m * 16 + fr] : 1.0f;
#pragma unroll
                for (int bj = 0; bj < 2; ++bj) { const f32x4 v0 = acc[ai][bj][m][0] * rs, v1 = acc[ai][bj][m][1] * rs;
                    u32x4 w; w.x = cvt_pk_bf16(v0[0], v0[1]); w.y = cvt_pk_bf16(v0[2], v0[3]); w.z = cvt_pk_bf16(v1[0], v1[1]); w.w = cvt_pk_bf16(v1[2], v1[3]);
                    *(u32x4*)(O + (size_t)row * ldc + col0 + bj * HALF) = w;
                    if (side != nullptr && u.pn < 6 && fr == 15) *(u32x4*)(side + (size_t)(row >> 4) * 1536 + col0 + bj * HALF) = w; } }
    }
};

template <class Epi, class Sched, bool ALIGN_EPI = false, bool SP2 = false>
__device__ __forceinline__ void gemm_phase(PG8_LAS unsigned char* lds, const Gemm g, const Sched& S, const Epi& E) {
    int tid_ = threadIdx.x; asm volatile("" : "+v"(tid_));
    const int tid = tid_, wid = __builtin_amdgcn_readfirstlane(tid >> 6), lane = tid & 63, wr = wid >> 2, wc = wid & 3, fr = lane & 15, fq = lane >> 4;
    const int K = g.K, nt = K / BK;
    unsigned voffA[2], voffB[2];
#pragma unroll
    for (int i = 0; i < 2; ++i) { int R, C; stage_rc(tid * 16 + i * 8192, R, C); const int Rb = Epi::PERM ? ((R & ~31) + perm32(R & 31)) : R;
        voffA[i] = (unsigned)(R * K + C) * 2u; voffB[i] = (unsigned)(Rb * K + C) * 2u; }
    const unsigned kstep = (unsigned)(BK * 2);
    const unsigned hstep = (unsigned)HALF * (unsigned)K * 2u;
    const unsigned tstep = 2u * hstep;
    const unsigned tstepA = tstep + g.apad;
    const __amdgpu_buffer_rsrc_t rsA = __builtin_amdgcn_make_buffer_rsrc((void*)g.A, (short)0, (int)((size_t)g.M * K * 2 + (size_t)(g.M / BM) * g.apad), 0x00020000);
    const __amdgpu_buffer_rsrc_t rsB = __builtin_amdgcn_make_buffer_rsrc((void*)g.Bt, (short)0, (int)((size_t)g.N * K * 2), 0x00020000);
    const unsigned ldsw = (unsigned)wid * 1024u;
    const int aoff = lds_byte(wr * 64 + fr, fq * 8), boff = lds_byte(wc * 32 + fr, fq * 8);
#define PG8_SA(b, h) (((b) * 2 + (h)) * HTB)
#define PG8_SB(b, h) ((4 + (b) * 2 + (h)) * HTB)
#define PG8_STAGE_X(rs, bufoff, goff, voff) do { _Pragma("unroll") for (int _i = 0; _i < 2; ++_i) \
        __builtin_amdgcn_raw_ptr_buffer_load_lds(rs, (PG8_LAS unsigned*)(lds + (bufoff) + ldsw + _i * 8192), 16, (int)(voff)[_i], (int)(goff), 0, 0); } while (0)
#define PG8_STAGE_A(bufoff, goff, voff) PG8_STAGE_X(rsA, bufoff, goff, voff)
#define PG8_STAGE_B(bufoff, goff, voff) PG8_STAGE_X(rsB, bufoff, goff, voff)
#define PG8_LDA(dst, b, h) do { _Pragma("unroll") for (int m = 0; m < 4; ++m) _Pragma("unroll") for (int k = 0; k < 2; ++k) dst[m][k] = *(const PG8_LAS bf16x8*)(lds + PG8_SA(b, h) + aoff + m * 2048 + k * 1024); } while (0)
#define PG8_LDB(dst, b, h) do { _Pragma("unroll") for (int n = 0; n < 2; ++n) _Pragma("unroll") for (int k = 0; k < 2; ++k) dst[n][k] = *(const PG8_LAS bf16x8*)(lds + PG8_SB(b, h) + boff + n * 2048 + k * 1024); } while (0)
#define PG8_MMA(ai, bj, At, Bt) do { __builtin_amdgcn_s_setprio(1); _Pragma("unroll") for (int m = 0; m < 4; ++m) _Pragma("unroll") for (int n = 0; n < 2; ++n) _Pragma("unroll") for (int k = 0; k < 2; ++k) \
        acc[ai][bj][m][n] = __builtin_amdgcn_mfma_f32_16x16x32_bf16(Bt[n][k], At[m][k], acc[ai][bj][m][n], 0, 0, 0); __builtin_amdgcn_s_setprio(0); } while (0)
#define PG8_WAIT_V(n) asm volatile("s_waitcnt vmcnt(" #n ")" ::: "memory")
#define PG8_WAIT_L(n) asm volatile("s_waitcnt lgkmcnt(" #n ")" ::: "memory")
#define PG8_BAR __builtin_amdgcn_s_barrier()
#define PG8_SCHED __builtin_amdgcn_sched_barrier(0)
    E.begin(wid, lane);
    Unit cur, nxt; int ui = 0;
    if (!S.next(0, cur)) return;
    f32x4 acc[2][2][4][2];
#pragma unroll
    for (int a = 0; a < 2; ++a)
#pragma unroll
        for (int b = 0; b < 2; ++b)
#pragma unroll
            for (int m = 0; m < 4; ++m)
#pragma unroll
                for (int n = 0; n < 2; ++n) acc[a][b][m][n] = (f32x4){0.f, 0.f, 0.f, 0.f};
    bf16x8 At[4][2], B0[2][2], B1[2][2];
    unsigned cA = (unsigned)cur.pm * tstepA, cB = (unsigned)cur.pn * tstep;
    S.a_ready(cur);
    if constexpr (SP2) {
        PG8_STAGE_B(PG8_SB(0, 0), cB, voffB); PG8_STAGE_B(PG8_SB(0, 1), cB + hstep, voffB); PG8_STAGE_A(PG8_SA(0, 0), cA, voffA); PG8_STAGE_A(PG8_SA(0, 1), cA + hstep, voffA);
        if (wr == 1) PG8_BAR;
        PG8_WAIT_V(2); PG8_BAR;
        PG8_STAGE_B(PG8_SB(1, 0), cB + kstep, voffB); PG8_STAGE_A(PG8_SA(1, 0), cA + kstep, voffA); PG8_STAGE_B(PG8_SB(1, 1), cB + hstep + kstep, voffB);
        PG8_WAIT_V(6); PG8_BAR;
    } else {
        PG8_STAGE_B(PG8_SB(0, 0), cB, voffB); PG8_STAGE_A(PG8_SA(0, 0), cA, voffA); PG8_STAGE_B(PG8_SB(0, 1), cB + hstep, voffB); PG8_STAGE_A(PG8_SA(0, 1), cA + hstep, voffA);
        if (wr == 1) PG8_BAR;
        PG8_WAIT_V(4); PG8_BAR;
        PG8_STAGE_B(PG8_SB(1, 0), cB + kstep, voffB); PG8_STAGE_A(PG8_SA(1, 0), cA + kstep, voffA); PG8_STAGE_B(PG8_SB(1, 1), cB + hstep + kstep, voffB);
        PG8_WAIT_V(6); PG8_BAR;
    }
    for (;;) {
        const bool has_next = S.next(ui + 1, nxt);
        const unsigned nA = has_next ? (unsigned)nxt.pm * tstepA : cA, nB = has_next ? (unsigned)nxt.pn * tstep : cB;
        for (int t = 0; t < nt; t += 2) {
            const bool last = (t == nt - 2);
            const unsigned a1 = cA + (unsigned)(t + 1) * kstep;
            const unsigned a2 = last ? nA : cA + (unsigned)(t + 2) * kstep, b2 = last ? nB : cB + (unsigned)(t + 2) * kstep;
            const unsigned a3 = a2 + kstep, b3 = b2 + kstep;
            if (last && has_next) S.a_ready(nxt);
            if constexpr (SP2) {
            PG8_LDB(B0, 0, 0); PG8_LDB(B1, 0, 1); PG8_SCHED; PG8_LDA(At, 0, 0); PG8_STAGE_A(PG8_SA(1, 1), a1 + hstep, voffA);
            PG8_WAIT_V(8); PG8_WAIT_L(0); PG8_BAR; PG8_MMA(0, 0, At, B0); PG8_MMA(0, 1, At, B1); PG8_BAR; PG8_SCHED;
            PG8_LDA(At, 0, 1); PG8_STAGE_B(PG8_SB(0, 0), b2, voffB); PG8_STAGE_B(PG8_SB(0, 1), b2 + hstep, voffB); PG8_STAGE_A(PG8_SA(0, 0), a2, voffA);
            PG8_WAIT_V(8); PG8_WAIT_L(0); PG8_BAR; PG8_MMA(1, 0, At, B0); PG8_MMA(1, 1, At, B1); PG8_BAR; PG8_SCHED;
            PG8_LDB(B0, 1, 0); PG8_LDB(B1, 1, 1); PG8_SCHED; PG8_LDA(At, 1, 0); PG8_STAGE_A(PG8_SA(0, 1), a2 + hstep, voffA);
            PG8_WAIT_V(8); PG8_WAIT_L(0); PG8_BAR; PG8_MMA(0, 0, At, B0); PG8_MMA(0, 1, At, B1); PG8_BAR; PG8_SCHED;
            PG8_LDA(At, 1, 1); PG8_STAGE_B(PG8_SB(1, 0), b3, voffB); PG8_STAGE_B(PG8_SB(1, 1), b3 + hstep, voffB); PG8_STAGE_A(PG8_SA(1, 0), a3, voffA);
            PG8_WAIT_V(8); PG8_WAIT_L(0); PG8_BAR; PG8_MMA(1, 0, At, B0); PG8_MMA(1, 1, At, B1); PG8_BAR; PG8_SCHED;
            } else {
            PG8_LDB(B0, 0, 0); PG8_SCHED; PG8_LDA(At, 0, 0); PG8_STAGE_A(PG8_SA(1, 1), a1 + hstep, voffA);
            PG8_WAIT_L(8); PG8_BAR; PG8_WAIT_L(0); PG8_MMA(0, 0, At, B0); PG8_BAR; PG8_SCHED;
            PG8_LDB(B1, 0, 1); PG8_STAGE_B(PG8_SB(0, 0), b2, voffB);
            PG8_BAR; PG8_WAIT_L(0); PG8_MMA(0, 1, At, B1); PG8_BAR;
            PG8_LDA(At, 0, 1); PG8_STAGE_A(PG8_SA(0, 0), a2, voffA);
            PG8_BAR; PG8_WAIT_L(0); PG8_MMA(1, 0, At, B0); PG8_BAR; PG8_SCHED;
            PG8_STAGE_B(PG8_SB(0, 1), b2 + hstep, voffB);
            PG8_WAIT_V(6); PG8_BAR; PG8_MMA(1, 1, At, B1); PG8_BAR;
            PG8_LDB(B0, 1, 0); PG8_SCHED; PG8_LDA(At, 1, 0); PG8_STAGE_A(PG8_SA(0, 1), a2 + hstep, voffA);
            PG8_WAIT_L(8); PG8_BAR; PG8_WAIT_L(0); PG8_MMA(0, 0, At, B0); PG8_BAR; PG8_SCHED;
            PG8_LDB(B1, 1, 1); PG8_STAGE_B(PG8_SB(1, 0), b3, voffB);
            PG8_BAR; PG8_WAIT_L(0); PG8_MMA(0, 1, At, B1); PG8_BAR;
            PG8_LDA(At, 1, 1); PG8_STAGE_A(PG8_SA(1, 0), a3, voffA);
            PG8_BAR; PG8_WAIT_L(0); PG8_MMA(1, 0, At, B0); PG8_BAR; PG8_SCHED;
            PG8_STAGE_B(PG8_SB(1, 1), b3 + hstep, voffB);
            PG8_WAIT_V(6); PG8_BAR; PG8_MMA(1, 1, At, B1); PG8_BAR;
            }
        }
        if constexpr (ALIGN_EPI) { if (wr == 0) PG8_BAR; }
        if constexpr (!Epi::AFTER_DRAIN) { E(acc, cur, wr, wc, fr, fq); S.done(cur); }
        if (!has_next) break;
#pragma unroll
        for (int a = 0; a < 2; ++a)
#pragma unroll
            for (int b = 0; b < 2; ++b)
#pragma unroll
                for (int m = 0; m < 4; ++m)
#pragma unroll
                    for (int n = 0; n < 2; ++n) acc[a][b][m][n] = (f32x4){0.f, 0.f, 0.f, 0.f};
        cur = nxt; cA = nA; cB = nB; ++ui;
        if constexpr (ALIGN_EPI) { if (wr == 1) PG8_BAR; }
    }
    PG8_WAIT_V(0);
    if constexpr (!ALIGN_EPI) { if (wr == 0) PG8_BAR; }
    PG8_BAR;
    if constexpr (Epi::AFTER_DRAIN) { E.fused(acc, cur, wr, wc, fr, fq, lds, wid, lane); S.done(cur); }
#undef PG8_SA
#undef PG8_SB
#undef PG8_STAGE_X
#undef PG8_STAGE_A
#undef PG8_STAGE_B
#undef PG8_LDA
#undef PG8_LDB
#undef PG8_MMA
#undef PG8_WAIT_V
#undef PG8_WAIT_L
#undef PG8_BAR
#undef PG8_SCHED
}
}
#define GAS __attribute__((address_space(1)))
#define LAS __attribute__((address_space(3)))
typedef unsigned short bf16;
typedef unsigned v4u __attribute__((ext_vector_type(4)));
typedef float f32x4 __attribute__((ext_vector_type(4)));
typedef short bf16x8 __attribute__((ext_vector_type(8)));
typedef GAS unsigned gu32;
typedef GAS unsigned long long gu64;
#define RLX_AGENT __ATOMIC_RELAXED, __HIP_MEMORY_SCOPE_AGENT
#define LDS_WAIT() asm volatile("s_waitcnt lgkmcnt(0)" ::: "memory")
#define VM_WAIT() asm volatile("s_waitcnt vmcnt(0)" ::: "memory")
__device__ __forceinline__ unsigned long long rt() { return __builtin_amdgcn_s_memrealtime(); }
__device__ __forceinline__ unsigned f2bf(float f) { unsigned u = __builtin_bit_cast(unsigned, f); return (u + 0x7fffu + ((u >> 16) & 1u)) >> 16; }
__device__ __forceinline__ unsigned pk2(float lo, float hi) { return f2bf(lo) | (f2bf(hi) << 16); }

#define XB_TMO      128
#define XB_XCNT(j)  (256  + 64 * (j))
#define XB_XSUB(j)  (1280 + 64 * (j))
#define XB_XGEN(j)  (2304 + 64 * (j))
#define XB_TOP      3328
#define XB_TOPGEN   3392
#define XCD_BAR_WORDS 3456
#define GB_SUB(j)   (3456 + 64 * (j))
#define GB_GEN(j)   (3968 + 64 * (j))
#define GB_MASK(j)  (4480 + 64 * (j))
#define GB_WDONE    4992
#define GB_MDONE    5056
#define QB_SUB(j)   (5120 + 64 * (j))
#define QB_GEN(j)   (9216 + 64 * (j))
#define XB_SPIN_CAP (1u << 18)
#ifndef QSLEEP
#define QSLEEP 16
#endif

__device__ __forceinline__ unsigned xb_ld(unsigned* p)              { return __hip_atomic_load(p, __ATOMIC_RELAXED, __HIP_MEMORY_SCOPE_AGENT); }
__device__ __forceinline__ unsigned xb_add(unsigned* p, unsigned v) { return __hip_atomic_fetch_add(p, v, __ATOMIC_RELAXED, __HIP_MEMORY_SCOPE_AGENT); }
__device__ __forceinline__ unsigned xb_xcc_id() { return (unsigned)__builtin_amdgcn_s_getreg((3 << 11) | 20) & 0xFu; }
#define XB_SPIN(cond, bar) do { unsigned _sp = 0; while (cond) { __builtin_amdgcn_s_sleep(1); \
    if ((++_sp & 255u) == 0u) { if (xb_ld(&(bar)[XB_TMO])) break; if (_sp > XB_SPIN_CAP) { atomicAdd(&(bar)[XB_TMO], 1u); break; } } } } while (0)

struct XcdBarrier {
    unsigned* bar; unsigned x;
    volatile LAS unsigned* st;
};

__device__ __forceinline__ XcdBarrier xcd_barrier_post(unsigned* bar, volatile LAS unsigned* st) {
    XcdBarrier b; b.bar = bar; b.x = xb_xcc_id(); b.st = st;
    if (threadIdx.x == 0) (void)xb_add(&bar[XB_XCNT(b.x)], 1u);
    return b;
}
__device__ __forceinline__ void xcd_barrier_complete(unsigned* bar, unsigned x, unsigned& nloc, unsigned& nx) {
    const unsigned G = gridDim.x * gridDim.y * gridDim.z;
    unsigned sum, cnt, mine, sp = 0u;
    for (;;) {
        sum = 0u; cnt = 0u; mine = 0u;
#pragma unroll
        for (unsigned j = 0; j < 16; ++j) { const unsigned c = xb_ld(&bar[XB_XCNT(j)]); sum += c; cnt += (c > 0u) ? 1u : 0u; mine = (j == x) ? c : mine; }
        if (sum == G) break;
        __builtin_amdgcn_s_sleep(1);
        if ((++sp & 255u) == 0u) { if (xb_ld(&bar[XB_TMO])) break; if (sp > XB_SPIN_CAP) { atomicAdd(&bar[XB_TMO], 1u); break; } }
    }
    nloc = mine > 0u ? mine : 1u; nx = cnt > 0u ? cnt : 1u;
}

__device__ __forceinline__ void xcd_barrier(const XcdBarrier& b) {
    asm volatile("s_waitcnt vmcnt(0)" ::: "memory");
    __syncthreads();
    if (threadIdx.x == 0) {
        unsigned* bar = b.bar;
        __builtin_amdgcn_s_waitcnt(0);
        unsigned nloc = b.st[0], nx = b.st[1];
        if (nloc == 0u) { xcd_barrier_complete(bar, b.x, nloc, nx); b.st[0] = nloc; b.st[1] = nx; }
        const unsigned old = xb_add(&bar[XB_XSUB(b.x)], 1u);
        const unsigned gen = old / nloc;
        if (old + 1u == (gen + 1u) * nloc) {
            __builtin_amdgcn_fence(__ATOMIC_RELEASE, "agent");
            asm volatile("s_waitcnt vmcnt(0)" ::: "memory");
            const unsigned og = xb_add(&bar[XB_TOP], 1u);
            const unsigned tg = og / nx;
            if (og + 1u == (tg + 1u) * nx) xb_add(&bar[XB_TOPGEN], 1u);
            else XB_SPIN(xb_ld(&bar[XB_TOPGEN]) == tg, bar);
            __builtin_amdgcn_fence(__ATOMIC_ACQUIRE, "agent");
            xb_add(&bar[XB_XGEN(b.x)], 1u);
            asm volatile("s_waitcnt vmcnt(0)" ::: "memory");
        } else {
            XB_SPIN(xb_ld(&bar[XB_XGEN(b.x)]) == gen, bar);
            __builtin_amdgcn_fence(__ATOMIC_ACQUIRE, "agent");
            asm volatile("s_waitcnt vmcnt(0)" ::: "memory");
        }
    }
    __syncthreads();
}

__device__ __forceinline__ void grp_barrier(unsigned* bar, unsigned subw, unsigned genw, unsigned nloc, bool wb) {
    asm volatile("s_waitcnt vmcnt(0)" ::: "memory");
    __syncthreads();
    if (threadIdx.x == 0) {
        __builtin_amdgcn_s_waitcnt(0);
        if (wb) { __builtin_amdgcn_fence(__ATOMIC_RELEASE, "agent"); asm volatile("s_waitcnt vmcnt(0)" ::: "memory"); }
        const unsigned old = xb_add(&bar[subw], 1u);
        if (!wb) asm volatile("buffer_inv sc1" ::: "memory");
        const unsigned gen = old / nloc;
        if (old + 1u == (gen + 1u) * nloc) xb_add(&bar[genw], 1u);
        else XB_SPIN(xb_ld(&bar[genw]) == gen, bar);
        if (wb) __builtin_amdgcn_fence(__ATOMIC_ACQUIRE, "agent");
        asm volatile("s_waitcnt vmcnt(0)" ::: "memory");
    }
    __syncthreads();
}

#define FB_FLAG(v)  (16384 + 64 * (v))
__device__ __forceinline__ void flag_barrier(unsigned* bar, unsigned first, unsigned stride, unsigned n, unsigned me, volatile LAS unsigned* seqp, bool wb) {
    asm volatile("s_waitcnt vmcnt(0)" ::: "memory");
    __syncthreads();
    if (threadIdx.x < 64) {
        unsigned seq = 0u;
        if (threadIdx.x == 0) {
            __builtin_amdgcn_s_waitcnt(0);
            if (wb) { __builtin_amdgcn_fence(__ATOMIC_RELEASE, "agent"); asm volatile("s_waitcnt vmcnt(0)" ::: "memory"); }
            seq = seqp[0] + 1u; seqp[0] = seq;
            __hip_atomic_store(&bar[FB_FLAG(me)], seq, __ATOMIC_RELAXED, __HIP_MEMORY_SCOPE_AGENT);
            if (!wb) asm volatile("buffer_inv sc1" ::: "memory");
        }
        seq = (unsigned)__builtin_amdgcn_readfirstlane((int)seq);
        unsigned* fp = &bar[FB_FLAG(first + stride * (threadIdx.x < n ? threadIdx.x : 0u))];
        unsigned sp = 0u;
        for (;;) {
            const unsigned v = xb_ld(fp);
            if (!__builtin_amdgcn_ballot_w64(v < seq)) break;
            __builtin_amdgcn_s_sleep(1);
            if ((++sp & 255u) == 0u) { if (xb_ld(&bar[XB_TMO])) break; if (sp > XB_SPIN_CAP) { if (threadIdx.x == 0) atomicAdd(&bar[XB_TMO], 1u); break; } }
        }
        if (wb) __builtin_amdgcn_fence(__ATOMIC_ACQUIRE, "agent");
        asm volatile("s_waitcnt vmcnt(0)" ::: "memory");
    }
    __syncthreads();
}

constexpr int NWAVES = 8;
constexpr int BATCH = 16, SEQ = 2048, DM = 1024, DEPTH = 2, DFF = 2816, NGU = 2 * DFF, NPROJ = 3328, RWKV_IN = 1792, NLORA = 1536, KLORA = 256;
constexpr int M = BATCH * SEQ;
constexpr int RET_OFF = RWKV_IN;
constexpr float LN_X_EPS = 64e-5f;
constexpr size_t MiB = 1u << 20;
constexpr size_t WS_CTL = 0, CTL_ZERO_BYTES = 1 * MiB;
constexpr size_t SZ_WGU = (size_t)NGU * DM * 2, SZ_WD = (size_t)DM * DFF * 2, SZ_WIN = (size_t)NPROJ * DM * 2, SZ_WLORA = (size_t)NLORA * KLORA * 2, SZ_WOUT = (size_t)DM * DM * 2;
constexpr size_t OFF_WGU1 = 0, OFF_WD1 = OFF_WGU1 + SZ_WGU, OFF_WIN = OFF_WD1 + SZ_WD, OFF_WLORA = OFF_WIN + SZ_WIN, OFF_WOUT = OFF_WLORA + SZ_WLORA, OFF_WGU2 = OFF_WOUT + SZ_WOUT, OFF_WD2 = OFF_WGU2 + SZ_WGU, SZ_LAYER = OFF_WD2 + SZ_WD;
constexpr size_t WS_W = 1 * MiB;
constexpr size_t WS_TRIG = WS_W + DEPTH * SZ_LAYER;
constexpr size_t WS_SSQ = 86 * MiB;
constexpr size_t WS_XB = 90 * MiB;
constexpr size_t WS_SIDE = 186 * MiB;
constexpr size_t WS_DUMP = 192 * MiB;
constexpr size_t WS_ALORA = 154 * MiB;
constexpr size_t WS_MIXED = 218 * MiB;
constexpr size_t WS_H = 282 * MiB;
constexpr size_t WS_END = 490 * MiB;
static_assert(WS_TRIG + 2 * 2048 * 32 * 4 <= WS_SSQ && WS_SSQ + 2 * (size_t)M * 16 * 4 <= WS_XB && WS_XB + (size_t)M * DM * 2 <= WS_SIDE && (size_t)M * NLORA * 2 <= (size_t)M * DM * 4 && WS_H + (size_t)M * NPROJ * 2 <= WS_END, "d_ws map");
constexpr int CW_TMO = 0, CW_CODE = 1, CW_BAR = 4096;

constexpr int RING_OFF = 0, RING_BYTES = 131072;
constexpr int LDSCTL_OFF = 161792, MISC_OFF = LDSCTL_OFF + 320;
constexpr int EPI_TAB_OFF = 131072;
constexpr int LDS_BYTES = 163840;

__device__ __forceinline__ int opaque_bx() { int b = (int)blockIdx.x; asm volatile("" : "+s"(b)); return b; }
struct Frame {
    LAS unsigned char* lds;
    volatile LAS unsigned* MISC;
    int tid, lane, wave;
    int vcu, G;
    unsigned char* ws;
    unsigned char* lora;
};
struct LayerP {
    const float *mu, *w0, *a0, *k_k, *k_a, *r_k, *ln_w, *ln_b;
    const unsigned short* wlora;
};
__device__ __forceinline__ float bf_lo(unsigned u) { return __builtin_bit_cast(float, u << 16); }
__device__ __forceinline__ float bf_hi(unsigned u) { return __builtin_bit_cast(float, u & 0xffff0000u); }
typedef float f32x2_t __attribute__((ext_vector_type(2))); typedef __bf16 bf16x2_t __attribute__((ext_vector_type(2)));
__device__ __forceinline__ unsigned cvtpk(float lo, float hi) { f32x2_t v = {lo, hi}; bf16x2_t b = __builtin_convertvector(v, bf16x2_t); return __builtin_bit_cast(unsigned, b); }
__device__ __forceinline__ float wave_sum(float v) {
#pragma unroll
    for (int o = 1; o < 64; o <<= 1) v += __shfl_xor(v, o);
    return v;
}
template <int CTRL> __device__ __forceinline__ float dpp_f(float v) { return __builtin_bit_cast(float, __builtin_amdgcn_update_dpp(0, __builtin_bit_cast(int, v), CTRL, 0xF, 0xF, true)); }
__device__ __forceinline__ float sum8(float v) { v += dpp_f<0xB1>(v); v += dpp_f<0x4E>(v); v += dpp_f<0x141>(v); return v; }
__device__ __forceinline__ float sum16(float v) { v = sum8(v); v += dpp_f<0x140>(v); return v; }
__device__ __forceinline__ float sigm(float x) { return __builtin_amdgcn_rcpf(1.0f + __expf(-x)); }

constexpr int P0_SCR_BYTES = 64 * 65 * 4;
__device__ __forceinline__ void p0_transpose_item(const float* W, int K, int N, const float* gain, bf16* WT, int k0, int n0, int dst_row0, LAS float* scr, int lane) {
    const int n4 = (lane & 15) * 4, kr = lane >> 4;
#pragma unroll 8
    for (int i = 0; i < 16; ++i) { const int kk = 4 * i + kr; const float g = gain ? gain[k0 + kk] : 1.0f;
        const f32x4 v = *(const GAS f32x4*)(W + (size_t)(k0 + kk) * N + n0 + n4);
        LAS float* s = scr + kk * 65 + n4; s[0] = v.x * g; s[1] = v.y * g; s[2] = v.z * g; s[3] = v.w * g; }
    LDS_WAIT(); asm volatile("" ::: "memory");
    const int c = lane & 7;
#pragma unroll
    for (int j = 0; j < 8; ++j) { const int n = (lane >> 3) + 8 * j; const LAS float* s = scr + (8 * c) * 65 + n;
        v4u o; o.x = pk2(s[0 * 65], s[1 * 65]); o.y = pk2(s[2 * 65], s[3 * 65]); o.z = pk2(s[4 * 65], s[5 * 65]); o.w = pk2(s[6 * 65], s[7 * 65]);
        *(GAS v4u*)(WT + (size_t)(dst_row0 + n) * K + k0 + 8 * c) = o; }
    LDS_WAIT(); asm volatile("" ::: "memory");
}
struct Args { const float* in[24]; float* out; unsigned char* ws; int ph_lo, ph_hi; };
constexpr int ITEMS_FF = (DM / 64) * (DFF / 64), ITEMS_IN = (DM / 64) * (NPROJ / 64), ITEMS_OUT = (DM / 64) * (DM / 64);
constexpr int ITEMS_LAYER = 6 * ITEMS_FF + ITEMS_IN + ITEMS_OUT;
constexpr int ITEMS_EARLY = 2 * ITEMS_FF;
__device__ __forceinline__ void p0_weights(const Frame& F, const Args& A, int it_lo, int it_hi, int gw, int NGW) {
    LAS float* scr = (LAS float*)(F.lds + RING_OFF + F.wave * P0_SCR_BYTES);
    for (int it = it_lo + gw; it < it_hi; it += NGW) {
        const int l = it / ITEMS_LAYER; int r = it % ITEMS_LAYER;
        bf16* wl = (bf16*)(F.ws + WS_W + (size_t)l * SZ_LAYER);
        const float* W; const float* gain = nullptr; bf16* WT; int K, N, mode = 0;
        if (r < ITEMS_FF)            { W = A.in[2] + (size_t)l * DM * DFF; gain = A.in[1] + l * DM; WT = (bf16*)((unsigned char*)wl + OFF_WGU1); K = DM; N = DFF; mode = 1; }
        else if ((r -= ITEMS_FF) < ITEMS_FF)  { W = A.in[3] + (size_t)l * DM * DFF; gain = A.in[1] + l * DM; WT = (bf16*)((unsigned char*)wl + OFF_WGU1); K = DM; N = DFF; mode = 2; }
        else if ((r -= ITEMS_FF) < ITEMS_FF)  { W = A.in[4] + (size_t)l * DFF * DM; WT = (bf16*)((unsigned char*)wl + OFF_WD1); K = DFF; N = DM; }
        else if ((r -= ITEMS_FF) < ITEMS_IN)  { W = A.in[6] + (size_t)l * DM * NPROJ; gain = A.in[5] + l * DM; WT = (bf16*)((unsigned char*)wl + OFF_WIN); K = DM; N = NPROJ; }
        else if ((r -= ITEMS_IN) < ITEMS_OUT) { W = A.in[18] + (size_t)l * DM * DM; WT = (bf16*)((unsigned char*)wl + OFF_WOUT); K = DM; N = DM; }
        else if ((r -= ITEMS_OUT) < ITEMS_FF) { W = A.in[20] + (size_t)l * DM * DFF; gain = A.in[19] + l * DM; WT = (bf16*)((unsigned char*)wl + OFF_WGU2); K = DM; N = DFF; mode = 1; }
        else if ((r -= ITEMS_FF) < ITEMS_FF)  { W = A.in[21] + (size_t)l * DM * DFF; gain = A.in[19] + l * DM; WT = (bf16*)((unsigned char*)wl + OFF_WGU2); K = DM; N = DFF; mode = 2; }
        else { r -= ITEMS_FF;                   W = A.in[22] + (size_t)l * DFF * DM; WT = (bf16*)((unsigned char*)wl + OFF_WD2); K = DFF; N = DM; }
        const int nblk = N / 64, kb = r / nblk, nb = r % nblk, k0 = 64 * kb, n0 = 64 * nb;
        const int dst = mode == 0 ? n0 : ((n0 >> 7) * 256 + (n0 & 127) + (mode == 2 ? 128 : 0));
        p0_transpose_item(W, K, N, gain, WT, k0, n0, dst, scr, F.lane);
    }
}
__device__ __forceinline__ void p0_prologue(const Frame& F, const Args& A) {
    const int gw = F.vcu * NWAVES + F.wave, NGW = F.G * NWAVES;
    p0_weights(F, A, 0, F.G == 256 ? ITEMS_EARLY : DEPTH * ITEMS_LAYER, gw, NGW);
    const int gt = gw * 64 + F.lane, NGT = NGW * 64;
    for (int it = gt; it < DEPTH * NLORA * (KLORA / 8); it += NGT) {
        const int l = it / (NLORA * (KLORA / 8)), r = it % (NLORA * (KLORA / 8)), n = r >> 5, k8 = (r & 31) * 8;
        const int blk = n >> 9, nn = n & 511;
        const int klo = blk == 0 ? 0 : (blk == 1 ? 64 : 128), khi = blk == 0 ? 64 : (blk == 1 ? 128 : 256);
        const float* src = blk == 0 ? A.in[9] + (size_t)l * 64 * 512 : (blk == 1 ? A.in[11] + (size_t)l * 64 * 512 : A.in[12] + (size_t)l * 128 * 512);
        float v[8];
#pragma unroll
        for (int j = 0; j < 8; ++j) { const int k = k8 + j; v[j] = (k >= klo && k < khi) ? src[(size_t)(k - klo) * 512 + nn] : 0.0f; }
        v4u o; o.x = pk2(v[0], v[1]); o.y = pk2(v[2], v[3]); o.z = pk2(v[4], v[5]); o.w = pk2(v[6], v[7]);
        *(GAS v4u*)((bf16*)(F.ws + WS_W + (size_t)l * SZ_LAYER + OFF_WLORA) + (size_t)n * KLORA + k8) = o;
    }
    for (int it = gt; it < SEQ * 32; it += NGT) {
        const int pos = it >> 5, i = it & 31;
        const float x = (float)i * (1.0f / 31.0f);
        const float inv_freq = 1.0f / powf(10000.0f, x);
        const float ang = (float)pos * inv_freq;
        float sn, cs; sincosf(ang, &sn, &cs);
        ((float*)(F.ws + WS_TRIG))[it] = cs; ((float*)(F.ws + WS_TRIG))[SEQ * 32 + it] = sn;
    }
    const float* x = A.in[0]; bf16* xb = (bf16*)(F.ws + WS_XB); float* ssq = (float*)(F.ws + WS_SSQ);
    for (int m = gw; m < M; m += 4 * NGW) {
        f32x4 v[4][4]; int mr[4]; bool has[4];
#pragma unroll
        for (int r = 0; r < 4; ++r) { mr[r] = m + r * NGW; has[r] = mr[r] < M; if (!has[r]) mr[r] = m;
            const GAS f32x4* xr = (const GAS f32x4*)(x + (size_t)mr[r] * DM) + F.lane;
#pragma unroll
            for (int j = 0; j < 4; ++j) v[r][j] = xr[64 * j]; }
#pragma unroll
        for (int r = 0; r < 4; ++r) {
            GAS unsigned long long* o8 = (GAS unsigned long long*)(xb + (size_t)mr[r] * DM) + F.lane;
            float sq = 0.f;
#pragma unroll
            for (int j = 0; j < 4; ++j) { sq += (v[r][j].x * v[r][j].x + v[r][j].y * v[r][j].y) + (v[r][j].z * v[r][j].z + v[r][j].w * v[r][j].w);
                if (has[r]) o8[64 * j] = (unsigned long long)pk2(v[r][j].x, v[r][j].y) | ((unsigned long long)pk2(v[r][j].z, v[r][j].w) << 32); }
            sq = wave_sum(sq);
            if (has[r] && F.lane < 16) ssq[(size_t)mr[r] * 16 + F.lane] = (F.lane == 0) ? sq : 0.0f;
        }
    }
}
__device__ __forceinline__ void lora_prep(const Frame& F, const float* mu) {
    const bf16* proj = (const bf16*)(F.ws + WS_H); bf16* alora = (bf16*)(F.ws + WS_ALORA);
    const int gt = (F.vcu * NWAVES + F.wave) * 64 + F.lane, NGT = F.G * NWAVES * 64;
    for (int it = gt; it < M * 32; it += NGT) {
        const int m = it >> 5, c8 = (it & 31) * 8;
        const v4u pc = *(const GAS v4u*)(proj + (size_t)m * NPROJ + 1536 + c8);
        v4u pp = (v4u){0u, 0u, 0u, 0u};
        if ((m & (SEQ - 1)) != 0) pp = *(const GAS v4u*)(proj + (size_t)(m - 1) * NPROJ + 1536 + c8);
        const f32x4 m0 = *(const f32x4*)(mu + 1536 + c8), m1 = *(const f32x4*)(mu + 1536 + c8 + 4);
        float v[8];
#pragma unroll
        for (int j = 0; j < 4; ++j) { const unsigned a = pc[j], b = pp[j]; const float ml = j < 2 ? m0[2 * j] : m1[2 * j - 4], mh = j < 2 ? m0[2 * j + 1] : m1[2 * j - 3];
            const float cl = bf_lo(a), ch = bf_hi(a), pl = bf_lo(b), ph = bf_hi(b);
            v[2 * j] = cl + ml * (pl - cl); v[2 * j + 1] = ch + mh * (ph - ch); }
        if (c8 < 64) {
#pragma unroll
            for (int j = 0; j < 8; ++j) v[j] = 1.0f - 2.0f * __builtin_amdgcn_rcpf(1.0f + __expf(2.0f * v[j]));
        } else if (c8 >= 128) {
#pragma unroll
            for (int j = 0; j < 8; ++j) v[j] = sigm(v[j]);
        }
        v4u o; o.x = cvtpk(v[0], v[1]); o.y = cvtpk(v[2], v[3]); o.z = cvtpk(v[4], v[5]); o.w = cvtpk(v[6], v[7]);
        *(GAS v4u*)(alora + (size_t)m * KLORA + c8) = o;
    }
    bf16* side = (bf16*)(F.ws + WS_SIDE);
    for (int it = gt; it < (M / 16) * 192; it += NGT) {
        const int cidx = it / 192, c8 = (it % 192) * 8;
        *(GAS v4u*)(side + (size_t)cidx * 1536 + c8) = *(const GAS v4u*)(proj + ((size_t)cidx * 16 + 15) * NPROJ + c8);
    }
}
__device__ __forceinline__ void lora_prep_piece(const Frame& F, const float* mu, int m, int c8) {
    const bf16* proj = (const bf16*)(F.ws + WS_H); bf16* alora = (bf16*)(F.ws + WS_ALORA);
    const v4u pc = *(const GAS v4u*)(proj + (size_t)m * NPROJ + 1536 + c8);
    v4u pp = (v4u){0u, 0u, 0u, 0u};
    if ((m & (SEQ - 1)) != 0) pp = *(const GAS v4u*)(proj + (size_t)(m - 1) * NPROJ + 1536 + c8);
    const f32x4 m0 = *(const f32x4*)(mu + 1536 + c8), m1 = *(const f32x4*)(mu + 1536 + c8 + 4);
    float v[8];
#pragma unroll
    for (int j = 0; j < 4; ++j) { const unsigned a = pc[j], b = pp[j]; const float ml = j < 2 ? m0[2 * j] : m1[2 * j - 4], mh = j < 2 ? m0[2 * j + 1] : m1[2 * j - 3];
        const float cl = bf_lo(a), ch = bf_hi(a), pl = bf_lo(b), ph = bf_hi(b);
        v[2 * j] = cl + ml * (pl - cl); v[2 * j + 1] = ch + mh * (ph - ch); }
    if (c8 < 64) {
#pragma unroll
        for (int j = 0; j < 8; ++j) v[j] = 1.0f - 2.0f * __builtin_amdgcn_rcpf(1.0f + __expf(2.0f * v[j]));
    } else if (c8 >= 128) {
#pragma unroll
        for (int j = 0; j < 8; ++j) v[j] = sigm(v[j]);
    }
    v4u o; o.x = cvtpk(v[0], v[1]); o.y = cvtpk(v[2], v[3]); o.z = cvtpk(v[4], v[5]); o.w = cvtpk(v[6], v[7]);
    *(GAS v4u*)(alora + (size_t)m * KLORA + c8) = o;
}
__device__ __forceinline__ void lora_prep_panel(const Frame& F, const float* mu, int pm) {
    for (int it = F.tid; it < 256 * 32; it += NWAVES * 64) { const int r = it >> 5, m = pm * 256 + r;
        if (r == 0 && (m & (SEQ - 1)) != 0) continue;
        lora_prep_piece(F, mu, m, (it & 31) * 8); }
}
__device__ __forceinline__ void lora_prep_edges(const Frame& F, const float* mu, int n0) {
    if ((n0 & 15) == 0 && n0 != 0) { const int b = F.tid >> 5, m = b * SEQ + n0 * 16; lora_prep_piece(F, mu, m, (F.tid & 31) * 8); }
    asm volatile("s_waitcnt vmcnt(0)" ::: "memory");
    __syncthreads();
}
__device__ __forceinline__ void lora_prep_edges_grp(const Frame& F, const float* mu, int g, int q) {
    if (F.tid < 128) { const int e = F.tid >> 5, b = 2 * g + (e & 1), n = 32 * q + 16 * (e >> 1);
        if (n != 0) lora_prep_piece(F, mu, b * SEQ + n * 16, (F.tid & 31) * 8); }
    asm volatile("s_waitcnt vmcnt(0)" ::: "memory");
    __syncthreads();
}
constexpr int M1_PW = 14592;
constexpr int M1_EL = 0;
constexpr int M1_AT = 0, M1_BT = 2304, M1_KT = 4608, M1_RT = 6912;
constexpr int M1_TMP = 0, M1_SM = 2304, M1_AHT = 2304 + 8 * 1024;
constexpr int M1W_LD = 72, M1G_LD = 136;
constexpr int M1W_W = NWAVES * M1_PW, M1W_A = M1W_W + 64 * M1W_LD * 2, M1W_G = M1W_A + 64 * M1W_LD * 2, M1W_END = M1W_G + 64 * M1G_LD * 2;
constexpr int M1W_PRM = M1W_END;
static_assert(M1_AHT + 4096 == M1_PW && M1W_PRM + 8 * 64 * 4 <= LDSCTL_OFF && (M1W_W % 16) == 0 && (M1W_PRM % 16) == 0, "M1 LDS");
__device__ __forceinline__ float bfu(unsigned short x) { return __builtin_bit_cast(float, (unsigned)x << 16); }
__device__ __forceinline__ unsigned short bf1(float x) { return (unsigned short)(cvtpk(x, x) & 0xffffu); }
typedef unsigned u32x2_t __attribute__((ext_vector_type(2)));
__device__ __forceinline__ f32x4 bf4(u32x2_t u) { return (f32x4){bf_lo(u[0]), bf_hi(u[0]), bf_lo(u[1]), bf_hi(u[1])}; }
#define LBAR() do { asm volatile("s_waitcnt lgkmcnt(0)" ::: "memory"); __builtin_amdgcn_s_barrier(); asm volatile("" ::: "memory"); } while (0)
#define M1_WAIT() asm volatile("s_waitcnt lgkmcnt(0)" ::: "memory")
__device__ __forceinline__ bf16* slot_mix(const Frame& F, size_t m, int h) { return (bf16*)(F.ws + WS_MIXED) + m * DM + h * 64; }
__device__ __forceinline__ bf16* slot_lw(const Frame& F, size_t m, int h) { return (bf16*)(F.lora) + m * NLORA + h * 64; }
__device__ __forceinline__ bf16* slot_la(const Frame& F, size_t m, int h) { return (bf16*)(F.lora) + m * NLORA + 512 + h * 64; }
__device__ __forceinline__ bf16* slot_pr(const Frame& F, size_t m, int h) { return (bf16*)(F.ws + WS_H) + m * NPROJ + h * 64; }
__device__ __forceinline__ bf16* slot_pk(const Frame& F, size_t m, int h) { return (bf16*)(F.ws + WS_H) + m * NPROJ + 512 + h * 64; }
__device__ __forceinline__ bf16* slot_pv(const Frame& F, size_t m, int h) { return (bf16*)(F.ws + WS_H) + m * NPROJ + 1024 + h * 64; }
typedef short bf16x4 __attribute__((ext_vector_type(4)));
#define M2_K16(p) (*(const LAS bf16x4*)(p))
#define M2_MFMA16(a, b, c) __builtin_amdgcn_mfma_f32_16x16x16bf16_1k(a, b, c, 0, 0, 0)
#define M2_TR16(p) __builtin_amdgcn_ds_read_tr16_b64_v4i16((LAS bf16x4*)(p))
__device__ __forceinline__ bf16x4 m2_acc_op(const f32x4& d) { u32x2_t w_; w_[0] = cvtpk(d[0], d[1]); w_[1] = cvtpk(d[2], d[3]); return __builtin_bit_cast(bf16x4, w_); }
struct M1Alf { bf16x8 f[8]; };
__device__ __forceinline__ void m1_alf_issue(const Frame& F, int u, int lane, M1Alf& A) {
    const int n = u & 127, b = u >> 10; const size_t mb = (size_t)b * SEQ + n * 16;
    const bf16* AL = (const bf16*)(F.ws + WS_ALORA) + (mb + (lane & 15)) * KLORA + 8 * (lane >> 4);
#pragma unroll
    for (int ks = 0; ks < 8; ++ks) asm volatile("global_load_dwordx4 %0, %1, off" : "+v"(A.f[ks]) : "v"(AL + 32 * ks) : "memory");
}
#define M1_ALF_WAIT(A) asm volatile("s_waitcnt vmcnt(0)" : "+v"((A).f[0]), "+v"((A).f[1]), "+v"((A).f[2]), "+v"((A).f[3]), "+v"((A).f[4]), "+v"((A).f[5]), "+v"((A).f[6]), "+v"((A).f[7]) :: "memory")
__device__ __forceinline__ void rwkv_m1_unit(const Frame& F, const LayerP& L, int u, int u_next, M1Alf& ALF, LAS unsigned char* wl) {
    const int n = u & 127, h = (u >> 7) & 7, b = u >> 10;
    int ln_ = F.lane; asm volatile("" : "+v"(ln_));
    const int lane = ln_, lr = lane & 15, lq = lane >> 4, te = lane >> 2, c0 = (lane & 3) * 16, ch = h * 64 + c0;
    const size_t mb = (size_t)b * SEQ + n * 16, m = mb + te;
    const bf16* P = (const bf16*)(F.ws + WS_H) + m * NPROJ;
    const bool hasp = (te > 0) || (n > 0);
    const bf16* Pp = (te > 0) ? (P - NPROJ) : ((const bf16*)(F.ws + WS_SIDE) + ((size_t)b * 128 + (n > 0 ? n - 1 : 0)) * 1536);
    v4u rc[2], kc[2], vc[2], rp[2], kp[2], vp[2], lw[2], la[2];
#pragma unroll
    for (int hh = 0; hh < 2; ++hh) { rc[hh] = *(const GAS v4u*)(P + ch + 8 * hh); kc[hh] = *(const GAS v4u*)(P + 512 + ch + 8 * hh); vc[hh] = *(const GAS v4u*)(P + 1024 + ch + 8 * hh);
        rp[hh] = (v4u){0u, 0u, 0u, 0u}; kp[hh] = rp[hh]; vp[hh] = rp[hh];
        if (hasp) { rp[hh] = *(const GAS v4u*)(Pp + ch + 8 * hh); kp[hh] = *(const GAS v4u*)(Pp + 512 + ch + 8 * hh); vp[hh] = *(const GAS v4u*)(Pp + 1024 + ch + 8 * hh); } }
    {   bf16x8 alf[8];
#pragma unroll
        for (int ks = 0; ks < 8; ++ks) alf[ks] = ALF.f[ks];
        LAS bf16* WW = (LAS bf16*)(F.lds + M1W_W); LAS bf16* WA = (LAS bf16*)(F.lds + M1W_A); LAS bf16* WG = (LAS bf16*)(F.lds + M1W_G);
        LAS bf16* LWs = (LAS bf16*)(wl + M1_AT); LAS bf16* LAs = (LAS bf16*)(wl + M1_BT);
        const f32x4 z4l = (f32x4){0.f, 0.f, 0.f, 0.f};
#pragma unroll
        for (int ct = 0; ct < 4; ++ct) {
            f32x4 dw = z4l, da = z4l, dg = z4l;
#pragma unroll
            for (int ks = 0; ks < 2; ++ks) {
                dw = __builtin_amdgcn_mfma_f32_16x16x32_bf16(*(const LAS bf16x8*)(WW + (16 * ct + lr) * M1W_LD + 32 * ks + 8 * lq), alf[ks], dw, 0, 0, 0);
                da = __builtin_amdgcn_mfma_f32_16x16x32_bf16(*(const LAS bf16x8*)(WA + (16 * ct + lr) * M1W_LD + 32 * ks + 8 * lq), alf[2 + ks], da, 0, 0, 0); }
#pragma unroll
            for (int ks = 0; ks < 4; ++ks)
                dg = __builtin_amdgcn_mfma_f32_16x16x32_bf16(*(const LAS bf16x8*)(WG + (16 * ct + lr) * M1G_LD + 32 * ks + 8 * lq), alf[4 + ks], dg, 0, 0, 0);
            u32x2_t wv; wv[0] = cvtpk(dw[0], dw[1]); wv[1] = cvtpk(dw[2], dw[3]); *(LAS u32x2_t*)(LWs + lr * 72 + 16 * ct + 4 * lq) = wv;
            wv[0] = cvtpk(da[0], da[1]); wv[1] = cvtpk(da[2], da[3]); *(LAS u32x2_t*)(LAs + lr * 72 + 16 * ct + 4 * lq) = wv;
            wv[0] = cvtpk(dg[0], dg[1]); wv[1] = cvtpk(dg[2], dg[3]); *(GAS u32x2_t*)((bf16*)(F.lora) + (mb + lr) * NLORA + 1024 + h * 64 + 16 * ct + 4 * lq) = wv; }
        m1_alf_issue(F, u_next, lane, ALF);
        M1_WAIT();
#pragma unroll
        for (int hh = 0; hh < 2; ++hh) { lw[hh] = *(const LAS v4u*)(LWs + te * 72 + c0 + 8 * hh); la[hh] = *(const LAS v4u*)(LAs + te * 72 + c0 + 8 * hh); }
        M1_WAIT();
    }
    float r[16], kh[16], v[16], al[16], e[16], kraw[16]; float ss = 0.f, bs = 0.f;
#pragma unroll
    for (int q = 0; q < 4; ++q) { const int cc = ch + 4 * q; const int hh = q >> 1, w2 = (q & 1) * 2;
        const LAS float* PR = (const LAS float*)(F.lds + M1W_PRM) + c0 + 4 * q;
        const f32x4 mur = *(const LAS f32x4*)(PR), muk = *(const LAS f32x4*)(PR + 64), muv = *(const LAS f32x4*)(PR + 128), w0p = *(const LAS f32x4*)(PR + 192), a0p = *(const LAS f32x4*)(PR + 256);
        const f32x4 kkp = *(const LAS f32x4*)(PR + 320), kap = *(const LAS f32x4*)(PR + 384), rkp = *(const LAS f32x4*)(PR + 448);
#pragma unroll
        for (int j = 0; j < 4; ++j) { const int i = 4 * q + j; const unsigned sh = (j & 1) ? 0xffff0000u : 0u; const int wd = w2 + (j >> 1);
#define M1_BF(x) ((j & 1) ? bf_hi((x)[hh][wd]) : bf_lo((x)[hh][wd]))
            const float rcv = M1_BF(rc), kcv = M1_BF(kc), vcv = M1_BF(vc), rpv = M1_BF(rp), kpv = M1_BF(kp), vpv = M1_BF(vp), lwv = M1_BF(lw), lav = M1_BF(la);
#undef M1_BF
            (void)sh;
            r[i] = rcv + mur[j] * (rpv - rcv); const float ks = kcv + muk[j] * (kpv - kcv); v[i] = vcv + muv[j] * (vpv - vcv);
            al[i] = sigm(a0p[j] + lav); e[i] = 0.6065306597126334f * sigm(w0p[j] + lwv);
            kraw[i] = ks * kkp[j]; ss += kraw[i] * kraw[i];
            kh[i] = ks * (1.0f + (al[i] - 1.0f) * kap[j]); bs += r[i] * kh[i] * rkp[j]; } }
    ss += dpp_f<0xB1>(ss); ss += dpp_f<0x4E>(ss); bs += dpp_f<0xB1>(bs); bs += dpp_f<0x4E>(bs);
    const float inv = 1.0f / sqrtf(fmaxf(ss, 1e-24f));
    if ((lane & 3) == 0) ((GAS float*)slot_pv(F, mb + 14, h))[te] = bs;
    LAS float* EL = (LAS float*)(wl + M1_EL);
#pragma unroll
    for (int q = 0; q < 4; ++q) *(LAS f32x4*)(EL + te * 64 + c0 + 4 * q) = (f32x4){e[4 * q], e[4 * q + 1], e[4 * q + 2], e[4 * q + 3]};
    M1_WAIT();
    { float acc = 0.f;
#pragma unroll
      for (int t = 0; t < 16; ++t) { acc += EL[t * 64 + lane]; EL[t * 64 + lane] = acc; }
      ((GAS float*)slot_pv(F, mb + 12 + (lane >> 5), h))[lane & 31] = __expf(-acc); }
    M1_WAIT();
    float Lt[16], LC[16];
#pragma unroll
    for (int q = 0; q < 4; ++q) { const f32x4 a4 = *(const LAS f32x4*)(EL + te * 64 + c0 + 4 * q), b4 = *(const LAS f32x4*)(EL + 15 * 64 + c0 + 4 * q);
#pragma unroll
        for (int j = 0; j < 4; ++j) { Lt[4 * q + j] = a4[j]; LC[4 * q + j] = b4[j]; } }
    M1_WAIT();
    unsigned pat[8], pbt[8], pkt[8], prt[8], pbh[8], pkh[8], pv[8];
#pragma unroll
    for (int i2 = 0; i2 < 8; ++i2) { float at2[2], bt2[2], kt2[2], rt2[2], bh2[2], kh2[2];
#pragma unroll
        for (int s = 0; s < 2; ++s) { const int i = 2 * i2 + s; const float x1 = __expf(Lt[i]), x1i = __builtin_amdgcn_rcpf(x1), xm1 = x1i * __expf(e[i]), xc = __expf(Lt[i] - LC[i]);
            const float kn = kraw[i] * inv, ba = kn * al[i];
            at2[s] = -kn * xm1; bt2[s] = ba * x1; kt2[s] = kh[i] * x1; rt2[s] = r[i] * x1i; bh2[s] = ba * xc; kh2[s] = kh[i] * xc; }
        pat[i2] = cvtpk(at2[0], at2[1]); pbt[i2] = cvtpk(bt2[0], bt2[1]); pkt[i2] = cvtpk(kt2[0], kt2[1]); prt[i2] = cvtpk(rt2[0], rt2[1]);
        pbh[i2] = cvtpk(bh2[0], bh2[1]); pkh[i2] = cvtpk(kh2[0], kh2[1]); pv[i2] = cvtpk(v[2 * i2], v[2 * i2 + 1]); }
    LAS bf16* AT = (LAS bf16*)(wl + M1_AT); LAS bf16* BT = (LAS bf16*)(wl + M1_BT); LAS bf16* KT = (LAS bf16*)(wl + M1_KT); LAS bf16* RT = (LAS bf16*)(wl + M1_RT);
#pragma unroll
    for (int hh = 0; hh < 2; ++hh) {
        *(LAS v4u*)(AT + te * 72 + c0 + 8 * hh) = (v4u){pat[4 * hh], pat[4 * hh + 1], pat[4 * hh + 2], pat[4 * hh + 3]};
        *(LAS v4u*)(BT + te * 72 + c0 + 8 * hh) = (v4u){pbt[4 * hh], pbt[4 * hh + 1], pbt[4 * hh + 2], pbt[4 * hh + 3]};
        *(LAS v4u*)(KT + te * 72 + c0 + 8 * hh) = (v4u){pkt[4 * hh], pkt[4 * hh + 1], pkt[4 * hh + 2], pkt[4 * hh + 3]};
        const v4u rr = (v4u){prt[4 * hh], prt[4 * hh + 1], prt[4 * hh + 2], prt[4 * hh + 3]};
        *(LAS v4u*)(RT + te * 72 + c0 + 8 * hh) = rr; *(GAS v4u*)(slot_lw(F, m, h) + c0 + 8 * hh) = rr; }
    M1_WAIT();
    const bf16x8 at0 = *(const LAS bf16x8*)(AT + lr * 72 + 8 * lq), at1 = *(const LAS bf16x8*)(AT + lr * 72 + 32 + 8 * lq);
    const bf16x8 b0 = *(const LAS bf16x8*)(BT + lr * 72 + 8 * lq), b1 = *(const LAS bf16x8*)(BT + lr * 72 + 32 + 8 * lq);
    const bf16x8 k0 = *(const LAS bf16x8*)(KT + lr * 72 + 8 * lq), k1 = *(const LAS bf16x8*)(KT + lr * 72 + 32 + 8 * lq);
    const bf16x8 r0 = *(const LAS bf16x8*)(RT + lr * 72 + 8 * lq), r1 = *(const LAS bf16x8*)(RT + lr * 72 + 32 + 8 * lq);
    M1_WAIT();
    const f32x4 z4 = (f32x4){0.f, 0.f, 0.f, 0.f};
    f32x4 dL = z4, dLt = z4, dKt = z4, dRb = z4, dRk = z4;
    dL = __builtin_amdgcn_mfma_f32_16x16x32_bf16(b0, at0, dL, 0, 0, 0); dL = __builtin_amdgcn_mfma_f32_16x16x32_bf16(b1, at1, dL, 0, 0, 0);
    dLt = __builtin_amdgcn_mfma_f32_16x16x32_bf16(at0, b0, dLt, 0, 0, 0); dLt = __builtin_amdgcn_mfma_f32_16x16x32_bf16(at1, b1, dLt, 0, 0, 0);
    dKt = __builtin_amdgcn_mfma_f32_16x16x32_bf16(at0, k0, dKt, 0, 0, 0); dKt = __builtin_amdgcn_mfma_f32_16x16x32_bf16(at1, k1, dKt, 0, 0, 0);
    dRb = __builtin_amdgcn_mfma_f32_16x16x32_bf16(b0, r0, dRb, 0, 0, 0); dRb = __builtin_amdgcn_mfma_f32_16x16x32_bf16(b1, r1, dRb, 0, 0, 0);
    dRk = __builtin_amdgcn_mfma_f32_16x16x32_bf16(k0, r0, dRk, 0, 0, 0); dRk = __builtin_amdgcn_mfma_f32_16x16x32_bf16(k1, r1, dRk, 0, 0, 0);
    f32x4 eye;
#pragma unroll
    for (int i = 0; i < 4; ++i) { const int rr = 4 * lq + i; eye[i] = (rr == lr) ? 1.0f : 0.0f;
        dL[i] = (rr < lr) ? dL[i] : 0.f; dLt[i] = (lr < rr) ? dLt[i] : 0.f; dKt[i] = (lr < rr) ? dKt[i] : 0.f; dRb[i] = (rr <= lr) ? dRb[i] : 0.f; dRk[i] = (rr <= lr) ? dRk[i] : 0.f; }
    {
        u32x2_t wv; wv[0] = cvtpk(dRb[0], dRb[1]); wv[1] = cvtpk(dRb[2], dRb[3]); *(GAS u32x2_t*)(slot_pv(F, mb + 4 + (lr >> 2), h) + (lr & 3) * 16 + 4 * lq) = wv;
        wv[0] = cvtpk(dRk[0], dRk[1]); wv[1] = cvtpk(dRk[2], dRk[3]); *(GAS u32x2_t*)(slot_pv(F, mb + 8 + (lr >> 2), h) + (lr & 3) * 16 + 4 * lq) = wv; }
#pragma unroll
    for (int hh = 0; hh < 2; ++hh) {
        *(GAS v4u*)(slot_pr(F, m, h) + c0 + 8 * hh) = (v4u){pbh[4 * hh], pbh[4 * hh + 1], pbh[4 * hh + 2], pbh[4 * hh + 3]};
        *(GAS v4u*)(slot_pk(F, m, h) + c0 + 8 * hh) = (v4u){pkh[4 * hh], pkh[4 * hh + 1], pkh[4 * hh + 2], pkh[4 * hh + 3]};
        *(GAS v4u*)(slot_la(F, m, h) + c0 + 8 * hh) = (v4u){pv[4 * hh], pv[4 * hh + 1], pv[4 * hh + 2], pv[4 * hh + 3]}; }
    {
        const bf16x4 fL = m2_acc_op(dL), fLt = m2_acc_op(dLt);
        const f32x4 z4b = (f32x4){0.f, 0.f, 0.f, 0.f};
        const f32x4 dL2 = M2_MFMA16(fL, fLt, z4b), dL2t = M2_MFMA16(fLt, fL, z4b);
        f32x4 dTt = dL + eye;
        const bf16x4 fL2t = m2_acc_op(dL2), fL2 = m2_acc_op(dL2t);
        dTt = M2_MFMA16(fL2t, m2_acc_op(dTt), dTt);
        const f32x4 dL4 = M2_MFMA16(fL2, fL2t, z4b), dL4t = M2_MFMA16(fL2t, fL2, z4b);
        const bf16x4 fL4t = m2_acc_op(dL4), fL4 = m2_acc_op(dL4t);
        dTt = M2_MFMA16(fL4t, m2_acc_op(dTt), dTt);
        const f32x4 dL8 = M2_MFMA16(fL4, fL4t, z4b);
        dTt = M2_MFMA16(m2_acc_op(dL8), m2_acc_op(dTt), dTt);
        const bf16x4 tq = m2_acc_op(dTt);
        const f32x4 nn = M2_MFMA16(m2_acc_op(dKt), tq, z4b);
        u32x2_t wv; wv[0] = cvtpk(nn[0], nn[1]); wv[1] = cvtpk(nn[2], nn[3]); *(GAS u32x2_t*)(slot_pv(F, mb + (lr >> 2), h) + (lr & 3) * 16 + 4 * lq) = wv;
#pragma unroll
        for (int tc = 0; tc < 4; ++tc) { const bf16x4 ah = __builtin_amdgcn_ds_read_tr16_b64_v4i16((LAS bf16x4*)(AT + (4 * lq + (lr >> 2)) * 72 + 16 * tc + 4 * (lr & 3)));
            const f32x4 pq = M2_MFMA16(ah, tq, z4b);
            wv[0] = cvtpk(pq[0], pq[1]); wv[1] = cvtpk(pq[2], pq[3]); *(GAS u32x2_t*)(slot_mix(F, mb + lr, h) + 16 * tc + 4 * lq) = wv; }
    }
    M1_WAIT();
    M1_ALF_WAIT(ALF);
}

__device__ __forceinline__ void rwkv_m1_phase(const Frame& F, const LayerP& L) {
    LAS unsigned char* wl = F.lds + RING_OFF + F.wave * M1_PW;
    const int NGW = F.G * NWAVES; int hcur = -1;
    const bool GL = (F.G == 256); const int grp = F.vcu >> 5, li = F.vcu & 31;
    if (GL) lora_prep_edges_grp(F, L.mu, grp, li & 3);
    M1Alf ALF;
#pragma unroll
    for (int ks = 0; ks < 8; ++ks) ALF.f[ks] = (bf16x8){0, 0, 0, 0, 0, 0, 0, 0};
    {   int ul_ = F.lane; asm volatile("" : "+v"(ul_));
        const int uf = (GL ? (((2 * grp) << 10) | ((li >> 2) << 7) | (32 * (li & 3))) : F.vcu * NWAVES) + F.wave;
        m1_alf_issue(F, uf < BATCH * 8 * 128 ? uf : 0, ul_, ALF); M1_ALF_WAIT(ALF); }
    for (int r = 0;; ++r) {
        const int u0 = GL ? (((2 * grp + (r & 1)) << 10) | ((li >> 2) << 7) | (32 * (li & 3) + 8 * (r >> 1))) : F.vcu * NWAVES + r * NGW;
        if (GL ? (r >= 8) : (u0 >= BATCH * 8 * 128)) break;
        const int h = (u0 >> 7) & 7;
        if (h != hcur) {
            if (hcur >= 0) __syncthreads();
            const bf16* W = L.wlora; const int t = F.tid, row = t >> 3, pc = (t & 7) * 8;
            *(LAS v4u*)(F.lds + M1W_W + (row * M1W_LD + pc) * 2) = *(const GAS v4u*)(W + (size_t)(h * 64 + row) * KLORA + pc);
            *(LAS v4u*)(F.lds + M1W_A + (row * M1W_LD + pc) * 2) = *(const GAS v4u*)(W + (size_t)(512 + h * 64 + row) * KLORA + 64 + pc);
#pragma unroll
            for (int j = 0; j < 2; ++j) *(LAS v4u*)(F.lds + M1W_G + (row * M1G_LD + 64 * j + pc) * 2) = *(const GAS v4u*)(W + (size_t)(1024 + h * 64 + row) * KLORA + 128 + 64 * j + pc);
            if (t < 128) { const int pr = t >> 4, c4 = (t & 15) * 4;
                const float* src = pr == 0 ? L.mu : (pr == 1 ? L.mu + 512 : (pr == 2 ? L.mu + 1024 : (pr == 3 ? L.w0 : (pr == 4 ? L.a0 : (pr == 5 ? L.k_k : (pr == 6 ? L.k_a : L.r_k))))));
                *(LAS f32x4*)((LAS float*)(F.lds + M1W_PRM) + pr * 64 + c4) = *(const f32x4*)(src + h * 64 + c4); }
            __syncthreads(); hcur = h; }
        const int u = u0 + F.wave;
        int un = GL ? ((((2 * grp + ((r + 1) & 1)) << 10) | ((li >> 2) << 7) | (32 * (li & 3) + 8 * ((r + 1) >> 1))) + F.wave) : u + NGW;
        if (GL ? (r + 1 >= 8) : (un >= BATCH * 8 * 128)) un = u;
        if (u < BATCH * 8 * 128) rwkv_m1_unit(F, L, u, un, ALF, wl);
    }
}
constexpr int S2_PM = 0, S2_NM = S2_PM + 2304, S2_RT = S2_NM + 1280, S2_MRB = S2_RT + 2304, S2_MRK = S2_MRB + 1280, S2_BH = S2_MRK + 1280, S2_KH = S2_BH + 2560, S2_VS = S2_KH + 2560,
              S2_GC = S2_VS + 2560, S2_RK = S2_GC + 256, S2_SET = S2_RK + 64;
constexpr int S2_SAT = 3 * S2_SET, S2_S = S2_SAT + 5120, S2_YB = S2_S + 2 * 9216, S2_PRM = S2_YB + 2 * 4352, S2_END = S2_PRM + 512;
static_assert(S2_END <= RING_BYTES && (S2_SET % 16) == 0 && (S2_S % 16) == 0 && (S2_YB % 16) == 0, "M2 LDS");
struct M2Raw { v4u a, b, c; };
struct M2Ptr { const bf16 *pa, *pb, *pc; };
__device__ __forceinline__ void m2_ptr0(const Frame& F, int b, int h, int i, M2Ptr& P) {
    const size_t mb = (size_t)b * SEQ; const int i7 = i & 127, row = i7 >> 3, chk = i7 & 7;
    P.pa = (i < 128 ? slot_mix(F, mb + row, h) : slot_lw(F, mb + row, h)) + chk * 8;
    P.pb = (i < 128 ? slot_la(F, mb + row, h) : slot_pr(F, mb + row, h)) + chk * 8;
    const int k1 = i - 128, k2 = i - 224, k3 = i - 240;
    const int tok = i < 128 ? row : (i < 224 ? (k1 >> 3) : (i < 240 ? 12 + (k2 >> 3) : 14));
    const int col = i < 128 ? 512 + chk * 8 : 1024 + (i < 224 ? (k1 & 7) : (i < 240 ? (k2 & 7) : (k3 & 3))) * 8;
    P.pc = (const bf16*)(F.ws + WS_H) + (mb + tok) * NPROJ + h * 64 + col;
}
__device__ __forceinline__ void m2_adv(M2Ptr& P, int i) { P.pa += (i < 128 ? 16 * DM : 16 * NLORA); P.pb += (i < 128 ? 16 * NLORA : 16 * NPROJ); P.pc += 16 * NPROJ; }
__device__ __forceinline__ void m2_load(const M2Ptr& P, M2Raw& R) {
    asm volatile("global_load_dwordx4 %0, %1, off" : "+v"(R.a) : "v"(P.pa) : "memory");
    asm volatile("global_load_dwordx4 %0, %1, off" : "+v"(R.b) : "v"(P.pb) : "memory");
    asm volatile("global_load_dwordx4 %0, %1, off" : "+v"(R.c) : "v"(P.pc) : "memory");
}
#define M2_WAIT_R(R, N) asm volatile("s_waitcnt vmcnt(" #N ")" : "+v"((R).a), "+v"((R).b), "+v"((R).c) :: "memory")
#define M2_WAIT_G(G, N) asm volatile("s_waitcnt vmcnt(" #N ")" : "+v"(G) :: "memory")
__device__ __forceinline__ void g_load(const bf16* p, u32x2_t& G) { asm volatile("global_load_dwordx2 %0, %1, off" : "+v"(G) : "v"(p) : "memory"); }
struct M2Off { int a, b, c; };
__device__ __forceinline__ void m2_off(int i, M2Off& O) {
    const int i7 = i & 127, row = i7 >> 3, chk = i7 & 7;
    O.a = (i < 128 ? S2_PM : S2_RT) + (row * 72 + chk * 8) * 2;
    O.b = (i < 128 ? S2_VS : S2_BH) + (row * 80 + chk * 8) * 2;
    int c = -1;
    if (i < 128) c = S2_KH + (row * 80 + chk * 8) * 2;
    else if (i < 224) { const int k = i - 128, mat = k >> 5, kk = k & 31, t = kk >> 1, hf = kk & 1;
        c = (mat == 0 ? S2_NM : (mat == 1 ? S2_MRB : S2_MRK)) + (t * 40 + hf * 8) * 2; }
    else if (i < 240) c = S2_GC + (i - 224) * 16;
    else if (i < 244) c = S2_RK + (i - 240) * 16;
    O.c = c;
}
__device__ __forceinline__ void m2_store(LAS unsigned char* set, const M2Off& O, const M2Raw& R) {
    *(LAS v4u*)(set + O.a) = R.a; *(LAS v4u*)(set + O.b) = R.b;
    if (O.c >= 0) *(LAS v4u*)(set + O.c) = R.c;
}
#define M2_LDR_ITER(RSET, GSET) \
    { \
        const int pt = tl_ & 255, te = pt >> 4, c4 = (pt & 15) * 4; \
        { \
            LAS unsigned char* SP = lds + ((n + 2) % 3) * S2_SET; \
            const LAS float* PRM = (const LAS float*)(lds + S2_PRM) + c4; \
            const u32x2_t vraw = *(const LAS u32x2_t*)((const LAS bf16*)(SP + S2_VS) + te * 80 + c4); \
            const f32x4 y = *(const LAS f32x4*)((LAS float*)(lds + S2_YB) + ((n + 1) & 1) * 1088 + te * 68 + c4); \
            const f32x4 lnw = *(const LAS f32x4*)(PRM), lnb = *(const LAS f32x4*)(PRM + 64); \
            const f32x4 vv = bf4(vraw); \
            const float bonus = ((const LAS float*)(SP + S2_RK))[te]; \
            __builtin_amdgcn_sched_barrier(0); \
            float s1 = (y[0] + y[1]) + (y[2] + y[3]), s2 = (y[0] * y[0] + y[1] * y[1]) + (y[2] * y[2] + y[3] * y[3]);        \
            s1 += dpp_f<0xB1>(s1); s2 += dpp_f<0xB1>(s2); s1 += dpp_f<0x4E>(s1); s2 += dpp_f<0x4E>(s2); s1 += dpp_f<0x141>(s1); s2 += dpp_f<0x141>(s2); s1 += dpp_f<0x140>(s1); s2 += dpp_f<0x140>(s2); \
            const float mean = s1 * (1.0f / 64.0f), var = fmaxf(s2 * (1.0f / 64.0f) - mean * mean, 0.0f); \
            const f32x4 d = y - mean; \
            const float rstd = __builtin_amdgcn_rsqf(var + LN_X_EPS); \
            M2_WAIT_G(GSET, 18); \
            const f32x4 o = (d * rstd * lnw + lnb + vv * bonus) * bf4(GSET); \
            u32x2_t wv; wv[0] = cvtpk(o[0], o[1]); wv[1] = cvtpk(o[2], o[3]); \
            const bool live = n >= 1 && n <= NCH;                                     \
            GAS u32x2_t* dst = live ? (GAS u32x2_t*)(op) : (GAS u32x2_t*)(dump); \
            *dst = wv; \
            if (live) op += 16 * DM; \
            g_load(gq, GSET); if (n + 4 < NCH) gq += 16 * NLORA; \
        } \
        M2_WAIT_R(RSET, 17); \
        if (n + 1 < NCH) m2_store(lds + ((n + 1) % 3) * S2_SET, OFF, RSET); \
        m2_load(P, RSET); if (n + 6 < NCH) m2_adv(P, pt); \
        LBAR(); \
    }
#define M2_ST_ITER() \
    { \
        const int lane = tl_ & 63, lr = lane & 15, lq = lane >> 4, q = w - 4; \
        if (n < NCH) { \
            LAS unsigned char* SC = lds + (n % 3) * S2_SET; \
            LAS bf16* PM = (LAS bf16*)(SC + S2_PM); LAS bf16* NM = (LAS bf16*)(SC + S2_NM); LAS bf16* VS = (LAS bf16*)(SC + S2_VS); LAS bf16* RT = (LAS bf16*)(SC + S2_RT); \
            LAS bf16* MRB = (LAS bf16*)(SC + S2_MRB); LAS bf16* MRK = (LAS bf16*)(SC + S2_MRK); LAS bf16* BH = (LAS bf16*)(SC + S2_BH); LAS bf16* KH = (LAS bf16*)(SC + S2_KH); \
            const int trow = (4 * lq + (lr >> 2)) * 80 + 4 * (lr & 3);                  \
            bf16x4 pf[4], rf[4], bhf[4], khf[4]; f32x4 gc[4]; \
            _Pragma("unroll") \
            for (int kt = 0; kt < 4; ++kt) { pf[kt] = M2_K16(PM + lr * 72 + 16 * kt + 4 * lq); rf[kt] = M2_K16(RT + lr * 72 + 16 * kt + 4 * lq); \
                bhf[kt] = M2_TR16(BH + trow + 16 * kt); khf[kt] = M2_TR16(KH + trow + 16 * kt); \
                gc[kt] = *(const LAS f32x4*)((LAS float*)(SC + S2_GC) + 16 * kt + 4 * lq); } \
            const bf16x4 nf = M2_K16(NM + lr * 40 + 4 * lq), mbf = M2_K16(MRB + lr * 40 + 4 * lq), mkf = M2_K16(MRK + lr * 40 + 4 * lq), vf = M2_TR16(VS + trow + 16 * q); \
            __builtin_amdgcn_sched_barrier(0); \
            bf16x4 so[4]; \
            _Pragma("unroll") \
            for (int kt = 0; kt < 4; ++kt) so[kt] = m2_acc_op(accS[kt]); \
            const f32x4 z4_ = (f32x4){0.f, 0.f, 0.f, 0.f}; \
            f32x4 sa = M2_MFMA16(nf, vf, z4_), sb = z4_, ya = M2_MFMA16(mkf, vf, z4_), yb = z4_; \
            sa = M2_MFMA16(pf[0], so[0], sa); sb = M2_MFMA16(pf[1], so[1], sb); sa = M2_MFMA16(pf[2], so[2], sa); sb = M2_MFMA16(pf[3], so[3], sb); \
            ya = M2_MFMA16(rf[0], so[0], ya); yb = M2_MFMA16(rf[1], so[1], yb); ya = M2_MFMA16(rf[2], so[2], ya); yb = M2_MFMA16(rf[3], so[3], yb); \
            sa = sa + sb; \
            const bf16x4 sao = m2_acc_op(sa); \
            ya = M2_MFMA16(mbf, sao, ya); \
            _Pragma("unroll") \
            for (int kt = 0; kt < 4; ++kt) { accS[kt] = accS[kt] * gc[kt]; accS[kt] = M2_MFMA16(bhf[kt], sao, accS[kt]); accS[kt] = M2_MFMA16(khf[kt], vf, accS[kt]); } \
            ya = ya + yb;                                                            \
            LAS float* YBs = (LAS float*)(lds + S2_YB) + (n & 1) * 1088 + 16 * q + lr; \
            _Pragma("unroll") \
            for (int i = 0; i < 4; ++i) YBs[(4 * lq + i) * 68] = ya[i]; \
        } \
        LBAR(); \
    }
__device__ __forceinline__ void rwkv_m2_unit(const Frame& F, const LayerP& L, int unit) {
    const int b = unit >> 3, h = unit & 7;
    LAS unsigned char* lds = F.lds + RING_OFF;
    const int tid = F.tid, w = F.wave;
    const bool ldr = w < 4;
    constexpr int NCH = SEQ / 16;
    int tl_ = tid; asm volatile("" : "+v"(tl_));
    for (int i = tid; i < S2_PRM / 4; i += NWAVES * 64) ((LAS unsigned*)lds)[i] = 0u;
    if (tid < 32) { const int row = tid >> 4, c = (tid & 15) * 4; *(LAS f32x4*)((LAS float*)(lds + S2_PRM) + row * 64 + c) = *(const f32x4*)((row == 0 ? L.ln_w : L.ln_b) + h * 64 + c); }
    __syncthreads();
    if (ldr) {
        M2Raw R0, R1, R2, R3; R0.a = (v4u){0u, 0u, 0u, 0u}; R0.b = R0.a; R0.c = R0.a; R1 = R0; R2 = R0; R3 = R0;
        u32x2_t G0 = (u32x2_t){0u, 0u}, G1 = G0, G2 = G0, G3 = G0;
        const int pt = tid, te = pt >> 4, c4 = (pt & 15) * 4, ch = h * 64 + c4;
        M2Ptr P; m2_ptr0(F, b, h, pt, P);
        M2Off OFF; m2_off(pt, OFF);
        { M2Raw T = R0; m2_load(P, T); m2_adv(P, pt); M2_WAIT_R(T, 0); m2_store(lds, OFF, T); }
        const bf16* gq = (const bf16*)(F.lora) + ((size_t)b * SEQ + te) * NLORA + 1024 + ch;
        bf16* op = (bf16*)(F.ws + WS_MIXED) + ((size_t)b * SEQ + te) * DM + ch;
        bf16* dump = (bf16*)(F.ws + WS_DUMP) + ((size_t)F.vcu * 256 + pt) * 4;
#define M2_FILL(RSET, GSET, GADV) { *(GAS u32x2_t*)dump = (u32x2_t){0u, 0u}; g_load(gq, GSET); if (GADV) gq += 16 * NLORA; m2_load(P, RSET); m2_adv(P, pt); }
        M2_FILL(R1, G3, false) M2_FILL(R2, G0, true) M2_FILL(R3, G1, true) M2_FILL(R0, G2, true)
#undef M2_FILL
        __syncthreads();
        for (int n0 = 0; n0 <= NCH; n0 += 4) {
            { const int n = n0;     M2_LDR_ITER(R1, G3) }
            { const int n = n0 + 1; M2_LDR_ITER(R2, G0) }
            { const int n = n0 + 2; M2_LDR_ITER(R3, G1) }
            { const int n = n0 + 3; M2_LDR_ITER(R0, G2) }
        }
        asm volatile("s_waitcnt vmcnt(0)" ::: "memory");
    } else {
        f32x4 accS[4];
#pragma unroll
        for (int q = 0; q < 4; ++q) accS[q] = (f32x4){0.f, 0.f, 0.f, 0.f};
        __syncthreads();
        for (int n0 = 0; n0 <= NCH; n0 += 4) {
            { const int n = n0;     M2_ST_ITER() }
            { const int n = n0 + 1; M2_ST_ITER() }
            { const int n = n0 + 2; M2_ST_ITER() }
            { const int n = n0 + 3; M2_ST_ITER() }
        }
    }
    __syncthreads();
}
constexpr int RT_LD = 72, RT_K2LD = 80, RT_VLD = 144, RT_OLD = 132;
constexpr int RT_QS = 0, RT_KS = RT_QS + 64 * RT_LD * 2, RT_K2 = RT_KS + 64 * RT_LD * 2, RT_SC = RT_K2 + 64 * RT_K2LD * 2, RT_VS = RT_SC + 64 * RT_LD * 2, RT_PT = RT_VS + 64 * RT_VLD * 2,
              RT_OB = RT_PT + 128 * RT_LD * 2, RT_END = RT_OB + 64 * RT_OLD * 4;
static_assert(RT_END <= RING_BYTES && (RT_K2 % 16) == 0 && (RT_VS % 16) == 0 && (RT_OB % 16) == 0, "retention LDS");
typedef unsigned ret_u2 __attribute__((ext_vector_type(2)));
typedef short ret_s4 __attribute__((ext_vector_type(4)));
struct RetA { ret_u2 q1, q2, k1, k2; v4u va, vb; f32x4 cs, sn; };
struct RetG { v4u ga, gb; };
#define RET_LD2(dst, ptr) asm volatile("global_load_dwordx2 %0, %1, off" : "+v"(dst) : "v"(ptr) : "memory")
#define RET_LD4(dst, ptr) asm volatile("global_load_dwordx4 %0, %1, off" : "+v"(dst) : "v"(ptr) : "memory")
__device__ __forceinline__ void ret_load_a(const bf16* P, const float* CS, const float* SN, int h, int dq, RetA& R) {
    const int d = dq * 4, e0 = dq * 16;
    RET_LD2(R.q1, P + h * 64 + d); RET_LD2(R.q2, P + h * 64 + 32 + d); RET_LD2(R.k1, P + 256 + h * 64 + d); RET_LD2(R.k2, P + 256 + h * 64 + 32 + d);
    RET_LD4(R.va, P + 512 + h * 128 + e0); RET_LD4(R.vb, P + 512 + h * 128 + e0 + 8); RET_LD4(R.cs, CS + d); RET_LD4(R.sn, SN + d);
}
__device__ __forceinline__ void ret_load_g(const bf16* P, int h, int dq, RetG& R) { const int e0 = dq * 16; RET_LD4(R.ga, P + 1024 + h * 128 + e0); RET_LD4(R.gb, P + 1024 + h * 128 + e0 + 8); }
#define RET_WAIT_A(R, N) asm volatile("s_waitcnt vmcnt(" #N ")" : "+v"((R).q1), "+v"((R).q2), "+v"((R).k1), "+v"((R).k2), "+v"((R).va), "+v"((R).vb), "+v"((R).cs), "+v"((R).sn) :: "memory")
#define RET_WAIT_G(R, N) asm volatile("s_waitcnt vmcnt(" #N ")" : "+v"((R).ga), "+v"((R).gb) :: "memory")
__device__ __forceinline__ bf16x8 ret_tr(const LAS bf16* img, int ld, int r0, int c0, int lr, int lq) {
    const LAS bf16* p = img + (r0 + 4 * lq + (lr >> 2)) * ld + c0 + 4 * (lr & 3);
    const ret_s4 a = __builtin_amdgcn_ds_read_tr16_b64_v4i16((LAS ret_s4*)p), b = __builtin_amdgcn_ds_read_tr16_b64_v4i16((LAS ret_s4*)(p + 16 * ld));
    return __builtin_shufflevector(a, b, 0, 1, 2, 3, 4, 5, 6, 7);
}
__device__ __forceinline__ bf16x8 ret_rowp(const LAS bf16* row, int k0, int lq) {
    const ret_s4 a = *(const LAS ret_s4*)(row + k0 + 4 * lq), b = *(const LAS ret_s4*)(row + k0 + 16 + 4 * lq);
    return __builtin_shufflevector(a, b, 0, 1, 2, 3, 4, 5, 6, 7);
}
#define RET_ITER(A, G) \
    { \
        int tl_ = tid; asm volatile("" : "+v"(tl_)); \
        const int lane = tl_ & 63, lr = lane & 15, lq = lane >> 4, i = tl_ >> 3, dq = tl_ & 7, d = dq * 4, e0 = dq * 16; \
        const int n2 = (n + 2 < SEQ / 64) ? n + 2 : SEQ / 64 - 1; \
        const bf16* P2 = prow + (size_t)n2 * 64 * NPROJ; \
        {     \
            RET_WAIT_A(A, 16); \
            const f32x4 cs = A.cs, sn = A.sn; \
            f32x4 x1, x2; \
            x1[0] = bf_lo(A.q1[0]); x1[1] = bf_hi(A.q1[0]); x1[2] = bf_lo(A.q1[1]); x1[3] = bf_hi(A.q1[1]); \
            x2[0] = bf_lo(A.q2[0]); x2[1] = bf_hi(A.q2[0]); x2[2] = bf_lo(A.q2[1]); x2[3] = bf_hi(A.q2[1]); \
            f32x4 o1 = x1 * cs - x2 * sn, o2 = x1 * sn + x2 * cs; \
            ret_u2 wv; wv[0] = cvtpk(o1[0], o1[1]); wv[1] = cvtpk(o1[2], o1[3]); *(LAS ret_u2*)(QS + i * RT_LD + d) = wv; \
            wv[0] = cvtpk(o2[0], o2[1]); wv[1] = cvtpk(o2[2], o2[3]); *(LAS ret_u2*)(QS + i * RT_LD + 32 + d) = wv; \
            x1[0] = bf_lo(A.k1[0]); x1[1] = bf_hi(A.k1[0]); x1[2] = bf_lo(A.k1[1]); x1[3] = bf_hi(A.k1[1]); \
            x2[0] = bf_lo(A.k2[0]); x2[1] = bf_hi(A.k2[0]); x2[2] = bf_lo(A.k2[1]); x2[3] = bf_hi(A.k2[1]); \
            o1 = (x1 * cs - x2 * sn) * 0.125f; o2 = (x1 * sn + x2 * cs) * 0.125f; \
            wv[0] = cvtpk(o1[0], o1[1]); wv[1] = cvtpk(o1[2], o1[3]); *(LAS ret_u2*)(KS + i * RT_LD + d) = wv; \
            wv[0] = cvtpk(o2[0], o2[1]); wv[1] = cvtpk(o2[2], o2[3]); *(LAS ret_u2*)(KS + i * RT_LD + 32 + d) = wv; \
            o1 = o1 * kwi; o2 = o2 * kwi; \
            wv[0] = cvtpk(o1[0], o1[1]); wv[1] = cvtpk(o1[2], o1[3]); *(LAS ret_u2*)(K2 + i * RT_K2LD + d) = wv; \
            wv[0] = cvtpk(o2[0], o2[1]); wv[1] = cvtpk(o2[2], o2[3]); *(LAS ret_u2*)(K2 + i * RT_K2LD + 32 + d) = wv; \
            *(LAS v4u*)(VS + i * RT_VLD + e0) = A.va; *(LAS v4u*)(VS + i * RT_VLD + e0 + 8) = A.vb; \
            ret_load_a(P2, COS + n2 * 64 * 32, SIN + n2 * 64 * 32, h, dq, A); \
        } \
        LBAR(); \
        if (!warm) { \
        {     \
            const int ti = w >> 1, ii = 16 * ti + lr; \
            const bf16x8 b0 = *(const LAS bf16x8*)(QS + ii * RT_LD + 8 * lq), b1 = *(const LAS bf16x8*)(QS + ii * RT_LD + 32 + 8 * lq); \
            _Pragma("unroll") \
            for (int q = 0; q < 2; ++q) { const int tj = (w & 1) * 2 + q; \
                const bf16x8 a0 = *(const LAS bf16x8*)(KS + (16 * tj + lr) * RT_LD + 8 * lq), a1 = *(const LAS bf16x8*)(KS + (16 * tj + lr) * RT_LD + 32 + 8 * lq); \
                f32x4 acc = (f32x4){0.f, 0.f, 0.f, 0.f}; \
                acc = __builtin_amdgcn_mfma_f32_16x16x32_bf16(a0, b0, acc, 0, 0, 0); acc = __builtin_amdgcn_mfma_f32_16x16x32_bf16(a1, b1, acc, 0, 0, 0); \
                _Pragma("unroll") \
                for (int rg = 0; rg < 4; ++rg) { const int j = 16 * tj + 4 * lq + rg; const int dd = ii > j ? ii - j : j - ii; acc[rg] *= __builtin_amdgcn_exp2f(lg * (float)dd); } \
                ret_u2 wv; wv[0] = cvtpk(acc[0], acc[1]); wv[1] = cvtpk(acc[2], acc[3]); *(LAS ret_u2*)(SC + ii * RT_LD + 16 * tj + 4 * lq) = wv; } \
        } \
        LBAR(); \
        } \
        if (!warm) \
        {     \
            const int ti = w >> 1, ii = 16 * ti + lr; \
            const LAS bf16* scr = SC + ii * RT_LD; \
            const bf16x8 sb0 = ret_rowp(scr, 0, lq), sb1 = ret_rowp(scr, 32, lq); \
            const bf16x8 qb0 = *(const LAS bf16x8*)(QS + ii * RT_LD + 8 * lq), qb1 = *(const LAS bf16x8*)(QS + ii * RT_LD + 32 + 8 * lq); \
            const bf16x8 ka0 = ret_tr(K2, RT_K2LD, 0, 16 * ti, lr, lq), ka1 = ret_tr(K2, RT_K2LD, 32, 16 * ti, lr, lq); \
            const float gi = __builtin_amdgcn_exp2f(lg * (float)(ii + 1)); \
            _Pragma("unroll") \
            for (int hq = 0; hq < 2; ++hq) { \
                bf16x8 va0[2], va1[2], pa0[2], pa1[2]; \
                _Pragma("unroll") \
                for (int q = 0; q < 2; ++q) { const int te = (w & 1) * 4 + 2 * hq + q; \
                    va0[q] = ret_tr(VS, RT_VLD, 0, 16 * te, lr, lq); va1[q] = ret_tr(VS, RT_VLD, 32, 16 * te, lr, lq); \
                    pa0[q] = *(const LAS bf16x8*)(PT + (16 * te + lr) * RT_LD + 8 * lq); pa1[q] = *(const LAS bf16x8*)(PT + (16 * te + lr) * RT_LD + 32 + 8 * lq); } \
                __builtin_amdgcn_sched_barrier(0); \
                _Pragma("unroll") \
                for (int q = 0; q < 2; ++q) { const int te = (w & 1) * 4 + 2 * hq + q, qq = 2 * hq + q; \
                    f32x4 ai = (f32x4){0.f, 0.f, 0.f, 0.f}, ax = ai; \
                    ai = __builtin_amdgcn_mfma_f32_16x16x32_bf16(va0[q], sb0, ai, 0, 0, 0); ax = __builtin_amdgcn_mfma_f32_16x16x32_bf16(pa0[q], qb0, ax, 0, 0, 0); \
                    ai = __builtin_amdgcn_mfma_f32_16x16x32_bf16(va1[q], sb1, ai, 0, 0, 0); ax = __builtin_amdgcn_mfma_f32_16x16x32_bf16(pa1[q], qb1, ax, 0, 0, 0); \
                    accP[qq] = accP[qq] * g64; \
                    accP[qq] = __builtin_amdgcn_mfma_f32_16x16x32_bf16(ka0, va0[q], accP[qq], 0, 0, 0); accP[qq] = __builtin_amdgcn_mfma_f32_16x16x32_bf16(ka1, va1[q], accP[qq], 0, 0, 0); \
                    *(LAS f32x4*)(OB + ii * RT_OLD + 16 * te + 4 * lq) = ai + ax * gi; } \
                __builtin_amdgcn_sched_barrier(0); \
            } \
        } \
        else {     \
            const int ti = w >> 1; \
            const bf16x8 ka0 = ret_tr(K2, RT_K2LD, 0, 16 * ti, lr, lq), ka1 = ret_tr(K2, RT_K2LD, 32, 16 * ti, lr, lq); \
            _Pragma("unroll") \
            for (int q = 0; q < 4; ++q) { const int te = (w & 1) * 4 + q; \
                const bf16x8 va0 = ret_tr(VS, RT_VLD, 0, 16 * te, lr, lq), va1 = ret_tr(VS, RT_VLD, 32, 16 * te, lr, lq); \
                accP[q] = accP[q] * g64; \
                accP[q] = __builtin_amdgcn_mfma_f32_16x16x32_bf16(ka0, va0, accP[q], 0, 0, 0); accP[q] = __builtin_amdgcn_mfma_f32_16x16x32_bf16(ka1, va1, accP[q], 0, 0, 0); } \
        } \
        LBAR(); \
        {     \
            _Pragma("unroll") \
            for (int q = 0; q < 4; ++q) { const int te = (w & 1) * 4 + q, td = w >> 1; ret_u2 wv; wv[0] = cvtpk(accP[q][0], accP[q][1]); wv[1] = cvtpk(accP[q][2], accP[q][3]); \
                *(LAS ret_u2*)(PT + (16 * te + lr) * RT_LD + 16 * td + 4 * lq) = wv; } \
            RET_WAIT_G(G, 20);                                                        \
            if (warm) { dumpp[0] = (v4u){0u, 0u, 0u, 0u}; dumpp[1] = (v4u){0u, 0u, 0u, 0u}; } else { \
            f32x4 o[4]; float ss = 0.f; \
            _Pragma("unroll") \
            for (int j = 0; j < 4; ++j) { o[j] = *(const LAS f32x4*)(OB + i * RT_OLD + e0 + 4 * j); ss += (o[j][0] * o[j][0] + o[j][1] * o[j][1]) + (o[j][2] * o[j][2] + o[j][3] * o[j][3]); } \
            ss = sum8(ss); \
            const float rstd = __builtin_amdgcn_rsqf(ss * (1.0f / 128.0f) + 1e-6f); \
            v4u oa, ob; \
            _Pragma("unroll") \
            for (int j = 0; j < 4; ++j) { \
                const float g0 = bf_lo(G.ga[j]), g1 = bf_hi(G.ga[j]), g2 = bf_lo(G.gb[j]), g3 = bf_hi(G.gb[j]); \
                const float x0 = o[j >> 1][(2 * j) & 3], x1 = o[j >> 1][(2 * j + 1) & 3], x2 = o[2 + (j >> 1)][(2 * j) & 3], x3 = o[2 + (j >> 1)][(2 * j + 1) & 3]; \
                oa[j] = cvtpk(x0 * rstd * g0 * sigm(g0), x1 * rstd * g1 * sigm(g1)); ob[j] = cvtpk(x2 * rstd * g2 * sigm(g2), x3 * rstd * g3 * sigm(g3)); } \
            bf16* O = orow + (size_t)n * 64 * DM; \
            *(GAS v4u*)O = oa; *(GAS v4u*)(O + 8) = ob; } \
            ret_load_g(P2, h, dq, G); \
        } \
          \
    }
__device__ __forceinline__ void ret_unit(const Frame& F, int unit) {
    const int b = unit >> 3, h = (unit >> 1) & 3, half = unit & 1;
    LAS unsigned char* lds = F.lds + RING_OFF;
    LAS bf16* QS = (LAS bf16*)(lds + RT_QS); LAS bf16* KS = (LAS bf16*)(lds + RT_KS); LAS bf16* K2 = (LAS bf16*)(lds + RT_K2); LAS bf16* SC = (LAS bf16*)(lds + RT_SC);
    LAS bf16* VS = (LAS bf16*)(lds + RT_VS); LAS bf16* PT = (LAS bf16*)(lds + RT_PT); LAS float* OB = (LAS float*)(lds + RT_OB);
    const int tid = F.tid, w = F.wave;
    const float gamma = 1.0f - exp2f(-5.0f - (float)h), lg = log2f(gamma), g64 = exp2f(64.0f * lg);
    for (int i = tid; i < 128 * RT_LD / 2; i += NWAVES * 64) ((LAS unsigned*)PT)[i] = 0u;
    f32x4 accP[4];
#pragma unroll
    for (int q = 0; q < 4; ++q) accP[q] = (f32x4){0.f, 0.f, 0.f, 0.f};
    const float* COS = (const float*)(F.ws + WS_TRIG) + (tid >> 3) * 32; const float* SIN = COS + SEQ * 32;
    const bf16* prow = (const bf16*)(F.ws + WS_H) + ((size_t)b * SEQ + (tid >> 3)) * NPROJ + RET_OFF;
    bf16* orow = (bf16*)(F.ws + WS_MIXED) + ((size_t)b * SEQ + (tid >> 3)) * DM + 512 + h * 128 + (tid & 7) * 16;
    const float kwi = exp2f(lg * (float)(63 - (tid >> 3)));
    GAS v4u* dumpp = (GAS v4u*)(F.ws + WS_DUMP + 1 * MiB) + ((size_t)F.vcu * 512 + tid) * 2;
    const int nend = half ? SEQ / 64 : SEQ / 128;
    RetA A0, A1; RetG G0, G1;
    A0.q1 = (ret_u2){0u, 0u}; A0.q2 = A0.q1; A0.k1 = A0.q1; A0.k2 = A0.q1; A0.va = (v4u){0u, 0u, 0u, 0u}; A0.vb = A0.va; A0.cs = (f32x4){0.f, 0.f, 0.f, 0.f}; A0.sn = A0.cs; A1 = A0;
    G0.ga = (v4u){0u, 0u, 0u, 0u}; G0.gb = G0.ga; G1 = G0;
    {
        const int dq = tid & 7;
        ret_load_a(prow, COS, SIN, h, dq, A0); dumpp[0] = (v4u){0u, 0u, 0u, 0u}; dumpp[1] = (v4u){0u, 0u, 0u, 0u}; ret_load_g(prow, h, dq, G0);
        const bf16* p1 = prow + (size_t)64 * NPROJ;
        ret_load_a(p1, COS + 64 * 32, SIN + 64 * 32, h, dq, A1); dumpp[0] = (v4u){0u, 0u, 0u, 0u}; dumpp[1] = (v4u){0u, 0u, 0u, 0u}; ret_load_g(p1, h, dq, G1);
    }
    __syncthreads();
    for (int n0 = 0; n0 < nend; n0 += 2) {
        const bool warm = half && n0 < SEQ / 128;
        { const int n = n0;     RET_ITER(A0, G0) }
        { const int n = n0 + 1; RET_ITER(A1, G1) }
    }
    asm volatile("s_waitcnt vmcnt(0)" ::: "memory");
    __syncthreads();
}
#ifndef MK_PER_PHASE
#define MK_PER_PHASE 0
#endif
constexpr int PH_PER_LAYER = 10, PH_FINAL = 1 + DEPTH * PH_PER_LAYER, N_PHASES = PH_FINAL + 1;
__global__ void __launch_bounds__(NWAVES * 64, 2) mk_fwd(Args args) {
    extern __shared__ __attribute__((aligned(16))) unsigned char lds[];
    Frame F;
    F.lds = (LAS unsigned char*)lds;
    F.MISC = (volatile LAS unsigned*)(F.lds + MISC_OFF);
    F.tid = threadIdx.x; F.lane = F.tid & 63; F.wave = __builtin_amdgcn_readfirstlane(F.tid >> 6);
    F.G = gridDim.x; { const int bx = blockIdx.x; F.vcu = (F.G % 8 == 0) ? (bx % 8) * (F.G / 8) + bx / 8 : bx; }
    F.ws = args.ws; F.lora = (unsigned char*)args.out;
    gu32* ctl = (gu32*)(F.ws + WS_CTL);
    for (int u = F.tid; u < (LDS_BYTES - LDSCTL_OFF) / 4; u += NWAVES * 64) ((LAS unsigned*)(F.lds + LDSCTL_OFF))[u] = 0u;
    __syncthreads();
#if MK_PER_PHASE
    const int lo = args.ph_lo, hi = args.ph_hi;
#else
    constexpr int lo = 0, hi = N_PHASES;
#endif
    XcdBarrier bar; bar.bar = (unsigned*)(ctl + CW_BAR); bar.x = 0; bar.st = nullptr;
    if (hi - lo > 1) bar = xcd_barrier_post((unsigned*)(ctl + CW_BAR), F.MISC + 8);
    const bool GL = (F.G == 256) && (hi - lo > 1);
    const unsigned grp = (unsigned)(F.vcu >> 5) & 7u;
    if (GL && threadIdx.x == 0) (void)__hip_atomic_fetch_or((unsigned*)(ctl + CW_BAR) + GB_MASK(grp), 1u << bar.x, RLX_AGENT);
#define IN(k) (lo <= (k) && (k) < hi)
#define PHASE_ENTER() do { int t_ = threadIdx.x; asm volatile("" : "+v"(t_)); F.tid = t_; F.lane = t_ & 63; } while (0)
#define SEAM(k) do { if (IN(k) && IN((k) + 1)) { XcdBarrier b_ = bar; asm volatile("" : "+s"(b_.bar), "+s"(b_.x)); xcd_barrier(b_); } } while (0)
#define GSEAM(k) do { if (IN(k) && IN((k) + 1)) { if (GL) { unsigned* gb_ = (unsigned*)(ctl + CW_BAR); unsigned gg_ = grp; asm volatile("" : "+s"(gb_), "+s"(gg_)); flag_barrier(gb_, gg_ * 32u, 1u, 32u, (unsigned)F.vcu, F.MISC + 11, F.MISC[10] != 0u); } \
        else { XcdBarrier b_ = bar; asm volatile("" : "+s"(b_.bar), "+s"(b_.x)); xcd_barrier(b_); } } } while (0)
#define QSEAM(k) do { if (IN(k) && IN((k) + 1)) { if (GL) { unsigned* gb_ = (unsigned*)(ctl + CW_BAR); unsigned qq_ = grp * 32u + ((unsigned)F.vcu & 7u); asm volatile("" : "+s"(gb_), "+s"(qq_)); flag_barrier(gb_, qq_, 8u, 4u, (unsigned)F.vcu, F.MISC + 11, F.MISC[10] != 0u); } \
        else { XcdBarrier b_ = bar; asm volatile("" : "+s"(b_.bar), "+s"(b_.x)); xcd_barrier(b_); } } } while (0)
#define QSTAGGER() do { if (GL) for (unsigned i_ = 0; i_ < ((unsigned)F.vcu & 7u); ++i_) __builtin_amdgcn_s_sleep(QSLEEP); } while (0)
#define CTR_WAIT(word, below, acq) do { if (threadIdx.x == 0) { unsigned* gb_ = (unsigned*)(ctl + CW_BAR); asm volatile("" : "+s"(gb_)); XB_SPIN(xb_ld(&gb_[word]) < (below), gb_); \
        if (acq) { __builtin_amdgcn_fence(__ATOMIC_ACQUIRE, "agent"); asm volatile("s_waitcnt vmcnt(0)" ::: "memory"); } } __syncthreads(); } while (0)
#define CTR_POST(word) do { if (threadIdx.x == 0) { unsigned* gb_ = (unsigned*)(ctl + CW_BAR); asm volatile("" : "+s"(gb_)); __builtin_amdgcn_fence(__ATOMIC_RELEASE, "agent"); asm volatile("s_waitcnt vmcnt(0)" ::: "memory"); \
        (void)xb_add(&gb_[word], 1u); } } while (0)
    bf16* XB = (bf16*)(F.ws + WS_XB); bf16* HB = (bf16*)(F.ws + WS_H); bf16* PROJ = (bf16*)(F.ws + WS_H); bf16* MIXED = (bf16*)(F.ws + WS_MIXED); bf16* ALORA = (bf16*)(F.ws + WS_MIXED);
    float* SSQ = (float*)(F.ws + WS_SSQ);
    bf16* HBg = HB;
    if (IN(0)) { PHASE_ENTER(); p0_prologue(F, args); SEAM(0); }
    if (GL) {
        if (threadIdx.x == 0) { const unsigned mk = xb_ld((unsigned*)(ctl + CW_BAR) + GB_MASK(grp)); F.MISC[10] = (mk & (mk - 1u)) != 0u ? 1u : 0u; }
        {   constexpr int LATE = DEPTH * ITEMS_LAYER - ITEMS_EARLY; const int g = (int)grp;
            const int it0 = ITEMS_EARLY + (int)(((long)LATE * (g * (g - 1) / 2)) / 28), it1 = ITEMS_EARLY + (int)(((long)LATE * (g * (g + 1) / 2)) / 28);
            PHASE_ENTER(); p0_weights(F, args, it0, it1, (F.vcu & 31) * NWAVES + F.wave, 32 * NWAVES);
            asm volatile("s_waitcnt vmcnt(0)" ::: "memory"); __syncthreads(); CTR_POST(GB_WDONE); }
        QSTAGGER();
    }
    for (int l = 0; l < DEPTH; ++l) {
        const int pb = 1 + PH_PER_LAYER * l;
        const unsigned char* wl = F.ws + WS_W + (size_t)l * SZ_LAYER;
        float* ssq_in = SSQ + (size_t)(l & 1) * M * 16; float* ssq_a = SSQ + (size_t)((l + 1) & 1) * M * 16; float* ssq_b = ssq_in; float* ssq_c = ssq_a;
        LayerP L; L.mu = args.in[7] + l * RWKV_IN; L.w0 = args.in[8] + l * 512; L.a0 = args.in[10] + l * 512; L.k_k = args.in[13] + l * 512; L.k_a = args.in[14] + l * 512;
        L.r_k = args.in[15] + l * 512; L.ln_w = args.in[16] + l * 512; L.ln_b = args.in[17] + l * 512; L.wlora = (const bf16*)(wl + OFF_WLORA);
        if (IN(pb + 0)) {
            pg8::Gemm g{XB, (const bf16*)(wl + OFF_WGU1), M, NGU, DM, 0u}; pg8::StaticOrder S; S.init(M, NGU, F.G, opaque_bx());
            pg8::EpiSwiglu E{HBg, DFF, ssq_in, (LAS float*)(F.lds + EPI_TAB_OFF)};
            pg8::gemm_phase<pg8::EpiSwiglu, pg8::StaticOrder, true, true>(F.lds + RING_OFF, g, S, E);
            QSEAM(pb + 0);
        }
        if (IN(pb + 1)) {
            if (GL && l == 0) CTR_WAIT(GB_WDONE, (unsigned)F.G, true);
            pg8::Gemm g{HBg, (const bf16*)(wl + OFF_WD1), M, DM, DFF, pg8::HPAD_EL * 2u}; pg8::StaticOrder S; S.init(M, DM, F.G, opaque_bx());
            pg8::EpiResid E{XB, ssq_a, 0.5f};
            pg8::gemm_phase<pg8::EpiResid, pg8::StaticOrder, true, true>(F.lds + RING_OFF, g, S, E);
            QSEAM(pb + 1);
        }
        if (IN(pb + 2)) {
            pg8::Gemm g{XB, (const bf16*)(wl + OFF_WIN), M, NPROJ, DM, 0u}; pg8::WinOrder S; S.init(M, NPROJ, F.G, opaque_bx());
            pg8::EpiProj<true> E{PROJ, NPROJ, ssq_a, (LAS float*)(F.lds + EPI_TAB_OFF), S.fused ? (bf16*)(F.ws + WS_SIDE) : nullptr};
            pg8::gemm_phase<pg8::EpiProj<true>, pg8::WinOrder, true, true>(F.lds + RING_OFF, g, S, E);
            if (S.fused && S.c >= 128) { PHASE_ENTER(); lora_prep_panel(F, L.mu, S.pm6());
            }
            GSEAM(pb + 2);
        }
        if (IN(pb + 3) && F.G != 256) { PHASE_ENTER(); lora_prep(F, L.mu); GSEAM(pb + 3); }
        if (IN(pb + 5)) {
            PHASE_ENTER();
            rwkv_m1_phase(F, L);
            GSEAM(pb + 5);
        }
        if (IN(pb + 6)) {
            PHASE_ENTER();
            for (int u = F.vcu; u < 256; u += F.G) { int uu = u;
                if (GL) { const int li = u & 31, g16 = (u >> 5) * 16; uu = li < 16 ? g16 + li : 128 + g16 + (li - 16); }
                if (uu < 128) rwkv_m2_unit(F, L, uu); else ret_unit(F, uu - 128); }
            GSEAM(pb + 6);
            QSTAGGER();
            if (GL && l == DEPTH - 1) CTR_POST(GB_MDONE);
        }
        if (IN(pb + 7)) {
            pg8::Gemm g{MIXED, (const bf16*)(wl + OFF_WOUT), M, DM, DM, 0u}; pg8::StaticOrder S; S.init(M, DM, F.G, opaque_bx());
            pg8::EpiResid E{XB, ssq_b, 1.0f};
            pg8::gemm_phase<pg8::EpiResid, pg8::StaticOrder, true, true>(F.lds + RING_OFF, g, S, E);
            QSEAM(pb + 7);
        }
        if (IN(pb + 8)) {
            pg8::Gemm g{XB, (const bf16*)(wl + OFF_WGU2), M, NGU, DM, 0u}; pg8::StaticOrder S; S.init(M, NGU, F.G, opaque_bx());
            pg8::EpiSwiglu E{HBg, DFF, ssq_b, (LAS float*)(F.lds + EPI_TAB_OFF)};
            pg8::gemm_phase<pg8::EpiSwiglu, pg8::StaticOrder, true, true>(F.lds + RING_OFF, g, S, E);
            QSEAM(pb + 8);
        }
        if (IN(pb + 9)) {
            pg8::Gemm g{HBg, (const bf16*)(wl + OFF_WD2), M, DM, DFF, pg8::HPAD_EL * 2u}; pg8::StaticOrder S; S.init(M, DM, F.G, opaque_bx());
            pg8::EpiResid E{XB, ssq_c, 0.5f};
            pg8::gemm_phase<pg8::EpiResid, pg8::StaticOrder, true, true>(F.lds + RING_OFF, g, S, E);
            QSEAM(pb + 9);
        }
    }
    if (IN(PH_FINAL)) {
        PHASE_ENTER();
        const float* ssq = SSQ + (size_t)(DEPTH & 1) * M * 16; const float* gain = args.in[23];
        const unsigned tmo = __hip_atomic_load(ctl + CW_BAR + XB_TMO, RLX_AGENT);
        const int gw = F.vcu * NWAVES + F.wave, NGW = F.G * NWAVES;
        if (GL) CTR_WAIT(GB_MDONE, (unsigned)F.G, false);
        f32x4 gv[4];
#pragma unroll
        for (int j = 0; j < 4; ++j) gv[j] = *((const f32x4*)gain + 2 * F.lane + (j & 1) + 128 * (j >> 1));
        for (int k = 0;; k += 4) {
            int mr[4]; bool ok[4];
#pragma unroll
            for (int r = 0; r < 4; ++r) { mr[r] = GL ? ((int)grp * 16 + (F.vcu & 7) + 8 * ((k + r) >> 3)) * 256 + (((F.vcu & 31) >> 3) * NWAVES + F.wave) + 32 * ((k + r) & 7) : gw + (k + r) * NGW;     ok[r] = GL ? (k + r < 16) : (mr[r] < M); if (!ok[r]) mr[r] = 0; }
            if (!ok[0]) break;
            f32x4 sq[4][4]; v4u xv[4][2];
#pragma unroll
            for (int r = 0; r < 4; ++r) { const f32x4* sp = (const f32x4*)(ssq + (size_t)mr[r] * pg8::SSQ_P);
#pragma unroll
                for (int j = 0; j < 4; ++j) sq[r][j] = sp[j];
                const GAS v4u* xr = (const GAS v4u*)(XB + (size_t)mr[r] * DM) + F.lane; xv[r][0] = xr[0]; xv[r][1] = xr[64]; }
#pragma unroll
            for (int r = 0; r < 4; ++r) { if (!ok[r]) continue;
                const f32x4 s4 = (sq[r][0] + sq[r][1]) + (sq[r][2] + sq[r][3]); const float tt = (s4[0] + s4[1]) + (s4[2] + s4[3]);
                const float rs = (1.0f / sqrtf(tt * (1.0f / 1024.0f) + pg8::RMS_EPS)) * (tmo ? __builtin_nanf("") : 1.0f);
                GAS f32x4* orow = (GAS f32x4*)(args.out + (size_t)mr[r] * DM) + 2 * F.lane;
#pragma unroll
                for (int j = 0; j < 2; ++j) { const v4u v = xv[r][j];
                    const f32x4 a = {bf_lo(v.x), bf_hi(v.x), bf_lo(v.y), bf_hi(v.y)}, c = {bf_lo(v.z), bf_hi(v.z), bf_lo(v.w), bf_hi(v.w)};
                    orow[128 * j] = a * rs * gv[2 * j]; orow[128 * j + 1] = c * rs * gv[2 * j + 1]; } }
        }
    }
#undef IN
#undef SEAM
}

extern "C" void kernel_launch(void* const* d_in, const int* in_sizes, int n_in, void* d_out, int out_size, void* d_ws, size_t ws_size, hipStream_t stream) {
    static int grid = 0;
    if (grid == 0) {
        if (n_in != 24 || in_sizes[0] != M * DM || out_size != M * DM || ws_size < WS_END) { fprintf(stderr, "kernel_launch: unexpected shapes (n_in %d, in0 %d, out %d, ws %zu); nothing launched\n", n_in, n_in > 0 ? in_sizes[0] : -1, out_size, ws_size); grid = -1; return; }
        int dev = 0, cus = 0, per_cu = 0;
        if (hipGetDevice(&dev) != hipSuccess || hipDeviceGetAttribute(&cus, hipDeviceAttributeMultiprocessorCount, dev) != hipSuccess) { grid = -1; return; }
        if (hipFuncSetAttribute((const void*)mk_fwd, hipFuncAttributeMaxDynamicSharedMemorySize, LDS_BYTES) != hipSuccess) { fprintf(stderr, "kernel_launch: hipFuncSetAttribute failed\n"); grid = -1; return; }
        if (hipOccupancyMaxActiveBlocksPerMultiprocessor(&per_cu, (const void*)mk_fwd, NWAVES * 64, LDS_BYTES) != hipSuccess || per_cu < 1)
            fprintf(stderr, "kernel_launch: note: occupancy query reports %d workgroups per CU\n", per_cu);
        (void)hipGetLastError();
        grid = cus;
    }
    if (grid < 0) return;
    if (hipMemsetAsync((char*)d_ws + WS_CTL, 0, CTL_ZERO_BYTES, stream) != hipSuccess) return;
    Args a{};
    for (int i = 0; i < 24; ++i) a.in[i] = (const float*)d_in[i];
    a.out = (float*)d_out; a.ws = (unsigned char*)d_ws;
#if MK_PER_PHASE
    for (int p = 0; p < N_PHASES; ++p) { a.ph_lo = p; a.ph_hi = p + 1; hipLaunchKernelGGL(mk_fwd, dim3(grid), dim3(NWAVES * 64), LDS_BYTES, stream, a); }
#else
    a.ph_lo = 0; a.ph_hi = N_PHASES;
    hipLaunchKernelGGL(mk_fwd, dim3(grid), dim3(NWAVES * 64), LDS_BYTES, stream, a);
#endif
}
```
